# Optimizing an MI355X kernel written in HIP

```python
import math
import jax
import jax.numpy as jnp
from jax import lax
import numpy as np

D_MODEL = 1024
BATCH = 16
SEQ = 2048
DEPTH = 2
DEC_BATCH = 16
DEC_SEQ = 64
PAST_LEN = 2048

CHUNK = 64
EPS = 1e-6
NEG_INF = -1e30
A_HEADS = 4
A_DK = 128
A_DV = 128
A_QK = A_HEADS * A_DK
A_WIDTH = A_HEADS * A_DV
A_CONV = 4
B_HEADS = 4
B_DQK = 64
B_DV = 2 * B_DQK
B_QK = B_HEADS * 2 * B_DQK
B_WIDTH = B_HEADS * B_DV
Q_BLOCK = 128
C_WINDOWS = (2, 4, 8, 16)
C_GROUPS = 4
C_GROUP_DIM = 128
C_WIDTH = C_GROUPS * C_GROUP_DIM
C_POOL_BUF = 15
MIX_WIDTH = A_WIDTH + B_WIDTH + C_WIDTH
IN_WIDTHS = (A_QK, A_QK, A_WIDTH, A_WIDTH, A_HEADS, A_HEADS, B_QK, B_QK, B_WIDTH, C_WIDTH)
IN_WIDTH = 2 * A_QK + 2 * A_WIDTH + 2 * A_HEADS + 2 * B_QK + B_WIDTH + C_WIDTH
D_FF = 2816
FFN_CONV = 3

kernel_name = 'hybrid_stream_deltanet_diffattn_pool_step'


def rmsnorm(x, g):
    xf = x.astype(jnp.float32)
    y = xf * lax.rsqrt(jnp.mean(xf * xf, axis=-1, keepdims=True) + EPS)
    return (y * g.astype(jnp.float32)).astype(x.dtype)


def l2norm(x):
    xf = x.astype(jnp.float32)
    return xf * lax.rsqrt(jnp.sum(xf * xf, axis=-1, keepdims=True) + EPS)


def split_cols(t, widths):
    out, start = [], 0
    for w in widths:
        out.append(t[..., start:start + w])
        start += w
    return out


def causal_dwconv(x, buf, w, b):
    width = w.shape[0]
    length = x.shape[1]
    xp = jnp.concatenate([buf.astype(x.dtype), x], axis=1)
    y = b
    for i in range(width):
        y = y + xp[:, i:i + length] * w[i]
    return y, xp[:, xp.shape[1] - (width - 1):]


def gated_delta_rule(q, k, v, g, beta, s0):
    bsz, length, heads, dk = q.shape
    dv = v.shape[-1]
    n = -(-length // CHUNK)
    pad = n * CHUNK - length

    def prep(t):
        t = jnp.pad(t, [(0, 0), (0, pad)] + [(0, 0)] * (t.ndim - 2))
        t = t.reshape((bsz, n, CHUNK) + t.shape[2:])
        return jnp.moveaxis(t, 3, 1)

    q, k, v, g, beta = prep(q), prep(k), prep(v), prep(g), prep(beta)
    G = jnp.cumsum(g, axis=-1)
    idx = jnp.arange(CHUNK)
    incl = idx[:, None] >= idx[None, :]
    strict = idx[:, None] > idx[None, :]
    diff = G[..., :, None] - G[..., None, :]
    decay = jnp.where(incl, jnp.exp(jnp.where(incl, diff, 0.0)), 0.0)
    kk = jnp.einsum('bhncd,bhnsd->bhncs', k, k)
    lmat = jnp.where(strict, beta[..., :, None] * decay * kk, 0.0)
    eye = jnp.eye(CHUNK, dtype=jnp.float32)
    gam = jnp.exp(G)
    rhs = jnp.concatenate([v * beta[..., None], k * (beta * gam)[..., None]], axis=-1)
    uw = lax.linalg.triangular_solve(eye + lmat, rhs, left_side=True, lower=True, unit_diagonal=True)
    u_blk, w_blk = uw[..., :dv], uw[..., dv:]
    qk = jnp.einsum('bhncd,bhnsd->bhncs', q, k) * decay
    q_g = q * gam[..., None]
    k_tail = k * jnp.exp(G[..., -1:] - G)[..., None]
    g_last = gam[..., -1]

    def step(state, xs):
        u_c, w_c, qg_c, qk_c, kt_c, gl_c = xs
        delta = u_c - jnp.einsum('bhcd,bhde->bhce', w_c, state)
        o = jnp.einsum('bhcd,bhde->bhce', qg_c, state) + jnp.einsum('bhcs,bhse->bhce', qk_c, delta)
        state = state * gl_c[..., None, None] + jnp.einsum('bhcd,bhce->bhde', kt_c, delta)
        return state, o

    xs = tuple(jnp.moveaxis(t, 2, 0) for t in (u_blk, w_blk, q_g, qk, k_tail, g_last))
    s_final, o = lax.scan(step, s0, xs)
    o = jnp.moveaxis(jnp.moveaxis(o, 0, 2), 1, 3).reshape(bsz, n * CHUNK, heads, dv)
    return o[:, :length], s_final


def diff_softmax_weights(s, lam):
    p = jax.nn.softmax(s, axis=-1)
    return p[:, :, 0] - lam * p[:, :, 1]


def diff_attn_prompt(q, k, v, lam):
    bsz, length = q.shape[:2]
    nb = length // Q_BLOCK
    scale = B_DQK ** -0.5
    q_blocks = jnp.moveaxis(q.reshape(bsz, nb, Q_BLOCK, B_HEADS, 2, B_DQK), 1, 0)
    k_chunk = jnp.arange(length) // CHUNK

    def one_block(args):
        qi, bi = args
        q_chunk = (bi * Q_BLOCK + jnp.arange(Q_BLOCK)) // CHUNK
        mask = k_chunk[None, :] <= q_chunk[:, None]
        s = jnp.einsum('bqhmd,bkhmd->bhmqk', qi, k, preferred_element_type=jnp.float32) * scale
        s = jnp.where(mask, s, NEG_INF)
        w = diff_softmax_weights(s, lam)
        return jnp.einsum('bhqk,bkhe->bqhe', w.astype(v.dtype), v)

    o = lax.map(one_block, (q_blocks, jnp.arange(nb)))
    return jnp.moveaxis(o, 0, 1).reshape(bsz, length, B_HEADS, B_DV)


def diff_attn_sample(q, k_all, v_all, lam):
    s = jnp.einsum('bqhmd,bkhmd->bhmqk', q, k_all, preferred_element_type=jnp.float32) * (B_DQK ** -0.5)
    w = diff_softmax_weights(s, lam)
    return jnp.einsum('bhqk,bkhe->bqhe', w.astype(v_all.dtype), v_all)


def pool_mixer(xc, buf, pos0, c_w, c_scale):
    bsz, length, _ = xc.shape
    xp_raw = jnp.concatenate([buf.astype(xc.dtype), xc], axis=1)
    xp = xp_raw.astype(jnp.float32)
    cs = jnp.concatenate([jnp.zeros((bsz, 1, C_WIDTH), jnp.float32), jnp.cumsum(xp, axis=1)], axis=1)
    pos = pos0 + jnp.arange(length)
    hi = cs[:, C_POOL_BUF + 1:C_POOL_BUF + 1 + length]
    outs = []
    for gi, win in enumerate(C_WINDOWS):
        sl = slice(gi * C_GROUP_DIM, (gi + 1) * C_GROUP_DIM)
        lo = cs[:, C_POOL_BUF + 1 - win:C_POOL_BUF + 1 - win + length, sl]
        cnt = jnp.minimum(pos + 1, win).astype(jnp.float32)[None, :, None]
        pooled = (hi[..., sl] - lo) / cnt - xp[:, C_POOL_BUF:, sl]
        outs.append(jnp.einsum('blc,cd->bld', pooled, c_w[gi].astype(jnp.float32)))
    y = jnp.concatenate(outs, axis=-1) * c_scale.astype(jnp.float32)
    return y.astype(xc.dtype), xp_raw[:, xp_raw.shape[1] - C_POOL_BUF:]


def conv_ffn(h, buf, w_up, w_conv, b_conv, w_down):
    u = jnp.einsum('bld,df->blf', h, w_up)
    u, new_buf = causal_dwconv(u, buf, w_conv, b_conv)
    gate, val = split_cols(u, (D_FF, D_FF))
    return jnp.einsum('blf,fd->bld', jax.nn.silu(gate) * val, w_down), new_buf


def trunk_layer(x, pos0, delta_s0, conv_buf, past_k, past_v, pool_buf, ffn_buf,
                norm_mix, w_in, a_conv_w, a_conv_b, a_log, a_dt_bias, a_norm,
                b_lambda, b_norm, c_w, c_scale, w_out,
                norm_ffn, ffn_up, ffn_conv_w, ffn_conv_b, ffn_down, lam_init):
    bsz, length, _ = x.shape
    h = rmsnorm(x, norm_mix)
    proj = jnp.einsum('bld,de->ble', h, w_in)
    aq, ak, av, az, aa, ab, bq, bk, bv, cx = split_cols(proj, IN_WIDTHS)

    qkv, new_conv = causal_dwconv(jnp.concatenate([aq, ak, av], axis=-1), conv_buf, a_conv_w, a_conv_b)
    qkv = jax.nn.silu(qkv)
    q, k, v = split_cols(qkv, (A_QK, A_QK, A_WIDTH))
    q = l2norm(q.reshape(bsz, length, A_HEADS, A_DK)) * (A_DK ** -0.5)
    k = l2norm(k.reshape(bsz, length, A_HEADS, A_DK))
    v = v.reshape(bsz, length, A_HEADS, A_DV).astype(jnp.float32)
    g = -jnp.exp(a_log.astype(jnp.float32)) * jax.nn.softplus(aa.astype(jnp.float32) + a_dt_bias.astype(jnp.float32))
    beta = jax.nn.sigmoid(ab.astype(jnp.float32))
    o_a, new_delta = gated_delta_rule(q, k, v, g, beta, delta_s0.astype(jnp.float32))
    gate = jax.nn.silu(az.reshape(bsz, length, A_HEADS, A_DV).astype(jnp.float32))
    o_a = (rmsnorm(o_a, a_norm) * gate).reshape(bsz, length, A_WIDTH).astype(x.dtype)

    bq5 = bq.reshape(bsz, length, B_HEADS, 2, B_DQK)
    bk5 = bk.reshape(bsz, length, B_HEADS, 2, B_DQK)
    bv4 = bv.reshape(bsz, length, B_HEADS, B_DV)
    lf = b_lambda.astype(jnp.float32)
    lam = jnp.exp(jnp.sum(lf[0] * lf[1])) - jnp.exp(jnp.sum(lf[2] * lf[3])) + lam_init
    if past_k is None:
        o_b = diff_attn_prompt(bq5, bk5, bv4, lam)
    else:
        pk = past_k.reshape(past_k.shape[0], past_k.shape[1], B_HEADS, 2, B_DQK).astype(bk5.dtype)
        k_all = jnp.concatenate([pk, bk5], axis=1)
        v_all = jnp.concatenate([past_v.astype(bv4.dtype), bv4], axis=1)
        o_b = diff_attn_sample(bq5, k_all, v_all, lam)
    o_b = (rmsnorm(o_b, b_norm) * (1.0 - lam_init)).reshape(bsz, length, B_WIDTH).astype(x.dtype)
    new_k = bk.reshape(bsz, length, B_HEADS, 2 * B_DQK)
    new_v = bv4

    o_c, new_pool = pool_mixer(cx, pool_buf, pos0, c_w, c_scale)

    mixed = jnp.concatenate([o_a, o_b, o_c], axis=-1)
    x = x + jnp.einsum('ble,ed->bld', mixed, w_out)
    f, new_ffn = conv_ffn(rmsnorm(x, norm_ffn), ffn_buf, ffn_up, ffn_conv_w, ffn_conv_b, ffn_down)
    x = x + f
    return x, (new_delta.astype(x.dtype), new_conv, new_k, new_v, new_pool, new_ffn)


def setup_inputs(seed: int = 0) -> dict:
    key = jax.random.key(seed)
    ks = jax.random.split(key, 32)
    f32 = jnp.float32

    def nrm(k, shape, s):
        return jax.random.normal(k, shape, f32) * s

    a_log = jnp.log(jax.random.uniform(ks[12], (DEPTH, A_HEADS), f32, 1.0, 16.0))
    dt = jax.random.uniform(ks[13], (DEPTH, A_HEADS), f32, 0.001, 0.1)
    return {
        'x_prompt': nrm(ks[0], (BATCH, SEQ, D_MODEL), 1.0),
        'x_sample': nrm(ks[1], (DEC_BATCH, DEC_SEQ, D_MODEL), 1.0),
        'state_delta': nrm(ks[2], (DEPTH, DEC_BATCH, A_HEADS, A_DK, A_DV), 0.5),
        'cache_qkv_conv': nrm(ks[3], (DEPTH, DEC_BATCH, A_CONV - 1, 3 * A_WIDTH), 1.0),
        'cache_k': nrm(ks[4], (DEPTH, DEC_BATCH, PAST_LEN, B_HEADS, 2 * B_DQK), 1.0),
        'cache_v': nrm(ks[5], (DEPTH, DEC_BATCH, PAST_LEN, B_HEADS, B_DV), 1.0),
        'cache_pool': nrm(ks[6], (DEPTH, DEC_BATCH, C_POOL_BUF, C_WIDTH), 1.0),
        'cache_ffn_conv': nrm(ks[7], (DEPTH, DEC_BATCH, FFN_CONV - 1, 2 * D_FF), 1.0),
        'norm_mix': 1.0 + nrm(ks[8], (DEPTH, D_MODEL), 0.05),
        'w_in': nrm(ks[9], (DEPTH, D_MODEL, IN_WIDTH), D_MODEL ** -0.5),
        'a_conv_w': nrm(ks[10], (DEPTH, A_CONV, 3 * A_WIDTH), A_CONV ** -0.5),
        'a_conv_b': nrm(ks[11], (DEPTH, 3 * A_WIDTH), 0.02),
        'a_log': a_log,
        'a_dt_bias': jnp.log(jnp.expm1(dt)),
        'a_norm': 1.0 + nrm(ks[14], (DEPTH, A_DV), 0.05),
        'b_lambda': nrm(ks[15], (DEPTH, 4, B_DQK), 0.1),
        'b_norm': 1.0 + nrm(ks[16], (DEPTH, B_DV), 0.05),
        'c_w': nrm(ks[17], (DEPTH, C_GROUPS, C_GROUP_DIM, C_GROUP_DIM), C_GROUP_DIM ** -0.5),
        'c_scale': 1.0 + nrm(ks[18], (DEPTH, C_WIDTH), 0.1),
        'w_out': nrm(ks[19], (DEPTH, MIX_WIDTH, D_MODEL), MIX_WIDTH ** -0.5),
        'norm_ffn': 1.0 + nrm(ks[20], (DEPTH, D_MODEL), 0.05),
        'ffn_up': nrm(ks[21], (DEPTH, D_MODEL, 2 * D_FF), D_MODEL ** -0.5),
        'ffn_conv_w': nrm(ks[22], (DEPTH, FFN_CONV, 2 * D_FF), FFN_CONV ** -0.5),
        'ffn_conv_b': nrm(ks[23], (DEPTH, 2 * D_FF), 0.02),
        'ffn_down': nrm(ks[24], (DEPTH, D_FF, D_MODEL), D_FF ** -0.5),
        'norm_final': 1.0 + nrm(ks[25], (D_MODEL,), 0.05),
    }


def reference(x_prompt, x_sample, state_delta, cache_qkv_conv, cache_k, cache_v, cache_pool, cache_ffn_conv,
              norm_mix, w_in, a_conv_w, a_conv_b, a_log, a_dt_bias, a_norm, b_lambda, b_norm,
              c_w, c_scale, w_out, norm_ffn, ffn_up, ffn_conv_w, ffn_conv_b, ffn_down, norm_final):
    yp, ys = x_prompt, x_sample
    nbp = x_prompt.shape[0]
    p_new, s_new = [], []
    for l in range(DEPTH):
        lam_init = 0.8 - 0.6 * math.exp(-0.3 * l)
        w = (norm_mix[l], w_in[l], a_conv_w[l], a_conv_b[l], a_log[l], a_dt_bias[l], a_norm[l],
             b_lambda[l], b_norm[l], c_w[l], c_scale[l], w_out[l],
             norm_ffn[l], ffn_up[l], ffn_conv_w[l], ffn_conv_b[l], ffn_down[l])
        yp, sp = trunk_layer(
            yp, 0,
            jnp.zeros((nbp, A_HEADS, A_DK, A_DV), jnp.float32),
            jnp.zeros((nbp, A_CONV - 1, 3 * A_WIDTH), x_prompt.dtype),
            None, None,
            jnp.zeros((nbp, C_POOL_BUF, C_WIDTH), x_prompt.dtype),
            jnp.zeros((nbp, FFN_CONV - 1, 2 * D_FF), x_prompt.dtype),
            *w, lam_init)
        ys, ss = trunk_layer(
            ys, PAST_LEN, state_delta[l], cache_qkv_conv[l], cache_k[l], cache_v[l],
            cache_pool[l], cache_ffn_conv[l], *w, lam_init)
        p_new.append(sp)
        s_new.append(ss)
    y_prompt = rmsnorm(yp, norm_final)
    y_sample = rmsnorm(ys, norm_final)
    p_delta, p_conv, p_k, p_v, p_pool, p_ffn = [jnp.stack(t) for t in zip(*p_new)]
    s_delta, s_conv, s_k, s_v, s_pool, s_ffn = [jnp.stack(t) for t in zip(*s_new)]
    return (y_prompt, y_sample, p_delta, s_delta, p_conv, s_conv, p_k, s_k, p_v, s_v, p_pool, s_pool, p_ffn, s_ffn)
```

```cpp
#include <hip/hip_runtime.h>
#include <hip/hip_cooperative_groups.h>
#include <cstdio>
#include <cstdint>
namespace cg = cooperative_groups;

#define LAS __attribute__((address_space(3)))
typedef unsigned short bf16_t;
typedef short bf16x8 __attribute__((ext_vector_type(8)));
typedef short bf16x4 __attribute__((ext_vector_type(4)));
typedef float f32x4 __attribute__((ext_vector_type(4)));
typedef unsigned u32x4 __attribute__((ext_vector_type(4)));
typedef unsigned u32x2 __attribute__((ext_vector_type(2)));

constexpr int D = 1024, TP = 32768, TSM = 1024, T = TP + TSM, SEQ = 2048;
constexpr int NPROJ = 4608, NPN = 4096, NMIX = 1536, NFF2 = 5632, NFF = 2816, INW = 4104;
constexpr float EPS = 1e-6f;
constexpr int C_BK = 1536, C_BV = 2048, C_CX = 2560, C_AZ = 3072, C_BQ = 3584, C_PO = 4096;
constexpr size_t O_YP = 0, O_YS = 33554432, O_PSD = 34603008, O_SSD = 36700160, O_PQC = 38797312, O_SQC = 38944768, O_PK = 39092224, O_SK = 72646656,
                 O_PV = 73695232, O_SV = 107249664, O_PPOOL = 108298240, O_SPOOL = 108544000, O_PFFN = 108789760, O_SFFN = 109150208;
constexpr size_t WS_CTL = 0, WS_BAR = 1024, WS_GB = 16384,
                 WS_WIN = WS_GB + (size_t)T * 8 * 4, WS_WOUT = WS_WIN + 2ull * 4096 * 1024 * 2, WS_WUP = WS_WOUT + 2ull * 1024 * 1536 * 2,
                 WS_WDN = WS_WUP + 2ull * 5632 * 1024 * 2, WS_CW = WS_WDN + 2ull * 1024 * 2816 * 2, WS_H = WS_CW + 2ull * 4 * 128 * 128 * 2,
                 WS_R2 = WS_H + (size_t)T * 1024 * 2, WS_QK = WS_R2 + (size_t)T * NPROJ * 2, WS_SIDE = WS_R2 + (size_t)T * NFF2 * 2, WS_DD = WS_SIDE,
                 WS_END = WS_SIDE + 1056ull * 2 * NFF2 * 2;
constexpr int LDS_BYTES = 155648;
constexpr int NTHREADS = 512;

struct Params { const float* in[26]; float* out; unsigned char* ws; };

__device__ __forceinline__ bf16_t f2bf(float f) { unsigned u = __float_as_uint(f); u += 0x7FFFu + ((u >> 16) & 1u); return (bf16_t)(u >> 16); }
__device__ __forceinline__ float bf2f(bf16_t b) { return __uint_as_float(((unsigned)b) << 16); }
typedef __bf16 bf16v2_t __attribute__((ext_vector_type(2)));
typedef float f32v2_t __attribute__((ext_vector_type(2)));
__device__ __forceinline__ unsigned pk2(float lo, float hi) { const f32v2_t f = {lo, hi}; const bf16v2_t r = __builtin_convertvector(f, bf16v2_t); return __builtin_bit_cast(unsigned, r); }
__device__ __forceinline__ float bflo(unsigned u) { return __uint_as_float(u << 16); }
__device__ __forceinline__ float bfhi(unsigned u) { return __uint_as_float(u & 0xFFFF0000u); }
__device__ __forceinline__ float siluf(float y) { return y * __builtin_amdgcn_rcpf(1.f + __expf(-y)); }
__device__ __forceinline__ int opaque_tid() { int t = threadIdx.x; asm volatile("" : "+v"(t)); return t; }
template <int CTRL> __device__ __forceinline__ float dpp_mov(float v) { return __builtin_bit_cast(float, __builtin_amdgcn_update_dpp(0, __builtin_bit_cast(int, v), CTRL, 0xF, 0xF, true)); }
__device__ __forceinline__ float row_sum16(float v) { v += dpp_mov<0xB1>(v); v += dpp_mov<0x4E>(v); v += dpp_mov<0x141>(v); v += dpp_mov<0x140>(v); return v; }
__device__ __forceinline__ float wave_sum64(float v) { v = row_sum16(v);
    return (__builtin_amdgcn_readlane(__builtin_bit_cast(int, v), 0) , __builtin_bit_cast(float, __builtin_amdgcn_readlane(__builtin_bit_cast(int, v), 0)) + __builtin_bit_cast(float, __builtin_amdgcn_readlane(__builtin_bit_cast(int, v), 16))
         + __builtin_bit_cast(float, __builtin_amdgcn_readlane(__builtin_bit_cast(int, v), 32)) + __builtin_bit_cast(float, __builtin_amdgcn_readlane(__builtin_bit_cast(int, v), 48))); }
#define MFMA16(a, b, c) __builtin_amdgcn_mfma_f32_16x16x32_bf16(a, b, c, 0, 0, 0)
__device__ __forceinline__ void unpack8(const u32x4 v, float* f) {
    f[0] = bflo(v.x); f[1] = bfhi(v.x); f[2] = bflo(v.y); f[3] = bfhi(v.y); f[4] = bflo(v.z); f[5] = bfhi(v.z); f[6] = bflo(v.w); f[7] = bfhi(v.w);
}

namespace pg8 {
constexpr int BM = 256, BK = 64, HALF = 128, HTB = HALF * BK * 2, STAGE_BYTES = 8 * HTB, NXCD = 8, WGM = 8;
__host__ __device__ __forceinline__ int lds_byte(int r, int c) { const int st = (r >> 4) * 2 + (c >> 5), rr = r & 15, cc = c & 31, ob = rr * 64 + cc * 2; return st * 1024 + (ob ^ (((ob >> 9) & 1) << 5)); }
__host__ __device__ __forceinline__ void stage_rc(int b, int& R, int& C) { const int st = b / 1024, sb = b % 1024, swz = sb ^ (((sb >> 9) & 1) << 5); R = (st >> 1) * 16 + swz / 64; C = (st & 1) * 32 + (swz % 64) / 2; }
__host__ __device__ __forceinline__ int perm32(int rho) { const int n = rho >> 4, i = rho & 15; return 8 * (i >> 2) + 4 * n + (i & 3); }
struct Unit { int pm, pn, k0, nt; };
struct Gemm { const bf16_t* A; const bf16_t* Bt; int M, N, K, lda; };
struct StaticOrder {
    int nM, nN, nwg, G, c, ntk, nslice, ntot;
    __device__ void init(int M, int N, int K, int G_, int c_, int split_rows) {
        nN = N / BM; G = G_; c = c_; ntk = K / BK;
        if (split_rows > 0) { nM = (M - split_rows) / BM; nslice = K / 256; nwg = nM * nN; ntot = nwg + (split_rows / BM) * nN * nslice; }
        else { nM = M / BM; nslice = 0; nwg = nM * nN; ntot = nwg; }
    }
    __device__ bool next(int i, Unit& u) const {
        const long L = (long)i * G + c; if (L >= ntot) return false;
        if (L >= nwg) { const int idx = (int)L - nwg, tile = idx / nslice, sl = idx - tile * nslice; u.pm = nM + tile / nN; u.pn = tile % nN; u.k0 = sl * 256; u.nt = 4; return true; }
        int wgid = (int)L; { const int q = nwg / NXCD, r = nwg % NXCD, xcd = wgid % NXCD, off = wgid / NXCD; wgid = (xcd < r ? xcd * (q + 1) : r * (q + 1) + (xcd - r) * q) + off; }
        const int nig = WGM * nN, gid = wgid / nig, fm = gid * WGM, gsz = (nM - fm) < WGM ? (nM - fm) : WGM;
        u.pm = fm + ((wgid % nig) % gsz); u.pn = (wgid % nig) / gsz; u.k0 = 0; u.nt = ntk; return true;
    }
};
__device__ __forceinline__ unsigned cvt_pk_bf16(float lo, float hi) { unsigned r; asm volatile("v_cvt_pk_bf16_f32 %0, %1, %2" : "=v"(r) : "v"(lo), "v"(hi)); return r; }

struct EpiAny;
__device__ __forceinline__ void run_epi(const EpiAny& E, const f32x4 (&acc)[2][2][4][2], const Unit& u, int wr, int wc, int fr, int fq);
__device__ __forceinline__ void gemm_phase(LAS unsigned char* lds, const Gemm g, const StaticOrder& S, const EpiAny& E, const bool perm) {
    const int tid = opaque_tid(), wid = __builtin_amdgcn_readfirstlane(tid >> 6), lane = tid & 63, wr = wid >> 2, wc = wid & 3, fr = lane & 15, fq = lane >> 4;
    const int K = g.K, lda = g.lda;
    unsigned voffA[2], voffB[2];
#pragma unroll
    for (int i = 0; i < 2; ++i) { int R, C; stage_rc(tid * 16 + i * 8192, R, C); const int Rb = perm ? ((R & ~31) + perm32(R & 31)) : R;
        voffA[i] = (unsigned)(R * lda + C) * 2u; voffB[i] = (unsigned)(Rb * K + C) * 2u; }
    const size_t kstep = (size_t)(BK * 2);
    const size_t hstepA = (size_t)HALF * lda * 2, hstepB = (size_t)HALF * K * 2;
    const size_t tstepA = 2 * hstepA, tstepB = 2 * hstepB;
    const unsigned ldsw = (unsigned)wid * 1024u;
    const int aoff = lds_byte(wr * 64 + fr, fq * 8), boff = lds_byte(wc * 32 + fr, fq * 8);
#define PG8_SA(b, h) (((b) * 2 + (h)) * HTB)
#define PG8_SB(b, h) ((4 + (b) * 2 + (h)) * HTB)
#define PG8_STAGE(bufoff, gbase, voff) do { _Pragma("unroll") for (int _i = 0; _i < 2; ++_i) \
        __builtin_amdgcn_global_load_lds((const unsigned*)((const char*)(gbase) + (voff)[_i]), (LAS unsigned*)(lds + (bufoff) + ldsw + _i * 8192), 16, 0, 0); } while (0)
#define PG8_LDA(dst, b, h) do { _Pragma("unroll") for (int m = 0; m < 4; ++m) _Pragma("unroll") for (int k = 0; k < 2; ++k) dst[m][k] = *(const LAS bf16x8*)(lds + PG8_SA(b, h) + aoff + m * 2048 + k * 1024); } while (0)
#define PG8_LDB(dst, b, h) do { _Pragma("unroll") for (int n = 0; n < 2; ++n) _Pragma("unroll") for (int k = 0; k < 2; ++k) dst[n][k] = *(const LAS bf16x8*)(lds + PG8_SB(b, h) + boff + n * 2048 + k * 1024); } while (0)
#define PG8_MMA(ai, bj, At, Bt) do { __builtin_amdgcn_s_setprio(1); _Pragma("unroll") for (int m = 0; m < 4; ++m) _Pragma("unroll") for (int n = 0; n < 2; ++n) _Pragma("unroll") for (int k = 0; k < 2; ++k) \
        acc[ai][bj][m][n] = __builtin_amdgcn_mfma_f32_16x16x32_bf16(Bt[n][k], At[m][k], acc[ai][bj][m][n], 0, 0, 0); __builtin_amdgcn_s_setprio(0); } while (0)
#define PG8_WAIT_V(n) asm volatile("s_waitcnt vmcnt(" #n ")" ::: "memory")
#define PG8_WAIT_L(n) asm volatile("s_waitcnt lgkmcnt(" #n ")" ::: "memory")
#define PG8_BAR __builtin_amdgcn_s_barrier()
#define PG8_SCHED __builtin_amdgcn_sched_barrier(0)
    Unit cur, nxt; int ui = 0;
    if (!S.next(0, cur)) return;
    f32x4 acc[2][2][4][2];
#pragma unroll
    for (int a = 0; a < 2; ++a)
#pragma unroll
        for (int b = 0; b < 2; ++b)
#pragma unroll
            for (int m = 0; m < 4; ++m)
#pragma unroll
                for (int n = 0; n < 2; ++n) acc[a][b][m][n] = (f32x4){0.f, 0.f, 0.f, 0.f};
    bf16x8 At[4][2], B0[2][2], B1[2][2];
    const char* cA = (const char*)g.A + (size_t)cur.pm * tstepA + (size_t)cur.k0 * 2; const char* cB = (const char*)g.Bt + (size_t)cur.pn * tstepB + (size_t)cur.k0 * 2;
    int nt = cur.nt;
    PG8_STAGE(PG8_SB(0, 0), cB, voffB); PG8_STAGE(PG8_SA(0, 0), cA, voffA); PG8_STAGE(PG8_SB(0, 1), cB + hstepB, voffB); PG8_STAGE(PG8_SA(0, 1), cA + hstepA, voffA);
    if (wr == 1) PG8_BAR;
    PG8_WAIT_V(4); PG8_BAR;
    PG8_STAGE(PG8_SB(1, 0), cB + kstep, voffB); PG8_STAGE(PG8_SA(1, 0), cA + kstep, voffA); PG8_STAGE(PG8_SB(1, 1), cB + hstepB + kstep, voffB);
    PG8_WAIT_V(6); PG8_BAR;
    for (;;) {
        const bool has_next = S.next(ui + 1, nxt);
        const char* nA = has_next ? (const char*)g.A + (size_t)nxt.pm * tstepA + (size_t)nxt.k0 * 2 : cA; const char* nB = has_next ? (const char*)g.Bt + (size_t)nxt.pn * tstepB + (size_t)nxt.k0 * 2 : cB;
        for (int t = 0; t < nt; t += 2) {
            const bool last = (t == nt - 2);
            const char* a1 = cA + (size_t)(t + 1) * kstep;
            const char* a2 = last ? nA : cA + (size_t)(t + 2) * kstep; const char* b2 = last ? nB : cB + (size_t)(t + 2) * kstep;
            const char* a3 = a2 + kstep; const char* b3 = b2 + kstep;
            PG8_LDB(B0, 0, 0); PG8_SCHED; PG8_LDA(At, 0, 0); PG8_STAGE(PG8_SA(1, 1), a1 + hstepA, voffA);
            PG8_WAIT_L(8); PG8_BAR; PG8_WAIT_L(0); PG8_MMA(0, 0, At, B0); PG8_BAR; PG8_SCHED;
            PG8_LDB(B1, 0, 1); PG8_STAGE(PG8_SB(0, 0), b2, voffB);
            PG8_BAR; PG8_WAIT_L(0); PG8_MMA(0, 1, At, B1); PG8_BAR;
            PG8_LDA(At, 0, 1); PG8_STAGE(PG8_SA(0, 0), a2, voffA);
            PG8_BAR; PG8_WAIT_L(0); PG8_MMA(1, 0, At, B0); PG8_BAR; PG8_SCHED;
            PG8_STAGE(PG8_SB(0, 1), b2 + hstepB, voffB);
            PG8_WAIT_V(6); PG8_BAR; PG8_MMA(1, 1, At, B1); PG8_BAR;
            PG8_LDB(B0, 1, 0); PG8_SCHED; PG8_LDA(At, 1, 0); PG8_STAGE(PG8_SA(0, 1), a2 + hstepA, voffA);
            PG8_WAIT_L(8); PG8_BAR; PG8_WAIT_L(0); PG8_MMA(0, 0, At, B0); PG8_BAR; PG8_SCHED;
            PG8_LDB(B1, 1, 1); PG8_STAGE(PG8_SB(1, 0), b3, voffB);
            PG8_BAR; PG8_WAIT_L(0); PG8_MMA(0, 1, At, B1); PG8_BAR;
            PG8_LDA(At, 1, 1); PG8_STAGE(PG8_SA(1, 0), a3, voffA);
            PG8_BAR; PG8_WAIT_L(0); PG8_MMA(1, 0, At, B0); PG8_BAR; PG8_SCHED;
            PG8_STAGE(PG8_SB(1, 1), b3 + hstepB, voffB);
            PG8_WAIT_V(6); PG8_BAR; PG8_MMA(1, 1, At, B1); PG8_BAR;
        }
        run_epi(E, acc, cur, wr, wc, fr, fq);
        if (!has_next) break;
#pragma unroll
        for (int a = 0; a < 2; ++a)
#pragma unroll
            for (int b = 0; b < 2; ++b)
#pragma unroll
                for (int m = 0; m < 4; ++m)
#pragma unroll
                    for (int n = 0; n < 2; ++n) acc[a][b][m][n] = (f32x4){0.f, 0.f, 0.f, 0.f};
        cur = nxt; cA = nA; cB = nB; nt = cur.nt; ++ui;
    }
    PG8_WAIT_V(0);
    if (wr == 0) PG8_BAR;
    PG8_BAR;
#undef PG8_SA
#undef PG8_SB
#undef PG8_STAGE
#undef PG8_LDA
#undef PG8_LDB
#undef PG8_MMA
#undef PG8_WAIT_V
#undef PG8_WAIT_L
#undef PG8_BAR
#undef PG8_SCHED
}

struct EpiAny {
    int mode; int l; void* p0; void* p1; float* out; int aux;
    __device__ __forceinline__ void operator()(const f32x4 (&acc)[2][2][4][2], const Unit& u, int wr, int wc, int fr, int fq) const {
        const int row0 = u.pm * BM + wr * 64 + fr;
        if (mode == 1) {
            const int col0 = u.pn * BM + wc * 32 + 4 * fq;
            const float* res = (const float*)p0;
#pragma unroll
            for (int ai = 0; ai < 2; ++ai)
#pragma unroll
                for (int m = 0; m < 4; ++m) {
                    const size_t ro = (size_t)(row0 + ai * HALF + m * 16) * D + col0;
#pragma unroll
                    for (int bj = 0; bj < 2; ++bj)
#pragma unroll
                        for (int n = 0; n < 2; ++n) {
                            float* o = out + ro + bj * HALF + n * 16;
                            if (u.nt == 4) {
                                const int rs = row0 + ai * HALF + m * 16 - TP, cs = col0 + bj * HALF + n * 16;
                                *(f32x4*)((char*)p1 + (size_t)((u.k0 >> 8) * TSM + rs) * (size_t)aux + (size_t)cs * 4) = acc[ai][bj][m][n];
                            } else { const f32x4 r = *(const f32x4*)(res + ro + bj * HALF + n * 16); *(f32x4*)o = acc[ai][bj][m][n] + r; }
                        }
                    __builtin_amdgcn_sched_barrier(0);
                }
        } else if (mode == 0) {
            bf16_t* proj = (bf16_t*)p0;
#pragma unroll
            for (int bj = 0; bj < 2; ++bj) {
                const int cb = u.pn * BM + bj * HALF;
                const int col0 = cb + wc * 32 + 8 * fq;
                const bool iskv = (cb >= C_BK) && (cb < C_CX);
                const bool isv = cb >= C_BV;
                float* kvdst = nullptr;
                if (iskv) { const bool pr = u.pm * BM < TP; const size_t off = pr ? ((isv ? O_PV : O_PK) + (size_t)l * 16777216 + (size_t)row0 * 512) : ((isv ? O_SV : O_SK) + (size_t)l * 524288 + (size_t)(row0 - TP) * 512); kvdst = out + off; }
                const int cc = col0 - (isv ? C_BV : C_BK);
#pragma unroll
                for (int ai = 0; ai < 2; ++ai)
#pragma unroll
                    for (int m = 0; m < 4; ++m) {
                        const int ro = ai * HALF + m * 16;
                        const f32x4 v0 = acc[ai][bj][m][0], v1 = acc[ai][bj][m][1];
                        u32x4 o; o.x = cvt_pk_bf16(v0[0], v0[1]); o.y = cvt_pk_bf16(v0[2], v0[3]); o.z = cvt_pk_bf16(v1[0], v1[1]); o.w = cvt_pk_bf16(v1[2], v1[3]);
                        *(u32x4*)(proj + (size_t)(row0 + ro) * NPROJ + col0) = o;
                        if (iskv) { float* dst = kvdst + (size_t)ro * 512 + cc; __builtin_nontemporal_store(v0, (f32x4*)dst); __builtin_nontemporal_store(v1, (f32x4*)(dst + 4)); }
                    }
            }
        } else {
            bf16_t* ub = (bf16_t*)p0; bf16_t* side = (bf16_t*)p1;
#pragma unroll
            for (int bj = 0; bj < 2; ++bj) {
                const int col0 = u.pn * BM + bj * HALF + wc * 32 + 8 * fq;
#pragma unroll
                for (int ai = 0; ai < 2; ++ai)
#pragma unroll
                    for (int m = 0; m < 4; ++m) {
                        const int row = row0 + ai * HALF + m * 16;
                        const f32x4 v0 = acc[ai][bj][m][0], v1 = acc[ai][bj][m][1];
                        u32x4 o; o.x = cvt_pk_bf16(v0[0], v0[1]); o.y = cvt_pk_bf16(v0[2], v0[3]); o.z = cvt_pk_bf16(v1[0], v1[1]); o.w = cvt_pk_bf16(v1[2], v1[3]);
                        *(u32x4*)(ub + (size_t)row * NFF2 + col0) = o;
                        if ((m & 1) && fr >= 14) {
                            const int rr = fr - 14;
                            *(u32x4*)(side + ((size_t)(row >> 5) * 2 + rr) * NFF2 + col0) = o;
                            float* dst = nullptr;
                            if (row < TP) { if ((row & 2047) >= 2046) dst = out + O_PFFN + (size_t)l * 180224 + ((size_t)(row >> 11) * 2 + rr) * NFF2 + col0; }
                            else if (((row - TP) & 63) >= 62) dst = out + O_SFFN + (size_t)l * 180224 + ((size_t)((row - TP) >> 6) * 2 + rr) * NFF2 + col0;
                            if (dst) { *(f32x4*)dst = v0; *(f32x4*)(dst + 4) = v1; }
                        }
                    }
            }
        }
    }
};
__device__ __forceinline__ void run_epi(const EpiAny& E, const f32x4 (&acc)[2][2][4][2], const Unit& u, int wr, int wc, int fr, int fq) { E(acc, u, wr, wc, fr, fq); }
}

__device__ __forceinline__ void transpose_tile(const float* __restrict__ src, int ldsrc, bf16_t* __restrict__ dst, int lddst, int k0, int n0d, int n0s, float* tile, const int tid) {
#pragma unroll
    for (int i = 0; i < 8; ++i) { const int idx = tid + 512 * i, kk = idx >> 6, nn = idx & 63; tile[kk * 65 + nn] = src[(size_t)(k0 + kk) * ldsrc + n0s + nn]; }
    __syncthreads();
#pragma unroll
    for (int i = 0; i < 4; ++i) { const int idx = tid + 512 * i, nn = idx >> 5, kp = idx & 31;
        *(unsigned*)(dst + (size_t)(n0d + nn) * lddst + k0 + 2 * kp) = pk2(tile[(2 * kp) * 65 + nn], tile[(2 * kp + 1) * 65 + nn]); }
    __syncthreads();
}
__device__ __forceinline__ void phase_weights(const Params& p, unsigned char* smem) {
    float* tile = (float*)smem; const int tid = opaque_tid();
    constexpr int N_IN = 16 * 64, N_OUT = 24 * 16, N_UP = 16 * 88, N_DN = 44 * 16, N_CW = 16, PER_L = N_IN + N_OUT + N_UP + N_DN + N_CW;
    for (int it = blockIdx.x; it < 2 * PER_L; it += gridDim.x) {
        const int l = it / PER_L; int r = it % PER_L;
        if (r < N_IN) { const int kb = r / 64, nb = r % 64, n0 = nb * 64;
            transpose_tile(p.in[9] + (size_t)l * 1024 * INW, INW, (bf16_t*)(p.ws + WS_WIN) + (size_t)l * 4096 * 1024, 1024, kb * 64, n0, n0 < 1536 ? n0 : (n0 < 2048 ? n0 + 1032 : (n0 < 2560 ? n0 + 1032 : (n0 < 3072 ? n0 + 1032 : (n0 < 3584 ? n0 - 1536 : n0 - 1528)))), tile, tid); continue; }
        r -= N_IN;
        if (r < N_OUT) { const int kb = r / 16, nb = r % 16;
            transpose_tile(p.in[19] + (size_t)l * 1536 * 1024, 1024, (bf16_t*)(p.ws + WS_WOUT) + (size_t)l * 1024 * 1536, 1536, kb * 64, nb * 64, nb * 64, tile, tid); continue; }
        r -= N_OUT;
        if (r < N_UP) { const int kb = r / 88, nb = r % 88;
            transpose_tile(p.in[21] + (size_t)l * 1024 * NFF2, NFF2, (bf16_t*)(p.ws + WS_WUP) + (size_t)l * NFF2 * 1024, 1024, kb * 64, nb * 64, nb * 64, tile, tid); continue; }
        r -= N_UP;
        if (r < N_DN) { const int kb = r / 16, nb = r % 16;
            transpose_tile(p.in[24] + (size_t)l * NFF * 1024, 1024, (bf16_t*)(p.ws + WS_WDN) + (size_t)l * 1024 * NFF, NFF, kb * 64, nb * 64, nb * 64, tile, tid); continue; }
        r -= N_DN;
        { const int gi = r >> 2, kb = (r >> 1) & 1, nb = r & 1;
            transpose_tile(p.in[17] + ((size_t)l * 4 + gi) * 16384, 128, (bf16_t*)(p.ws + WS_CW) + ((size_t)l * 4 + gi) * 16384, 128, kb * 64, nb * 64, nb * 64, tile, tid); }
    }
}

__device__ __forceinline__ void phase_norm(const Params& p, unsigned char* smem, int l, int mode, const int nsl = 0, const unsigned char* pbase = nullptr, const int ppitch = 0) {
    const int tid = opaque_tid(), lane = tid & 63, wave = tid >> 6;
    float* wab = (float*)smem;
    const float* gw = mode == 0 ? p.in[8] + l * 1024 : (mode == 1 ? p.in[20] + l * 1024 : p.in[25]);
    if (mode == 0) {
        const float* w = p.in[9] + (size_t)l * 1024 * INW;
        for (int idx = tid; idx < 8192; idx += 512) wab[idx] = w[(size_t)(idx >> 3) * INW + 2048 + (idx & 7)];
        __syncthreads();
    }
    f32x4 gv[4];
#pragma unroll
    for (int j = 0; j < 4; ++j) gv[j] = *(const f32x4*)(gw + 4 * (lane + 64 * j));
    bf16_t* h = (bf16_t*)(p.ws + WS_H);
    float* gb = (float*)(p.ws + WS_GB);
    const bool from_in = (mode == 0 && l == 0);
    for (int row = blockIdx.x * 8 + wave; row < T; row += gridDim.x * 8) {
        const float* xr = from_in ? (row < TP ? p.in[0] + (size_t)row * D : p.in[1] + (size_t)(row - TP) * D) : p.out + (size_t)row * D;
        f32x4 v[4]; float ss = 0.f;
#pragma unroll
        for (int j = 0; j < 4; ++j) { v[j] = *(const f32x4*)(xr + 4 * (lane + 64 * j)); ss += v[j][0] * v[j][0] + v[j][1] * v[j][1] + v[j][2] * v[j][2] + v[j][3] * v[j][3]; }
        ss = wave_sum64(ss);
        if (row >= TP) {
            if (from_in) {
#pragma unroll
                for (int j = 0; j < 4; ++j) *(f32x4*)(p.out + (size_t)row * D + 4 * (lane + 64 * j)) = v[j];
            } else if (nsl > 0) {
                for (int sl = 0; sl < nsl; ++sl) {
                    const unsigned char* pr = pbase + (size_t)(sl * TSM + row - TP) * (size_t)ppitch;
#pragma unroll
                    for (int j = 0; j < 4; ++j) v[j] += *(const f32x4*)(pr + 16 * (lane + 64 * j));
                }
                ss = 0.f;
#pragma unroll
                for (int j = 0; j < 4; ++j) { ss += v[j][0] * v[j][0] + v[j][1] * v[j][1] + v[j][2] * v[j][2] + v[j][3] * v[j][3];
                    if (mode != 2) *(f32x4*)(p.out + (size_t)row * D + 4 * (lane + 64 * j)) = v[j]; }
                ss = wave_sum64(ss);
            }
        }
        const float rstd = rsqrtf(ss * (1.f / D) + EPS);
#pragma unroll
        for (int j = 0; j < 4; ++j) v[j] = v[j] * rstd * gv[j];
        if (mode == 2) {
#pragma unroll
            for (int j = 0; j < 4; ++j) *(f32x4*)(p.out + (size_t)row * D + 4 * (lane + 64 * j)) = v[j];
            continue;
        }
#pragma unroll
        for (int j = 0; j < 4; ++j) { u32x2 o; o.x = pk2(v[j][0], v[j][1]); o.y = pk2(v[j][2], v[j][3]); *(u32x2*)(h + (size_t)row * D + 4 * (lane + 64 * j)) = o; }
        if (mode == 0) {
            float d8[8];
#pragma unroll
            for (int c = 0; c < 8; ++c) d8[c] = 0.f;
#pragma unroll
            for (int j = 0; j < 4; ++j)
#pragma unroll
                for (int i = 0; i < 4; ++i) { const int k = 4 * (lane + 64 * j) + i; const f32x4 w0 = *(const f32x4*)(wab + k * 8), w1 = *(const f32x4*)(wab + k * 8 + 4); const float hv = v[j][i];
                    d8[0] += hv * w0[0]; d8[1] += hv * w0[1]; d8[2] += hv * w0[2]; d8[3] += hv * w0[3]; d8[4] += hv * w1[0]; d8[5] += hv * w1[1]; d8[6] += hv * w1[2]; d8[7] += hv * w1[3]; }
#pragma unroll
            for (int c = 0; c < 8; ++c) d8[c] = wave_sum64(d8[c]);
            if (lane < 8) {
                float val = 0.f;
#pragma unroll
                for (int c = 0; c < 8; ++c) val = (lane == c) ? d8[c] : val;
                float res;
                if (lane < 4) { const float xx = val + p.in[13][l * 4 + lane]; const float sp = xx > 20.f ? xx : log1pf(expf(xx)); res = -expf(p.in[12][l * 4 + lane]) * sp; }
                else res = 1.f / (1.f + expf(-val));
                gb[(size_t)row * 8 + lane] = res;
            }
        }
    }
}

constexpr int DP_QB = 0, DP_KB = 17408, DP_KTT = 34816, DP_VU = 53248, DP_LM = 86016, DP_QKD = 102400, DP_SM = 111616;
__device__ __forceinline__ void delta_prep(const Params& p, unsigned char* smem, int l, int pi) {
    const int tid = opaque_tid(), lane = tid & 63, w = tid >> 6, fr = lane & 15, fq = lane >> 4;
    const bool prompt = pi < 2048;
    const int sid = prompt ? (pi >> 5) : (pi - 2048), n = prompt ? (pi & 31) : 0;
    const int b = sid >> 2, hh = sid & 3;
    const int rowbase = prompt ? b * SEQ : TP + b * 64, L = prompt ? SEQ : 64, t0 = n * 64;
    const bf16_t* proj = (const bf16_t*)(p.ws + WS_R2);
    const float* gb = (const float*)(p.ws + WS_GB);
    bf16_t* QB = (bf16_t*)(smem + DP_QB); bf16_t* KB = (bf16_t*)(smem + DP_KB); bf16_t* KTT = (bf16_t*)(smem + DP_KTT);
    float* VU = (float*)(smem + DP_VU); float* LM = (float*)(smem + DP_LM); bf16_t* QKD = (bf16_t*)(smem + DP_QKD);
    float* sG = (float*)(smem + DP_SM); float* sgam = sG + 64; float* sbeta = sG + 128; float* stail = sG + 192; float* sbg = sG + 256;
    const float* convw = p.in[10] + l * 6144; const float* convb = p.in[11] + l * 1536;
    const float* cbuf = p.in[3] + ((size_t)l * 16 + b) * 3 * 1536;
    u32x4 raw[6][4];
#pragma unroll
    for (int zp = 0; zp < 6; ++zp) {
        const int z = zp >> 1, item = tid + 512 * (zp & 1), row = item >> 4, seg = item & 15, cq = z * 512 + hh * 128 + seg * 8;
#pragma unroll
        for (int i = 0; i < 4; ++i) {
            const int tt = t0 + row - 3 + i;
            if (tt >= 0) raw[zp][i] = *(const u32x4*)(proj + (size_t)(rowbase + tt) * NPROJ + cq);
            else if (!prompt) { const f32x4 c0 = *(const f32x4*)(cbuf + (3 + tt) * 1536 + cq), c1 = *(const f32x4*)(cbuf + (3 + tt) * 1536 + cq + 4);
                raw[zp][i].x = pk2(c0[0], c0[1]); raw[zp][i].y = pk2(c0[2], c0[3]); raw[zp][i].z = pk2(c1[0], c1[1]); raw[zp][i].w = pk2(c1[2], c1[3]); }
            else raw[zp][i] = (u32x4){0u, 0u, 0u, 0u};
        }
    }
    if (tid < 64) {
        const float g = gb[(size_t)(rowbase + t0 + tid) * 8 + hh], be = gb[(size_t)(rowbase + t0 + tid) * 8 + 4 + hh];
        float G = g;
#pragma unroll
        for (int o = 1; o < 64; o <<= 1) { const float t = __shfl_up(G, o); if (lane >= o) G += t; }
        const float Gl = __shfl(G, 63);
        sG[tid] = G; sgam[tid] = __expf(G); sbeta[tid] = be; stail[tid] = __expf(Gl - G); sbg[tid] = be * __expf(G);
    }
    __syncthreads();
#pragma unroll
    for (int zp = 0; zp < 6; ++zp) {
        const int z = zp >> 1, item = tid + 512 * (zp & 1), row = item >> 4, seg = item & 15, cq = z * 512 + hh * 128 + seg * 8;
        float y[8];
        { const f32x4 b0 = *(const f32x4*)(convb + cq), b1 = *(const f32x4*)(convb + cq + 4); y[0] = b0[0]; y[1] = b0[1]; y[2] = b0[2]; y[3] = b0[3]; y[4] = b1[0]; y[5] = b1[1]; y[6] = b1[2]; y[7] = b1[3]; }
#pragma unroll
        for (int i = 0; i < 4; ++i) {
            float x[8]; unpack8(raw[zp][i], x);
            const f32x4 w0 = *(const f32x4*)(convw + i * 1536 + cq), w1 = *(const f32x4*)(convw + i * 1536 + cq + 4);
            y[0] += w0[0] * x[0]; y[1] += w0[1] * x[1]; y[2] += w0[2] * x[2]; y[3] += w0[3] * x[3]; y[4] += w1[0] * x[4]; y[5] += w1[1] * x[5]; y[6] += w1[2] * x[6]; y[7] += w1[3] * x[7];
        }
        float ss = 0.f;
#pragma unroll
        for (int e = 0; e < 8; ++e) { y[e] = siluf(y[e]); ss += y[e] * y[e]; }
        if (z < 2) {
            ss = row_sum16(ss);
            const float sc = rsqrtf(ss + EPS) * (z == 0 ? 0.08838834764831845f : 1.f);
#pragma unroll
            for (int e = 0; e < 8; ++e) y[e] *= sc;
            u32x4 o; o.x = pk2(y[0], y[1]); o.y = pk2(y[2], y[3]); o.z = pk2(y[4], y[5]); o.w = pk2(y[6], y[7]);
            *(u32x4*)((z == 0 ? QB : KB) + row * 136 + seg * 8) = o;
            if (z == 1) { const float tl = stail[row];
#pragma unroll
                for (int e = 0; e < 8; ++e) KTT[(seg * 8 + e) * 72 + row] = f2bf(y[e] * tl); }
        } else {
            const float be = sbeta[row];
            *(f32x4*)(VU + row * 128 + seg * 8) = (f32x4){y[0] * be, y[1] * be, y[2] * be, y[3] * be};
            *(f32x4*)(VU + row * 128 + seg * 8 + 4) = (f32x4){y[4] * be, y[5] * be, y[6] * be, y[7] * be};
        }
        __builtin_amdgcn_sched_barrier(0);
    }
    __syncthreads();
    {
        const int ct = w >> 1;
#pragma unroll
        for (int si = 0; si < 2; ++si) {
            const int st = 2 * (w & 1) + si;
            f32x4 akk = (f32x4){0.f, 0.f, 0.f, 0.f}, aqk = (f32x4){0.f, 0.f, 0.f, 0.f};
#pragma unroll
            for (int ks = 0; ks < 4; ++ks) {
                const bf16x8 xk = *(const bf16x8*)(KB + (16 * ct + fr) * 136 + 32 * ks + 8 * fq);
                const bf16x8 xq = *(const bf16x8*)(QB + (16 * ct + fr) * 136 + 32 * ks + 8 * fq);
                const bf16x8 yk = *(const bf16x8*)(KB + (16 * st + fr) * 136 + 32 * ks + 8 * fq);
                akk = MFMA16(xk, yk, akk); aqk = MFMA16(xq, yk, aqk);
            }
            const int s = 16 * st + fr; const float Gs = sG[s];
#pragma unroll
            for (int j = 0; j < 4; ++j) {
                const int c = 16 * ct + 4 * fq + j; const float dec = __expf(fminf(sG[c] - Gs, 0.f));
                LM[c * 64 + s] = (c > s) ? sbeta[c] * dec * akk[j] : 0.f;
                QKD[c * 72 + s] = f2bf((c >= s) ? dec * aqk[j] : 0.f);
            }
        }
    }
    __syncthreads();
    if (tid < 256) {
        float x[64];
        const bool isv = tid < 128; const int d = tid - 128;
        int vzero; asm volatile("v_mov_b32 %0, 0" : "=v"(vzero));
        const float* LMv = LM + vzero;
        if (isv) {
#pragma unroll
            for (int c = 0; c < 64; ++c) x[c] = VU[c * 128 + tid];
        } else {
#pragma unroll
            for (int c = 0; c < 64; ++c) x[c] = bf2f(KB[c * 136 + d]) * sbg[c];
        }
#pragma unroll
        for (int c = 1; c < 64; ++c) {
            float r0 = x[c], r1 = 0.f;
#pragma unroll
            for (int s4 = 0; s4 < (c + 3) / 4; ++s4) {
                const f32x4 lv = *(const f32x4*)(LMv + c * 64 + 4 * s4);
                r0 -= lv[0] * x[4 * s4]; r1 -= lv[1] * x[4 * s4 + 1]; r0 -= lv[2] * x[4 * s4 + 2]; r1 -= lv[3] * x[4 * s4 + 3];
            }
            x[c] = r0 + r1;
            if ((c & 3) == 3) __builtin_amdgcn_sched_barrier(0);
        }
        if (isv) {
#pragma unroll
            for (int c = 0; c < 64; ++c) VU[c * 128 + tid] = x[c];
        } else {
#pragma unroll
            for (int c = 0; c < 64; ++c) KB[c * 136 + d] = f2bf(x[c]);
        }
    }
    __syncthreads();
    {
        bf16_t* recWU = (bf16_t*)(p.ws + WS_H) + (size_t)pi * 16384;
        bf16_t* recQK = (bf16_t*)(p.ws + WS_QK) + (size_t)pi * 16384;
        unsigned char* recD = p.ws + WS_DD + (size_t)pi * 8448;
#pragma unroll
        for (int k = 0; k < 2; ++k) {
            const int idx = tid + 512 * k, row = idx >> 4, sg = idx & 15;
            *(u32x4*)(recWU + row * 128 + sg * 8) = *(const u32x4*)(KB + row * 136 + sg * 8);
            const f32x4 u0 = *(const f32x4*)(VU + row * 128 + sg * 8), u1 = *(const f32x4*)(VU + row * 128 + sg * 8 + 4);
            u32x4 o; o.x = pk2(u0[0], u0[1]); o.y = pk2(u0[2], u0[3]); o.z = pk2(u1[0], u1[1]); o.w = pk2(u1[2], u1[3]);
            *(u32x4*)(recWU + 8192 + row * 128 + sg * 8) = o;
            *(u32x4*)(recQK + row * 128 + sg * 8) = *(const u32x4*)(QB + row * 136 + sg * 8);
            const int r2 = idx >> 3, s8 = idx & 7;
            *(u32x4*)(recQK + 8192 + r2 * 64 + s8 * 8) = *(const u32x4*)(KTT + r2 * 72 + s8 * 8);
        }
        { const int r2 = tid >> 3, s8 = tid & 7; *(u32x4*)((bf16_t*)recD + r2 * 64 + s8 * 8) = *(const u32x4*)(QKD + r2 * 72 + s8 * 8); }
        if (tid < 64) ((float*)(recD + 8192))[tid] = sgam[tid];
        if (n == (prompt ? 31 : 0)) {
            float* co = p.out + (prompt ? O_PQC : O_SQC) + ((size_t)l * 16 + b) * 3 * 1536;
            for (int idx = tid; idx < 1152; idx += 512) { const int r = idx / 384, rem = idx % 384, z = rem >> 7, c = rem & 127;
                co[r * 1536 + z * 512 + hh * 128 + c] = bf2f(proj[(size_t)(rowbase + L - 3 + r) * NPROJ + z * 512 + hh * 128 + c]); }
        }
    }
}

constexpr int D2_QB = 0, D2_KB = 18432, D2_VU = 35840, D2_LM = 53248, D2_SM = 69632, D2_HALF = 70912;
__device__ __forceinline__ void delta_prep2(const Params& p, unsigned char* smem, int l, int piA, int piB) {
    const int tid = opaque_tid(), half = __builtin_amdgcn_readfirstlane(tid >> 8), t = tid & 255, lane = t & 63, wl = t >> 6, fr = lane & 15, fq = lane >> 4;
    const int pi = (half && piB >= 0) ? piB : piA;
    const bool prompt = pi < 2048;
    const int sid = prompt ? (pi >> 5) : (pi - 2048), n = prompt ? (pi & 31) : 0;
    const int b = sid >> 2, hh = sid & 3;
    const int rowbase = prompt ? b * SEQ : TP + b * 64, L = prompt ? SEQ : 64, t0 = n * 64;
    const bf16_t* proj = (const bf16_t*)(p.ws + WS_R2);
    const float* gb = (const float*)(p.ws + WS_GB);
    unsigned char* sb = smem + half * D2_HALF;
    bf16_t* QB = (bf16_t*)(sb + D2_QB); bf16_t* KTT = QB; bf16_t* KB = (bf16_t*)(sb + D2_KB); bf16_t* VUb = (bf16_t*)(sb + D2_VU); float* LM = (float*)(sb + D2_LM);
    float* sG = (float*)(sb + D2_SM); float* sgam = sG + 64; float* sbeta = sG + 128; float* stail = sG + 192; float* sbg = sG + 256;
    const float* convw = p.in[10] + l * 6144; const float* convb = p.in[11] + l * 1536;
    const float* cbuf = p.in[3] + ((size_t)l * 16 + b) * 3 * 1536;
    bf16_t* recWU = (bf16_t*)(p.ws + WS_H) + (size_t)pi * 16384;
    bf16_t* recQK = (bf16_t*)(p.ws + WS_QK) + (size_t)pi * 16384;
    unsigned char* recD = p.ws + WS_DD + (size_t)pi * 8448;
    if (t < 64) {
        const float g = gb[(size_t)(rowbase + t0 + t) * 8 + hh], be = gb[(size_t)(rowbase + t0 + t) * 8 + 4 + hh];
        float G = g;
#pragma unroll
        for (int o = 1; o < 64; o <<= 1) { const float tt = __shfl_up(G, o); if (lane >= o) G += tt; }
        const float Gl = __shfl(G, 63);
        sG[t] = G; sgam[t] = __expf(G); sbeta[t] = be; stail[t] = __expf(Gl - G); sbg[t] = be * __expf(G);
        ((float*)(recD + 8192))[t] = __expf(G);
    }
    __syncthreads();
    auto load_raw = [&](const int z, u32x4 (&raw)[4][4]) {
#pragma unroll
        for (int k = 0; k < 4; ++k) {
            const int item = t + 256 * k, row = item >> 4, seg = item & 15, cq = z * 512 + hh * 128 + seg * 8;
#pragma unroll
            for (int i = 0; i < 4; ++i) {
                const int tt = t0 + row - 3 + i;
                if (tt >= 0) raw[k][i] = *(const u32x4*)(proj + (size_t)(rowbase + tt) * NPROJ + cq);
                else if (!prompt) { const f32x4 c0 = *(const f32x4*)(cbuf + (3 + tt) * 1536 + cq), c1 = *(const f32x4*)(cbuf + (3 + tt) * 1536 + cq + 4);
                    raw[k][i].x = pk2(c0[0], c0[1]); raw[k][i].y = pk2(c0[2], c0[3]); raw[k][i].z = pk2(c1[0], c1[1]); raw[k][i].w = pk2(c1[2], c1[3]); }
                else raw[k][i] = (u32x4){0u, 0u, 0u, 0u};
            }
        }
    };
    auto conv_tensor = [&](const int z, const u32x4 (&raw)[4][4]) {
#pragma unroll
        for (int k = 0; k < 4; ++k) {
            const int item = t + 256 * k, row = item >> 4, seg = item & 15, cq = z * 512 + hh * 128 + seg * 8;
            float y[8];
            { const f32x4 b0 = *(const f32x4*)(convb + cq), b1 = *(const f32x4*)(convb + cq + 4); y[0] = b0[0]; y[1] = b0[1]; y[2] = b0[2]; y[3] = b0[3]; y[4] = b1[0]; y[5] = b1[1]; y[6] = b1[2]; y[7] = b1[3]; }
#pragma unroll
            for (int i = 0; i < 4; ++i) {
                float x[8]; unpack8(raw[k][i], x);
                const f32x4 w0 = *(const f32x4*)(convw + i * 1536 + cq), w1 = *(const f32x4*)(convw + i * 1536 + cq + 4);
                y[0] += w0[0] * x[0]; y[1] += w0[1] * x[1]; y[2] += w0[2] * x[2]; y[3] += w0[3] * x[3]; y[4] += w1[0] * x[4]; y[5] += w1[1] * x[5]; y[6] += w1[2] * x[6]; y[7] += w1[3] * x[7];
            }
            float ss = 0.f;
#pragma unroll
            for (int e = 0; e < 8; ++e) { y[e] = siluf(y[e]); ss += y[e] * y[e]; }
            if (z < 2) {
                ss = row_sum16(ss);
                const float sc = rsqrtf(ss + EPS) * (z == 0 ? 0.08838834764831845f : 1.f);
                u32x4 o; o.x = pk2(y[0] * sc, y[1] * sc); o.y = pk2(y[2] * sc, y[3] * sc); o.z = pk2(y[4] * sc, y[5] * sc); o.w = pk2(y[6] * sc, y[7] * sc);
                *(u32x4*)((z == 0 ? QB : KB) + row * 136 + seg * 8) = o;
            } else {
                const float be = sbeta[row];
                u32x4 o; o.x = pk2(y[0] * be, y[1] * be); o.y = pk2(y[2] * be, y[3] * be); o.z = pk2(y[4] * be, y[5] * be); o.w = pk2(y[6] * be, y[7] * be);
                *(u32x4*)(VUb + row * 136 + seg * 8) = o;
            }
        }
    };
    {
        u32x4 rawA[4][4], rawB[4][4];
        load_raw(0, rawA); load_raw(1, rawB);
        conv_tensor(0, rawA);
        load_raw(2, rawA);
        conv_tensor(1, rawB);
        conv_tensor(2, rawA);
    }
    __syncthreads();
    {
        const int ct = wl; bf16_t* qkd_g = (bf16_t*)recD;
#pragma unroll 1
        for (int st = 0; st < 4; ++st) {
            f32x4 akk = (f32x4){0.f, 0.f, 0.f, 0.f}, aqk = (f32x4){0.f, 0.f, 0.f, 0.f};
#pragma unroll
            for (int ks = 0; ks < 4; ++ks) {
                const bf16x8 xk = *(const bf16x8*)(KB + (16 * ct + fr) * 136 + 32 * ks + 8 * fq);
                const bf16x8 xq = *(const bf16x8*)(QB + (16 * ct + fr) * 136 + 32 * ks + 8 * fq);
                const bf16x8 yk = *(const bf16x8*)(KB + (16 * st + fr) * 136 + 32 * ks + 8 * fq);
                akk = MFMA16(xk, yk, akk); aqk = MFMA16(xq, yk, aqk);
            }
            const int s = 16 * st + fr; const float Gs = sG[s];
#pragma unroll
            for (int j = 0; j < 4; ++j) {
                const int c = 16 * ct + 4 * fq + j; const float dec = __expf(fminf(sG[c] - Gs, 0.f));
                LM[c * 64 + s] = (c > s) ? sbeta[c] * dec * akk[j] : 0.f;
                qkd_g[c * 64 + s] = f2bf((c >= s) ? dec * aqk[j] : 0.f);
            }
        }
    }
    __syncthreads();
#pragma unroll
    for (int k = 0; k < 4; ++k) { const int idx = t + 256 * k, row = idx >> 4, sg = idx & 15; *(u32x4*)(recQK + row * 128 + sg * 8) = *(const u32x4*)(QB + row * 136 + sg * 8); }
    __syncthreads();
#pragma unroll
    for (int k = 0; k < 4; ++k) {
        const int item = t + 256 * k, row = item >> 4, seg = item & 15;
        float x[8]; unpack8(*(const u32x4*)(KB + row * 136 + seg * 8), x);
        const float tl = stail[row];
#pragma unroll
        for (int e = 0; e < 8; ++e) KTT[(seg * 8 + e) * 72 + row] = f2bf(x[e] * tl);
    }
    __syncthreads();
    int vzero; asm volatile("v_mov_b32 %0, 0" : "=v"(vzero));
    if (vzero == 0) {
        float x[64];
        const bool isv = t < 128; const int d = t - 128;
        const float* LMv = LM + vzero;
        bf16_t* col = isv ? (VUb + t) : (KB + d);
#pragma unroll
        for (int c = 0; c < 64; ++c) x[c] = bf2f(col[c * 136]) * (isv ? 1.f : sbg[c]);
#pragma unroll
        for (int c = 1; c < 64; ++c) {
            float r0 = x[c], r1 = 0.f;
#pragma unroll
            for (int s4 = 0; s4 < (c + 3) / 4; ++s4) {
                const f32x4 lv = *(const f32x4*)(LMv + c * 64 + 4 * s4);
                r0 -= lv[0] * x[4 * s4]; r1 -= lv[1] * x[4 * s4 + 1]; r0 -= lv[2] * x[4 * s4 + 2]; r1 -= lv[3] * x[4 * s4 + 3];
            }
            x[c] = r0 + r1;
            if ((c & 3) == 3) __builtin_amdgcn_sched_barrier(0);
        }
#pragma unroll
        for (int c = 0; c < 64; ++c) col[c * 136] = f2bf(x[c]);
    }
    __syncthreads();
#pragma unroll
    for (int k = 0; k < 4; ++k) {
        const int idx = t + 256 * k, row = idx >> 4, sg = idx & 15;
        *(u32x4*)(recWU + row * 128 + sg * 8) = *(const u32x4*)(KB + row * 136 + sg * 8);
        *(u32x4*)(recWU + 8192 + row * 128 + sg * 8) = *(const u32x4*)(VUb + row * 136 + sg * 8);
        const int r2 = idx >> 3, s8 = idx & 7;
        *(u32x4*)(recQK + 8192 + r2 * 64 + s8 * 8) = *(const u32x4*)(KTT + r2 * 72 + s8 * 8);
    }
    if (n == (prompt ? 31 : 0)) {
        float* co = p.out + (prompt ? O_PQC : O_SQC) + ((size_t)l * 16 + b) * 3 * 1536;
        for (int idx = t; idx < 1152; idx += 256) { const int r = idx / 384, rem = idx % 384, z = rem >> 7, c = rem & 127;
            co[r * 1536 + z * 512 + hh * 128 + c] = bf2f(proj[(size_t)(rowbase + L - 3 + r) * NPROJ + z * 512 + hh * 128 + c]); }
    }
}

constexpr int SC_WB = 0, SC_UB = 17408, SC_QB = 34816, SC_KTT = 52224, SC_QKD = 70656, SC_DT = 79872, SC_STB = 98304, SC_SM = 133120;
__device__ __forceinline__ void delta_scan(const Params& p, unsigned char* smem, int l, int sid) {
    const int tid = opaque_tid(), lane = tid & 63, w = tid >> 6, fr = lane & 15, fq = lane >> 4;
    const bool prompt = sid < 64;
    const int s2 = prompt ? sid : sid - 64, b = s2 >> 2, hh = s2 & 3;
    const int rowbase = prompt ? b * SEQ : TP + b * 64, nch = prompt ? 32 : 1, pi0 = prompt ? s2 * 32 : 2048 + s2;
    bf16_t* proj = (bf16_t*)(p.ws + WS_R2);
    bf16_t* WB = (bf16_t*)(smem + SC_WB); bf16_t* UB = (bf16_t*)(smem + SC_UB); bf16_t* QB = (bf16_t*)(smem + SC_QB); bf16_t* KTT = (bf16_t*)(smem + SC_KTT);
    bf16_t* QKD = (bf16_t*)(smem + SC_QKD); bf16_t* DT = (bf16_t*)(smem + SC_DT) + w * 16 * 72; bf16_t* STB = (bf16_t*)(smem + SC_STB);
    float* sgam = (float*)(smem + SC_SM); float* osq = sgam + 64;
    f32x4 accS[8];
    if (prompt) {
#pragma unroll
        for (int dt = 0; dt < 8; ++dt) accS[dt] = (f32x4){0.f, 0.f, 0.f, 0.f};
    } else {
        const float* s0 = p.in[2] + (((size_t)l * 16 + b) * 4 + hh) * 16384;
#pragma unroll
        for (int dt = 0; dt < 8; ++dt)
#pragma unroll
            for (int j = 0; j < 4; ++j) accS[dt][j] = s0[(16 * dt + 4 * fq + j) * 128 + 16 * w + fr];
    }
#pragma unroll
    for (int dt = 0; dt < 8; ++dt) { u32x2 o; o.x = pk2(accS[dt][0], accS[dt][1]); o.y = pk2(accS[dt][2], accS[dt][3]); *(u32x2*)(STB + (16 * w + fr) * 136 + 16 * dt + 4 * fq) = o; }
    u32x4 pre[9]; float pgam = 0.f; bf16_t zr[16];
    auto load_chunk = [&](int n) {
        const size_t pi = (size_t)(pi0 + n);
        const u32x4* wu = (const u32x4*)((const bf16_t*)(p.ws + WS_H) + pi * 16384);
        const u32x4* qk = (const u32x4*)((const bf16_t*)(p.ws + WS_QK) + pi * 16384);
        const unsigned char* dd = p.ws + WS_DD + pi * 8448;
#pragma unroll
        for (int k = 0; k < 4; ++k) pre[k] = wu[tid + 512 * k];
#pragma unroll
        for (int k = 0; k < 4; ++k) pre[4 + k] = qk[tid + 512 * k];
        pre[8] = ((const u32x4*)dd)[tid];
        if (tid < 64) pgam = ((const float*)(dd + 8192))[tid];
#pragma unroll
        for (int ct = 0; ct < 4; ++ct)
#pragma unroll
            for (int j = 0; j < 4; ++j) zr[ct * 4 + j] = proj[(size_t)(rowbase + n * 64 + 16 * ct + 4 * fq + j) * NPROJ + C_AZ + hh * 128 + 16 * w + fr];
    };
    load_chunk(0);
    const float an = p.in[14][l * 128 + 16 * w + fr];
    for (int n = 0; n < nch; ++n) {
        const int t0 = n * 64;
#pragma unroll
        for (int k = 0; k < 2; ++k) {
            const int idx = tid + 512 * k, row = idx >> 4, sg = idx & 15;
            *(u32x4*)(WB + row * 136 + sg * 8) = pre[k];
            *(u32x4*)(UB + row * 136 + sg * 8) = pre[2 + k];
            *(u32x4*)(QB + row * 136 + sg * 8) = pre[4 + k];
            const int r2 = idx >> 3, s8 = idx & 7;
            *(u32x4*)(KTT + r2 * 72 + s8 * 8) = pre[6 + k];
        }
        { const int r2 = tid >> 3, s8 = tid & 7; *(u32x4*)(QKD + r2 * 72 + s8 * 8) = pre[8]; }
        if (tid < 64) sgam[tid] = pgam;
        bf16_t zc[16];
#pragma unroll
        for (int i = 0; i < 16; ++i) zc[i] = zr[i];
        __syncthreads();
        if (n + 1 < nch) load_chunk(n + 1);
        f32x4 oacc[4];
        {
            bf16x8 ysb[4];
#pragma unroll
            for (int ks = 0; ks < 4; ++ks) ysb[ks] = *(const bf16x8*)(STB + (16 * w + fr) * 136 + 32 * ks + 8 * fq);
#pragma unroll
            for (int ct = 0; ct < 4; ++ct) {
                f32x4 a = (f32x4){0.f, 0.f, 0.f, 0.f};
#pragma unroll
                for (int ks = 0; ks < 4; ++ks) a = MFMA16(*(const bf16x8*)(WB + (16 * ct + fr) * 136 + 32 * ks + 8 * fq), ysb[ks], a);
                float dl[4];
#pragma unroll
                for (int j = 0; j < 4; ++j) dl[j] = bf2f(UB[(16 * ct + 4 * fq + j) * 136 + 16 * w + fr]) - a[j];
                u32x2 o; o.x = pk2(dl[0], dl[1]); o.y = pk2(dl[2], dl[3]);
                *(u32x2*)(DT + fr * 72 + 16 * ct + 4 * fq) = o;
            }
            asm volatile("s_waitcnt lgkmcnt(0)" ::: "memory");
            bf16x8 ydt[2];
#pragma unroll
            for (int ks = 0; ks < 2; ++ks) ydt[ks] = *(const bf16x8*)(DT + fr * 72 + 32 * ks + 8 * fq);
#pragma unroll
            for (int ct = 0; ct < 4; ++ct) {
                f32x4 a1 = (f32x4){0.f, 0.f, 0.f, 0.f}, a2 = (f32x4){0.f, 0.f, 0.f, 0.f};
#pragma unroll
                for (int ks = 0; ks < 4; ++ks) a1 = MFMA16(*(const bf16x8*)(QB + (16 * ct + fr) * 136 + 32 * ks + 8 * fq), ysb[ks], a1);
#pragma unroll
                for (int ks = 0; ks < 2; ++ks) a2 = MFMA16(*(const bf16x8*)(QKD + (16 * ct + fr) * 72 + 32 * ks + 8 * fq), ydt[ks], a2);
#pragma unroll
                for (int j = 0; j < 4; ++j) {
                    const float o = sgam[16 * ct + 4 * fq + j] * a1[j] + a2[j];
                    oacc[ct][j] = o;
                    const float sq = row_sum16(o * o);
                    if (fr == 0) osq[w * 64 + 16 * ct + 4 * fq + j] = sq;
                }
                __builtin_amdgcn_sched_barrier(0);
            }
            const float gl = sgam[63];
#pragma unroll
            for (int dt = 0; dt < 8; ++dt) {
                f32x4 a = accS[dt] * gl;
#pragma unroll
                for (int ks = 0; ks < 2; ++ks) a = MFMA16(*(const bf16x8*)(KTT + (16 * dt + fr) * 72 + 32 * ks + 8 * fq), ydt[ks], a);
                accS[dt] = a;
                u32x2 o; o.x = pk2(a[0], a[1]); o.y = pk2(a[2], a[3]);
                *(u32x2*)(STB + (16 * w + fr) * 136 + 16 * dt + 4 * fq) = o;
                if (dt & 1) __builtin_amdgcn_sched_barrier(0);
            }
        }
        __syncthreads();
#pragma unroll
        for (int ct = 0; ct < 4; ++ct)
#pragma unroll
            for (int j = 0; j < 4; ++j) {
                const int c = 16 * ct + 4 * fq + j;
                float tot = 0.f;
#pragma unroll
                for (int ww = 0; ww < 8; ++ww) tot += osq[ww * 64 + c];
                const float zz = bf2f(zc[ct * 4 + j]);
                proj[(size_t)(rowbase + t0 + c) * NPROJ + C_AZ + hh * 128 + 16 * w + fr] = f2bf(oacc[ct][j] * rsqrtf(tot * (1.f / 128.f) + EPS) * an * siluf(zz));
            }
    }
    {
        float* so = p.out + (prompt ? O_PSD : O_SSD) + (((size_t)l * 16 + b) * 4 + hh) * 16384;
#pragma unroll
        for (int dt = 0; dt < 8; ++dt)
#pragma unroll
            for (int j = 0; j < 4; ++j) so[(16 * dt + 4 * fq + j) * 128 + 16 * w + fr] = accS[dt][j];
    }
    __syncthreads();
}

constexpr int AT_KS = 0, AT_VT = 34816, AT_OB = 71680;
__device__ __forceinline__ void attn_item(const Params& p, unsigned char* smem, int l, bool prompt, int b, int hh, int qc, float lam, float lam_init) {
    const int tid = opaque_tid(), lane = tid & 63, w = tid >> 6, fr = lane & 15, fq = lane >> 4, map = w >> 2, rb = w & 3;
    const bf16_t* proj = (const bf16_t*)(p.ws + WS_R2);
    bf16_t* mixed = (bf16_t*)(p.ws + WS_R2);
    const int row0 = prompt ? b * SEQ + qc * 64 : TP + b * 64;
    const int nt = prompt ? qc + 1 : 33;
    const float* ck = p.in[4] + ((size_t)l * 16 + b) * 2048 * 512 + hh * 128;
    const float* cv = p.in[5] + ((size_t)l * 16 + b) * 2048 * 512 + hh * 128;
    bf16_t* Ks = (bf16_t*)(smem + AT_KS); bf16_t* Vt = (bf16_t*)(smem + AT_VT); float* ob = (float*)(smem + AT_OB);
    bf16x8 qf[2];
#pragma unroll
    for (int ks = 0; ks < 2; ++ks) qf[ks] = *(const bf16x8*)(proj + (size_t)(row0 + rb * 16 + fr) * NPROJ + C_BQ + hh * 128 + map * 64 + 32 * ks + 8 * fq);
    const int lkey = tid >> 3, lseg = tid & 7;
    const int vkp = tid >> 4, ves = tid & 15;
    u32x4 rk[2], rv[2];
    auto load_tile = [&](int t) {
        if (prompt || t == 32) {
            const size_t rbase = prompt ? (size_t)(b * SEQ + t * 64) : (size_t)(TP + b * 64);
            const bf16_t* src = proj + (rbase + lkey) * NPROJ + hh * 128 + lseg * 16;
            rk[0] = *(const u32x4*)(src + C_BK); rk[1] = *(const u32x4*)(src + C_BK + 8);
            const bf16_t* sv = proj + (rbase + 2 * vkp) * NPROJ + C_BV + hh * 128 + ves * 8;
            rv[0] = *(const u32x4*)sv; rv[1] = *(const u32x4*)(sv + NPROJ);
        } else {
            const size_t o = (size_t)(t * 64 + lkey) * 512 + lseg * 16;
#pragma unroll
            for (int i = 0; i < 2; ++i) {
                const f32x4 a = __builtin_nontemporal_load((const f32x4*)(ck + o + 8 * i)), c = __builtin_nontemporal_load((const f32x4*)(ck + o + 8 * i + 4));
                rk[i].x = pk2(a[0], a[1]); rk[i].y = pk2(a[2], a[3]); rk[i].z = pk2(c[0], c[1]); rk[i].w = pk2(c[2], c[3]);
                const size_t ov = (size_t)(t * 64 + 2 * vkp + i) * 512 + ves * 8;
                const f32x4 a2 = __builtin_nontemporal_load((const f32x4*)(cv + ov)), c2 = __builtin_nontemporal_load((const f32x4*)(cv + ov + 4));
                rv[i].x = pk2(a2[0], a2[1]); rv[i].y = pk2(a2[2], a2[3]); rv[i].z = pk2(c2[0], c2[1]); rv[i].w = pk2(c2[2], c2[3]);
            }
        }
    };
    auto store_tile = [&](int buf) {
        bf16_t* kd = Ks + buf * 64 * 136 + lkey * 136 + lseg * 16;
        *(u32x4*)kd = rk[0]; *(u32x4*)(kd + 8) = rk[1];
        unsigned* vd = (unsigned*)(Vt + buf * 128 * 72 + (ves * 8) * 72) + (vkp ^ (2 * ves));
        const unsigned a0 = rv[0].x, a1 = rv[0].y, a2 = rv[0].z, a3 = rv[0].w, b0 = rv[1].x, b1 = rv[1].y, b2 = rv[1].z, b3 = rv[1].w;
        vd[0 * 36] = __builtin_amdgcn_perm(b0, a0, 0x05040100u); vd[1 * 36] = __builtin_amdgcn_perm(b0, a0, 0x07060302u);
        vd[2 * 36] = __builtin_amdgcn_perm(b1, a1, 0x05040100u); vd[3 * 36] = __builtin_amdgcn_perm(b1, a1, 0x07060302u);
        vd[4 * 36] = __builtin_amdgcn_perm(b2, a2, 0x05040100u); vd[5 * 36] = __builtin_amdgcn_perm(b2, a2, 0x07060302u);
        vd[6 * 36] = __builtin_amdgcn_perm(b3, a3, 0x05040100u); vd[7 * 36] = __builtin_amdgcn_perm(b3, a3, 0x07060302u);
    };
    f32x4 oacc[8];
#pragma unroll
    for (int et = 0; et < 8; ++et) oacc[et] = (f32x4){0.f, 0.f, 0.f, 0.f};
    float m_run = -INFINITY, l_run = 0.f;
    const float cs = 0.125f * 1.4426950408889634f;
    load_tile(0); store_tile(0);
    __syncthreads();
    asm volatile("" : "+v"(qf[0]), "+v"(qf[1]));
    for (int t = 0; t < nt; ++t) {
        const int buf = t & 1;
        if (t + 1 < nt) load_tile(t + 1);
        const bf16_t* kb = Ks + buf * 64 * 136; const bf16_t* vb = Vt + buf * 128 * 72;
        f32x4 sacc[4];
#pragma unroll
        for (int kt = 0; kt < 4; ++kt) {
            f32x4 a = (f32x4){0.f, 0.f, 0.f, 0.f};
#pragma unroll
            for (int ks = 0; ks < 2; ++ks) a = MFMA16(*(const bf16x8*)(kb + (16 * kt + fr) * 136 + map * 64 + 32 * ks + 8 * fq), qf[ks], a);
            sacc[kt] = a;
        }
        float mx = sacc[0][0];
#pragma unroll
        for (int kt = 0; kt < 4; ++kt)
#pragma unroll
            for (int j = 0; j < 4; ++j) mx = fmaxf(mx, sacc[kt][j]);
        mx = fmaxf(mx, __shfl_xor(mx, 16)); mx = fmaxf(mx, __shfl_xor(mx, 32));
        const float m_new = fmaxf(m_run, mx);
        const float alpha = __builtin_amdgcn_exp2f((m_run - m_new) * cs);
        m_run = m_new;
        float psum = 0.f;
        bf16x8 pf[2];
#pragma unroll
        for (int ks = 0; ks < 2; ++ks) {
            float pv[8];
#pragma unroll
            for (int i = 0; i < 8; ++i) { pv[i] = __builtin_amdgcn_exp2f((sacc[2 * ks + (i >> 2)][i & 3] - m_new) * cs); psum += pv[i]; }
            u32x4 pk; pk.x = pk2(pv[0], pv[1]); pk.y = pk2(pv[2], pv[3]); pk.z = pk2(pv[4], pv[5]); pk.w = pk2(pv[6], pv[7]);
            pf[ks] = __builtin_bit_cast(bf16x8, pk);
        }
        l_run = l_run * alpha + psum;
#pragma unroll
        for (int et = 0; et < 8; ++et) {
            f32x4 a = oacc[et] * alpha;
#pragma unroll
            for (int ks = 0; ks < 2; ++ks) {
                const int sw = 2 * (2 * et + (fr >> 3));
                const bf16x4 v0 = *(const bf16x4*)(vb + (16 * et + fr) * 72 + 2 * ((16 * ks + 2 * fq) ^ sw));
                const bf16x4 v1 = *(const bf16x4*)(vb + (16 * et + fr) * 72 + 2 * ((16 * ks + 8 + 2 * fq) ^ sw));
                const bf16x8 vx = __builtin_shufflevector(v0, v1, 0, 1, 2, 3, 4, 5, 6, 7);
                a = MFMA16(vx, pf[ks], a);
            }
            oacc[et] = a;
        }
        if (t + 1 < nt) store_tile(buf ^ 1);
        __syncthreads();
    }
    float lt = l_run; lt += __shfl_xor(lt, 16); lt += __shfl_xor(lt, 32);
    const float inv = 1.f / lt;
    const int q = rb * 16 + fr;
    if (map == 1) {
#pragma unroll
        for (int et = 0; et < 8; ++et)
#pragma unroll
            for (int j = 0; j < 4; ++j) ob[q * 129 + 16 * et + 4 * fq + j] = oacc[et][j] * inv * lam;
    }
    __syncthreads();
    if (map == 0) {
        float ss = 0.f;
#pragma unroll
        for (int et = 0; et < 8; ++et)
#pragma unroll
            for (int j = 0; j < 4; ++j) { const float o = oacc[et][j] * inv - ob[q * 129 + 16 * et + 4 * fq + j]; oacc[et][j] = o; ss += o * o; }
        ss += __shfl_xor(ss, 16); ss += __shfl_xor(ss, 32);
        const float sc = rsqrtf(ss * (1.f / 128.f) + EPS) * (1.f - lam_init);
        const float* bn = p.in[16] + l * 128;
#pragma unroll
        for (int et = 0; et < 8; ++et) {
            const int e = 16 * et + 4 * fq; const f32x4 g4 = *(const f32x4*)(bn + e);
            u32x2 o; o.x = pk2(oacc[et][0] * sc * g4[0], oacc[et][1] * sc * g4[1]); o.y = pk2(oacc[et][2] * sc * g4[2], oacc[et][3] * sc * g4[3]);
            *(u32x2*)(mixed + (size_t)(row0 + q) * NPROJ + C_BQ + hh * 128 + e) = o;
        }
    }
}

constexpr int PL_XS = 0, PL_PB = 40448;
__device__ __forceinline__ void pool_item(const Params& p, unsigned char* smem, int l, int pt, int gi) {
    const int tid = opaque_tid(), lane = tid & 63, w = tid >> 6, fr = lane & 15, fq = lane >> 4;
    const bf16_t* proj = (const bf16_t*)(p.ws + WS_R2);
    bf16_t* mixed = (bf16_t*)(p.ws + WS_R2);
    const int r0 = pt * 64; const bool prompt = r0 < TP;
    const int b = prompt ? (r0 >> 11) : ((r0 - TP) >> 6), t0 = prompt ? (r0 & 2047) : 0;
    float* xs = (float*)(smem + PL_XS); bf16_t* pb = (bf16_t*)(smem + PL_PB);
    const float* cpool = p.in[6] + ((size_t)l * 16 + b) * 15 * 512 + gi * 128;
    {
        u32x4 raw[3]; f32x4 ca[3], cc[3];
#pragma unroll
        for (int k = 0; k < 3; ++k) {
            const int idx = tid + 512 * k, rr = idx >> 4, sg = idx & 15, tt = t0 + rr - 15;
            raw[k] = (u32x4){0u, 0u, 0u, 0u}; ca[k] = (f32x4){0.f, 0.f, 0.f, 0.f}; cc[k] = ca[k];
            if (idx < 79 * 16) {
                if (tt >= 0) raw[k] = *(const u32x4*)(proj + (size_t)(r0 + rr - 15) * NPROJ + C_CX + gi * 128 + sg * 8);
                else if (!prompt) { ca[k] = *(const f32x4*)(cpool + (15 + tt) * 512 + sg * 8); cc[k] = *(const f32x4*)(cpool + (15 + tt) * 512 + sg * 8 + 4); }
            }
        }
#pragma unroll
        for (int k = 0; k < 3; ++k) {
            const int idx = tid + 512 * k, rr = idx >> 4, sg = idx & 15, tt = t0 + rr - 15;
            if (idx < 79 * 16) {
                float x[8];
                if (tt >= 0) unpack8(raw[k], x);
                else { x[0] = ca[k][0]; x[1] = ca[k][1]; x[2] = ca[k][2]; x[3] = ca[k][3]; x[4] = cc[k][0]; x[5] = cc[k][1]; x[6] = cc[k][2]; x[7] = cc[k][3]; }
                *(f32x4*)(xs + rr * 128 + sg * 8) = (f32x4){x[0], x[1], x[2], x[3]}; *(f32x4*)(xs + rr * 128 + sg * 8 + 4) = (f32x4){x[4], x[5], x[6], x[7]};
            }
        }
    }
    __syncthreads();
    const int win = 2 << gi;
    {
        const int c = tid & 127, tf = (tid >> 7) * 16;
        float s = 0.f;
        for (int j = 0; j < win; ++j) s += xs[(15 + tf - j) * 128 + c];
#pragma unroll 4
        for (int tt = 0; tt < 16; ++tt) {
            const int t = tf + tt; const float xt = xs[(15 + t) * 128 + c];
            if (tt > 0) s += xt - xs[(15 + t - win) * 128 + c];
            const int cnt = prompt ? min(t0 + t + 1, win) : win;
            pb[t * 136 + c] = f2bf(s / (float)cnt - xt);
        }
    }
    if (!prompt || t0 == SEQ - 64) {
        float* po = p.out + (prompt ? O_PPOOL : O_SPOOL) + ((size_t)l * 16 + b) * 15 * 512 + gi * 128;
        for (int idx = tid; idx < 15 * 128; idx += 512) { const int rr = idx >> 7, c = idx & 127; po[rr * 512 + c] = xs[(15 + 49 + rr) * 128 + c]; }
    }
    __syncthreads();
    const bf16_t* cw = (const bf16_t*)(p.ws + WS_CW) + ((size_t)l * 4 + gi) * 16384;
    bf16x8 yf[4];
#pragma unroll
    for (int ks = 0; ks < 4; ++ks) yf[ks] = *(const bf16x8*)(cw + (16 * w + fr) * 128 + 32 * ks + 8 * fq);
    const f32x4 sc4 = *(const f32x4*)(p.in[18] + l * 512 + gi * 128 + 16 * w + 4 * fq);
#pragma unroll
    for (int tt = 0; tt < 4; ++tt) {
        f32x4 a = (f32x4){0.f, 0.f, 0.f, 0.f};
#pragma unroll
        for (int ks = 0; ks < 4; ++ks) a = MFMA16(yf[ks], *(const bf16x8*)(pb + (16 * tt + fr) * 136 + 32 * ks + 8 * fq), a);
        u32x2 o; o.x = pk2(a[0] * sc4[0], a[1] * sc4[1]); o.y = pk2(a[2] * sc4[2], a[3] * sc4[3]);
        *(u32x2*)(mixed + (size_t)(r0 + 16 * tt + fr) * NPROJ + C_PO + gi * 128 + 16 * w + 4 * fq) = o;
    }
}

constexpr int N_PREP = 1056, N_PL = 2112, N_AS = 64, N_AP = 2048, N_AP_A = 0;
__device__ __forceinline__ void phase_mix(const Params& p, unsigned char* smem, int l, const bool second) {
    const int tid = opaque_tid();
    const float lam_init = (l == 0) ? 0.2f : 0.35550906759096924f;
    float lam;
    { const float* bl = p.in[15] + l * 256; float s1 = 0.f, s2 = 0.f;
        for (int i = 0; i < 64; ++i) { s1 += bl[i] * bl[64 + i]; s2 += bl[128 + i] * bl[192 + i]; }
        lam = expf(s1) - expf(s2) + lam_init; }
    if (second) { for (int sid = blockIdx.x; sid < 128; sid += gridDim.x) delta_scan(p, smem, l, sid); }
    unsigned* ctr = (unsigned*)(p.ws + WS_CTL) + l * 2 + (second ? 1 : 0);
    int* s_item = (int*)(smem + LDS_BYTES - 16);
    const int nitems = second ? (N_AP - N_AP_A) : (N_PREP + N_AS + N_AP_A + N_PL);
    for (;;) {
        __syncthreads();
        if (tid == 0) *s_item = (int)atomicAdd(ctr, 1u);
        __syncthreads();
        int item = *s_item;
        if (item >= nitems) break;
        if (second) { item += N_AP_A; const int qc = 31 - (item >> 6), bh = item & 63; attn_item(p, smem, l, true, bh >> 2, bh & 3, qc, lam, lam_init); continue; }
        if (item < N_AS) { attn_item(p, smem, l, false, item >> 2, item & 3, 0, lam, lam_init); continue; }
        item -= N_AS;
        if (item < N_PREP) { const int i0 = 2 * item, i1 = 2 * item + 1, c0 = i0 >> 6, q0 = i0 & 63, c1 = i1 >> 6, q1 = i1 & 63;
            delta_prep2(p, smem, l, c0 < 32 ? q0 * 32 + c0 : 2048 + q0, c1 < 32 ? q1 * 32 + c1 : 2048 + q1); continue; }
        item -= N_PREP;
        if (item < N_AP_A) { const int qc = 31 - (item >> 6), bh = item & 63; attn_item(p, smem, l, true, bh >> 2, bh & 3, qc, lam, lam_init); continue; }
        item -= N_AP_A;
        pool_item(p, smem, l, item >> 2, item & 3);
    }
}

__device__ __forceinline__ void phase_ffnconv(const Params& p, int l) {
    bf16_t* u = (bf16_t*)(p.ws + WS_R2); const bf16_t* side = (const bf16_t*)(p.ws + WS_SIDE);
    const float* cw = p.in[22] + l * 3 * NFF2; const float* cb = p.in[23] + l * NFF2;
    const int nitems = 1056 * 352;
    const int tid0 = opaque_tid();
    for (int item = blockIdx.x * NTHREADS + tid0; item < nitems; item += gridDim.x * NTHREADS) {
        const int seg = item / 352, j = (item % 352) * 8;
        float wg[3][8], wv[3][8], bg[8], bv[8];
#pragma unroll
        for (int i = 0; i < 3; ++i) {
            const f32x4 a0 = *(const f32x4*)(cw + i * NFF2 + j), a1 = *(const f32x4*)(cw + i * NFF2 + j + 4), c0 = *(const f32x4*)(cw + i * NFF2 + NFF + j), c1 = *(const f32x4*)(cw + i * NFF2 + NFF + j + 4);
#pragma unroll
            for (int e = 0; e < 4; ++e) { wg[i][e] = a0[e]; wg[i][4 + e] = a1[e]; wv[i][e] = c0[e]; wv[i][4 + e] = c1[e]; }
        }
        { const f32x4 a0 = *(const f32x4*)(cb + j), a1 = *(const f32x4*)(cb + j + 4), c0 = *(const f32x4*)(cb + NFF + j), c1 = *(const f32x4*)(cb + NFF + j + 4);
#pragma unroll
            for (int e = 0; e < 4; ++e) { bg[e] = a0[e]; bg[4 + e] = a1[e]; bv[e] = c0[e]; bv[4 + e] = c1[e]; } }
        float g1[8], g2[8], v1[8], v2[8];
        const int r0 = seg * 32;
        if (r0 >= TP && ((r0 - TP) & 63) == 0) {
            const float* c = p.in[7] + ((size_t)l * 16 + ((r0 - TP) >> 6)) * 2 * NFF2;
#pragma unroll
            for (int e = 0; e < 8; ++e) { g1[e] = c[j + e]; v1[e] = c[NFF + j + e]; g2[e] = c[NFF2 + j + e]; v2[e] = c[NFF2 + NFF + j + e]; }
        } else if (r0 < TP && (r0 & 2047) == 0) {
#pragma unroll
            for (int e = 0; e < 8; ++e) { g1[e] = 0.f; g2[e] = 0.f; v1[e] = 0.f; v2[e] = 0.f; }
        } else {
            const bf16_t* sd = side + (size_t)(seg - 1) * 2 * NFF2;
            unpack8(*(const u32x4*)(sd + j), g1); unpack8(*(const u32x4*)(sd + NFF + j), v1); unpack8(*(const u32x4*)(sd + NFF2 + j), g2); unpack8(*(const u32x4*)(sd + NFF2 + NFF + j), v2);
        }
        bf16_t* ur = u + (size_t)r0 * NFF2 + j;
#pragma unroll 4
        for (int r = 0; r < 32; ++r) {
            float g3[8], v3[8];
            unpack8(__builtin_nontemporal_load((const u32x4*)(ur + (size_t)r * NFF2)), g3); unpack8(__builtin_nontemporal_load((const u32x4*)(ur + (size_t)r * NFF2 + NFF)), v3);
            float hh[8];
#pragma unroll
            for (int e = 0; e < 8; ++e) {
                const float cg = bg[e] + wg[0][e] * g1[e] + wg[1][e] * g2[e] + wg[2][e] * g3[e], cv = bv[e] + wv[0][e] * v1[e] + wv[1][e] * v2[e] + wv[2][e] * v3[e];
                hh[e] = siluf(cg) * cv; g1[e] = g2[e]; g2[e] = g3[e]; v1[e] = v2[e]; v2[e] = v3[e];
            }
            u32x4 o; o.x = pk2(hh[0], hh[1]); o.y = pk2(hh[2], hh[3]); o.z = pk2(hh[4], hh[5]); o.w = pk2(hh[6], hh[7]);
            *(u32x4*)(ur + (size_t)r * NFF2) = o;
        }
    }
}

template <int s> __device__ __forceinline__ void run_step(const Params& p, unsigned char* smem) {
    constexpr int l = s / 9, ph = s % 9;
    if constexpr (s == 18) { phase_norm(p, smem, 0, 2, 11, p.ws + WS_R2 + 5632, 11264); }
    else if constexpr (ph == 1 || ph == 4 || ph == 6 || ph == 8) {
        pg8::Gemm g; pg8::EpiAny E; bool perm = true;
        if constexpr (ph == 1) {
            g = pg8::Gemm{(const bf16_t*)(p.ws + WS_H), (const bf16_t*)(p.ws + WS_WIN) + (size_t)l * 4096 * 1024, T, NPN, 1024, 1024};
            E = pg8::EpiAny{0, l, p.ws + WS_R2, nullptr, p.out, 0};
        } else if constexpr (ph == 4) {
            g = pg8::Gemm{(const bf16_t*)(p.ws + WS_R2) + C_AZ, (const bf16_t*)(p.ws + WS_WOUT) + (size_t)l * 1024 * 1536, T, D, NMIX, NPROJ};
            E = pg8::EpiAny{1, l, (void*)(l == 0 ? p.in[0] : p.out), p.ws + WS_QK, p.out, 4096}; perm = false;
        } else if constexpr (ph == 6) {
            g = pg8::Gemm{(const bf16_t*)(p.ws + WS_H), (const bf16_t*)(p.ws + WS_WUP) + (size_t)l * NFF2 * 1024, T, NFF2, 1024, 1024};
            E = pg8::EpiAny{2, l, p.ws + WS_R2, p.ws + WS_SIDE, p.out, 0};
        } else {
            g = pg8::Gemm{(const bf16_t*)(p.ws + WS_R2), (const bf16_t*)(p.ws + WS_WDN) + (size_t)l * 1024 * NFF, T, D, NFF, NFF2};
            E = pg8::EpiAny{1, l, p.out, p.ws + WS_R2 + 5632, p.out, 11264}; perm = false;
        }
        pg8::StaticOrder S; S.init(g.M, g.N, g.K, gridDim.x, blockIdx.x, (ph == 4 || ph == 8) ? TSM : 0);
        pg8::gemm_phase((LAS unsigned char*)smem, g, S, E, perm);
    } else if constexpr (ph == 0) {
        if constexpr (l == 0) phase_weights(p, smem);
        if constexpr (l == 0) phase_norm(p, smem, l, 0); else phase_norm(p, smem, l, 0, 11, p.ws + WS_R2 + 5632, 11264);
    } else if constexpr (ph == 2) phase_mix(p, smem, l, false);
    else if constexpr (ph == 3) phase_mix(p, smem, l, true);
    else if constexpr (ph == 5) phase_norm(p, smem, l, 1, 6, p.ws + WS_QK, 4096);
    else phase_ffnconv(p, l);
}

#define XB_TMO      128
#define XB_XCNT(j)  (256  + 64 * (j))
#define XB_XSUB(j)  (1280 + 64 * (j))
#define XB_XGEN(j)  (2304 + 64 * (j))
#define XB_TOP      3328
#define XB_TOPGEN   3392
#define XCD_BAR_WORDS 3456
#define XB_SPIN_CAP (1u << 18)

__device__ __forceinline__ unsigned xb_ld(unsigned* p)              { return __hip_atomic_load(p, __ATOMIC_RELAXED, __HIP_MEMORY_SCOPE_AGENT); }
__device__ __forceinline__ unsigned xb_add(unsigned* p, unsigned v) { return __hip_atomic_fetch_add(p, v, __ATOMIC_RELAXED, __HIP_MEMORY_SCOPE_AGENT); }
__device__ __forceinline__ unsigned xb_xcc_id() { return (unsigned)__builtin_amdgcn_s_getreg((3 << 11) | 20) & 0xFu; }
#define XB_SPIN(cond, bar) do { unsigned _sp = 0; while (cond) { __builtin_amdgcn_s_sleep(1); \
    if ((++_sp & 255u) == 0u) { if (xb_ld(&(bar)[XB_TMO])) break; if (_sp > XB_SPIN_CAP) { atomicAdd(&(bar)[XB_TMO], 1u); break; } } } } while (0)

struct XcdBarrier {
    unsigned* bar; unsigned x;
    volatile LAS unsigned* st;
};

__device__ __forceinline__ XcdBarrier xcd_barrier_post(unsigned* bar, volatile LAS unsigned* st) {
    XcdBarrier b; b.bar = bar; b.x = xb_xcc_id(); b.st = st;
    if (threadIdx.x == 0) (void)xb_add(&bar[XB_XCNT(b.x)], 1u);
    return b;
}
__device__ __forceinline__ void xcd_barrier_complete(unsigned* bar, unsigned x, unsigned& nloc, unsigned& nx) {
    const unsigned G = gridDim.x * gridDim.y * gridDim.z;
    unsigned sum, cnt, mine, sp = 0u;
    for (;;) {
        sum = 0u; cnt = 0u; mine = 0u;
#pragma unroll
        for (unsigned j = 0; j < 16; ++j) { const unsigned c = xb_ld(&bar[XB_XCNT(j)]); sum += c; cnt += (c > 0u) ? 1u : 0u; mine = (j == x) ? c : mine; }
        if (sum == G) break;
        __builtin_amdgcn_s_sleep(1);
        if ((++sp & 255u) == 0u) { if (xb_ld(&bar[XB_TMO])) break; if (sp > XB_SPIN_CAP) { atomicAdd(&bar[XB_TMO], 1u); break; } }
    }
    nloc = mine > 0u ? mine : 1u; nx = cnt > 0u ? cnt : 1u;
}

__device__ __forceinline__ void xcd_barrier(const XcdBarrier& b) {
    asm volatile("s_waitcnt vmcnt(0)" ::: "memory");
    __syncthreads();
    if (threadIdx.x == 0) {
        unsigned* bar = b.bar;
        __builtin_amdgcn_s_waitcnt(0);
        unsigned nloc = b.st[0], nx = b.st[1];
        if (nloc == 0u) { xcd_barrier_complete(bar, b.x, nloc, nx); b.st[0] = nloc; b.st[1] = nx; }
        const unsigned old = xb_add(&bar[XB_XSUB(b.x)], 1u);
        const unsigned gen = old / nloc;
        if (old + 1u == (gen + 1u) * nloc) {
            __builtin_amdgcn_fence(__ATOMIC_RELEASE, "agent");
            asm volatile("s_waitcnt vmcnt(0)" ::: "memory");
            const unsigned og = xb_add(&bar[XB_TOP], 1u);
            const unsigned tg = og / nx;
            if (og + 1u == (tg + 1u) * nx) xb_add(&bar[XB_TOPGEN], 1u);
            else XB_SPIN(xb_ld(&bar[XB_TOPGEN]) == tg, bar);
            __builtin_amdgcn_fence(__ATOMIC_ACQUIRE, "agent");
            xb_add(&bar[XB_XGEN(b.x)], 1u);
            asm volatile("s_waitcnt vmcnt(0)" ::: "memory");
        } else {
            XB_SPIN(xb_ld(&bar[XB_XGEN(b.x)]) == gen, bar);
            __builtin_amdgcn_fence(__ATOMIC_ACQUIRE, "agent");
            asm volatile("s_waitcnt vmcnt(0)" ::: "memory");
        }
    }
    __syncthreads();
}


__global__ void __launch_bounds__(NTHREADS, 2) fwd_megakernel(Params p) {
    extern __shared__ __attribute__((aligned(16))) unsigned char smem[];
    cg::grid_group grid = cg::this_grid();
    volatile LAS unsigned* xst = (volatile LAS unsigned*)(LAS unsigned char*)(smem + LDS_BYTES - 8);
    if (blockIdx.x == 0) for (int i = threadIdx.x; i < 4096; i += NTHREADS) ((unsigned*)(p.ws + WS_CTL))[i] = 0u;
    if (threadIdx.x == 0) { xst[0] = 0u; xst[1] = 0u; }
    __syncthreads();
    run_step<0>(p, smem); grid.sync();
    const XcdBarrier xb = xcd_barrier_post((unsigned*)(p.ws + WS_BAR), xst);
    run_step<1>(p, smem); xcd_barrier(xb);  run_step<2>(p, smem); xcd_barrier(xb);  run_step<3>(p, smem); xcd_barrier(xb);
    run_step<4>(p, smem); xcd_barrier(xb);  run_step<5>(p, smem); xcd_barrier(xb);  run_step<6>(p, smem); xcd_barrier(xb);  run_step<7>(p, smem); xcd_barrier(xb);
    run_step<8>(p, smem); xcd_barrier(xb);  run_step<9>(p, smem); xcd_barrier(xb);  run_step<10>(p, smem); xcd_barrier(xb); run_step<11>(p, smem); xcd_barrier(xb);
    run_step<12>(p, smem); xcd_barrier(xb); run_step<13>(p, smem); xcd_barrier(xb); run_step<14>(p, smem); xcd_barrier(xb); run_step<15>(p, smem); xcd_barrier(xb);
    run_step<16>(p, smem); xcd_barrier(xb); run_step<17>(p, smem); xcd_barrier(xb); run_step<18>(p, smem);
}

extern "C" void kernel_launch(void* const* d_in, const int* in_sizes, int n_in, void* d_out, int out_size, void* d_ws, size_t ws_size, hipStream_t stream) {
    static int grid_blocks = 0;
    if (grid_blocks == 0) {
        if (n_in != 26 || ws_size < WS_END) { fprintf(stderr, "kernel_launch: unexpected problem (n_in %d, ws %zu < %zu)\n", n_in, ws_size, (size_t)WS_END); grid_blocks = -1; return; }
        int dev = 0, cus = 0, per_cu = 0;
        (void)hipGetDevice(&dev);
        (void)hipDeviceGetAttribute(&cus, hipDeviceAttributeMultiprocessorCount, dev);
        if (hipFuncSetAttribute((const void*)fwd_megakernel, hipFuncAttributeMaxDynamicSharedMemorySize, LDS_BYTES) != hipSuccess) { fprintf(stderr, "hipFuncSetAttribute failed\n"); grid_blocks = -1; return; }
        if (hipOccupancyMaxActiveBlocksPerMultiprocessor(&per_cu, (const void*)fwd_megakernel, NTHREADS, LDS_BYTES) != hipSuccess || per_cu < 1) { fprintf(stderr, "occupancy query failed (%d)\n", per_cu); (void)hipGetLastError(); per_cu = 1; }
        if (per_cu > 1) per_cu = 1;
        grid_blocks = cus * per_cu;
    }
    if (grid_blocks < 0) return;
    Params p{};
    for (int i = 0; i < 26; ++i) p.in[i] = (const float*)d_in[i];
    p.out = (float*)d_out; p.ws = (unsigned char*)d_ws;
    void* args[] = {&p};
    hipError_t e = hipLaunchCooperativeKernel((const void*)fwd_megakernel, dim3(grid_blocks), dim3(NTHREADS), args, LDS_BYTES, stream);
    if (e != hipSuccess) fprintf(stderr, "cooperative launch failed: %s (grid %d)\n", hipGetErrorString(e), grid_blocks);
}
```

```cpp
#include <hip/hip_runtime.h>
#include <hip/hip_cooperative_groups.h>
#include <cstdio>
#include <cstdint>
namespace cg = cooperative_groups;

#define LAS __attribute__((address_space(3)))
typedef unsigned short bf16_t;
typedef short bf16x8 __attribute__((ext_vector_type(8)));
typedef short bf16x4 __attribute__((ext_vector_type(4)));
typedef float f32x4 __attribute__((ext_vector_type(4)));
typedef unsigned u32x4 __attribute__((ext_vector_type(4)));
typedef unsigned u32x2 __attribute__((ext_vector_type(2)));

constexpr int D = 1024, TP = 32768, TSM = 1024, T = TP + TSM, SEQ = 2048;
constexpr int NPROJ = 4608, NPN = 4096, NMIX = 1536, NFF2 = 5632, NFF = 2816, INW = 4104;
constexpr float EPS = 1e-6f;
constexpr int C_BK = 1536, C_BV = 2048, C_CX = 2560, C_AZ = 3072, C_BQ = 3584, C_PO = 4096;
constexpr size_t O_YP = 0, O_YS = 33554432, O_PSD = 34603008, O_SSD = 36700160, O_PQC = 38797312, O_SQC = 38944768, O_PK = 39092224, O_SK = 72646656,
                 O_PV = 73695232, O_SV = 107249664, O_PPOOL = 108298240, O_SPOOL = 108544000, O_PFFN = 108789760, O_SFFN = 109150208;
constexpr size_t WS_CTL = 0, WS_BAR = 1024, WS_GB = 16384,
                 WS_WIN = WS_GB + (size_t)T * 8 * 4, WS_WOUT = WS_WIN + 2ull * 4096 * 1024 * 2, WS_WUP = WS_WOUT + 2ull * 1024 * 1536 * 2,
                 WS_WDN = WS_WUP + 2ull * 5632 * 1024 * 2, WS_CW = WS_WDN + 2ull * 1024 * 2816 * 2, WS_H = WS_CW + 2ull * 4 * 128 * 128 * 2,
                 WS_R2 = WS_H + (size_t)T * 1024 * 2, WS_QK = WS_R2 + (size_t)T * NPROJ * 2, WS_SIDE = WS_R2 + (size_t)T * NFF2 * 2, WS_DD = WS_SIDE,
                 WS_END = WS_SIDE + 1056ull * 2 * NFF2 * 2;
constexpr int LDS_BYTES = 155648;
constexpr int NTHREADS = 512;

struct Params { const float* in[26]; float* out; unsigned char* ws; };

__device__ __forceinline__ bf16_t f2bf(float f) { unsigned u = __float_as_uint(f); u += 0x7FFFu + ((u >> 16) & 1u); return (bf16_t)(u >> 16); }
__device__ __forceinline__ float bf2f(bf16_t b) { return __uint_as_float(((unsigned)b) << 16); }
typedef __bf16 bf16v2_t __attribute__((ext_vector_type(2)));
typedef float f32v2_t __attribute__((ext_vector_type(2)));
__device__ __forceinline__ unsigned pk2(float lo, float hi) { const f32v2_t f = {lo, hi}; const bf16v2_t r = __builtin_convertvector(f, bf16v2_t); return __builtin_bit_cast(unsigned, r); }
__device__ __forceinline__ float bflo(unsigned u) { return __uint_as_float(u << 16); }
__device__ __forceinline__ float bfhi(unsigned u) { return __uint_as_float(u & 0xFFFF0000u); }
__device__ __forceinline__ float siluf(float y) { return y * __builtin_amdgcn_rcpf(1.f + __expf(-y)); }
__device__ __forceinline__ int opaque_tid() { int t = threadIdx.x; asm volatile("" : "+v"(t)); return t; }
template <int CTRL> __device__ __forceinline__ float dpp_mov(float v) { return __builtin_bit_cast(float, __builtin_amdgcn_update_dpp(0, __builtin_bit_cast(int, v), CTRL, 0xF, 0xF, true)); }
__device__ __forceinline__ float row_sum16(float v) { v += dpp_mov<0xB1>(v); v += dpp_mov<0x4E>(v); v += dpp_mov<0x141>(v); v += dpp_mov<0x140>(v); return v; }
__device__ __forceinline__ float wave_sum64(float v) { v = row_sum16(v);
    return (__builtin_amdgcn_readlane(__builtin_bit_cast(int, v), 0) , __builtin_bit_cast(float, __builtin_amdgcn_readlane(__builtin_bit_cast(int, v), 0)) + __builtin_bit_cast(float, __builtin_amdgcn_readlane(__builtin_bit_cast(int, v), 16))
         + __builtin_bit_cast(float, __builtin_amdgcn_readlane(__builtin_bit_cast(int, v), 32)) + __builtin_bit_cast(float, __builtin_amdgcn_readlane(__builtin_bit_cast(int, v), 48))); }
#define MFMA16(a, b, c) __builtin_amdgcn_mfma_f32_16x16x32_bf16(a, b, c, 0, 0, 0)
__device__ __forceinline__ void unpack8(const u32x4 v, float* f) {
    f[0] = bflo(v.x); f[1] = bfhi(v.x); f[2] = bflo(v.y); f[3] = bfhi(v.y); f[4] = bflo(v.z); f[5] = bfhi(v.z); f[6] = bflo(v.w); f[7] = bfhi(v.w);
}

namespace pg8 {
constexpr int BM = 256, BK = 64, HALF = 128, HTB = HALF * BK * 2, STAGE_BYTES = 8 * HTB, NXCD = 8, WGM = 8;
__host__ __device__ __forceinline__ int lds_byte(int r, int c) { const int st = (r >> 4) * 2 + (c >> 5), rr = r & 15, cc = c & 31, ob = rr * 64 + cc * 2; return st * 1024 + (ob ^ (((ob >> 9) & 1) << 5)); }
__host__ __device__ __forceinline__ void stage_rc(int b, int& R, int& C) { const int st = b / 1024, sb = b % 1024, swz = sb ^ (((sb >> 9) & 1) << 5); R = (st >> 1) * 16 + swz / 64; C = (st & 1) * 32 + (swz % 64) / 2; }
__host__ __device__ __forceinline__ int perm32(int rho) { const int n = rho >> 4, i = rho & 15; return 8 * (i >> 2) + 4 * n + (i & 3); }
struct Unit { int pm, pn, k0, nt; };
struct Gemm { const bf16_t* A; const bf16_t* Bt; int M, N, K, lda; };
struct StaticOrder {
    int nM, nN, nwg, G, c, ntk, nslice, ntot;
    __device__ void init(int M, int N, int K, int G_, int c_, int split_rows) {
        nN = N / BM; G = G_; c = c_; ntk = K / BK;
        if (split_rows > 0) { nM = (M - split_rows) / BM; nslice = K / 256; nwg = nM * nN; ntot = nwg + (split_rows / BM) * nN * nslice; }
        else { nM = M / BM; nslice = 0; nwg = nM * nN; ntot = nwg; }
    }
    __device__ bool next(int i, Unit& u) const {
        const long L = (long)i * G + c; if (L >= ntot) return false;
        if (L >= nwg) { const int idx = (int)L - nwg, tile = idx / nslice, sl = idx - tile * nslice; u.pm = nM + tile / nN; u.pn = tile % nN; u.k0 = sl * 256; u.nt = 4; return true; }
        int wgid = (int)L; { const int q = nwg / NXCD, r = nwg % NXCD, xcd = wgid % NXCD, off = wgid / NXCD; wgid = (xcd < r ? xcd * (q + 1) : r * (q + 1) + (xcd - r) * q) + off; }
        const int nig = WGM * nN, gid = wgid / nig, fm = gid * WGM, gsz = (nM - fm) < WGM ? (nM - fm) : WGM;
        u.pm = fm + ((wgid % nig) % gsz); u.pn = (wgid % nig) / gsz; u.k0 = 0; u.nt = ntk; return true;
    }
};
__device__ __forceinline__ unsigned cvt_pk_bf16(float lo, float hi) { unsigned r; asm volatile("v_cvt_pk_bf16_f32 %0, %1, %2" : "=v"(r) : "v"(lo), "v"(hi)); return r; }

struct EpiAny;
__device__ __forceinline__ void run_epi(const EpiAny& E, const f32x4 (&acc)[2][2][4][2], const Unit& u, int wr, int wc, int fr, int fq);
__device__ __forceinline__ void gemm_phase(LAS unsigned char* lds, const Gemm g, const StaticOrder& S, const EpiAny& E, const bool perm) {
    const int tid = opaque_tid(), wid = __builtin_amdgcn_readfirstlane(tid >> 6), lane = tid & 63, wr = wid >> 2, wc = wid & 3, fr = lane & 15, fq = lane >> 4;
    const int K = g.K, lda = g.lda;
    unsigned voffA[2], voffB[2];
#pragma unroll
    for (int i = 0; i < 2; ++i) { int R, C; stage_rc(tid * 16 + i * 8192, R, C); const int Rb = perm ? ((R & ~31) + perm32(R & 31)) : R;
        voffA[i] = (unsigned)(R * lda + C) * 2u; voffB[i] = (unsigned)(Rb * K + C) * 2u; }
    const size_t kstep = (size_t)(BK * 2);
    const size_t hstepA = (size_t)HALF * lda * 2, hstepB = (size_t)HALF * K * 2;
    const size_t tstepA = 2 * hstepA, tstepB = 2 * hstepB;
    const unsigned ldsw = (unsigned)wid * 1024u;
    const int aoff = lds_byte(wr * 64 + fr, fq * 8), boff = lds_byte(wc * 32 + fr, fq * 8);
#define PG8_SA(b, h) (((b) * 2 + (h)) * HTB)
#define PG8_SB(b, h) ((4 + (b) * 2 + (h)) * HTB)
#define PG8_STAGE(bufoff, gbase, voff) do { _Pragma("unroll") for (int _i = 0; _i < 2; ++_i) \
        __builtin_amdgcn_global_load_lds((const unsigned*)((const char*)(gbase) + (voff)[_i]), (LAS unsigned*)(lds + (bufoff) + ldsw + _i * 8192), 16, 0, 0); } while (0)
#define PG8_LDA(dst, b, h) do { _Pragma("unroll") for (int m = 0; m < 4; ++m) _Pragma("unroll") for (int k = 0; k < 2; ++k) dst[m][k] = *(const LAS bf16x8*)(lds + PG8_SA(b, h) + aoff + m * 2048 + k * 1024); } while (0)
#define PG8_LDB(dst, b, h) do { _Pragma("unroll") for (int n = 0; n < 2; ++n) _Pragma("unroll") for (int k = 0; k < 2; ++k) dst[n][k] = *(const LAS bf16x8*)(lds + PG8_SB(b, h) + boff + n * 2048 + k * 1024); } while (0)
#define PG8_MMA(ai, bj, At, Bt) do { __builtin_amdgcn_s_setprio(1); _Pragma("unroll") for (int m = 0; m < 4; ++m) _Pragma("unroll") for (int n = 0; n < 2; ++n) _Pragma("unroll") for (int k = 0; k < 2; ++k) \
        acc[ai][bj][m][n] = __builtin_amdgcn_mfma_f32_16x16x32_bf16(Bt[n][k], At[m][k], acc[ai][bj][m][n], 0, 0, 0); __builtin_amdgcn_s_setprio(0); } while (0)
#define PG8_WAIT_V(n) asm volatile("s_waitcnt vmcnt(" #n ")" ::: "memory")
#define PG8_WAIT_L(n) asm volatile("s_waitcnt lgkmcnt(" #n ")" ::: "memory")
#define PG8_BAR __builtin_amdgcn_s_barrier()
#define PG8_SCHED __builtin_amdgcn_sched_barrier(0)
    Unit cur, nxt; int ui = 0;
    if (!S.next(0, cur)) return;
    f32x4 acc[2][2][4][2];
#pragma unroll
    for (int a = 0; a < 2; ++a)
#pragma unroll
        for (int b = 0; b < 2; ++b)
#pragma unroll
            for (int m = 0; m < 4; ++m)
#pragma unroll
                for (int n = 0; n < 2; ++n) acc[a][b][m][n] = (f32x4){0.f, 0.f, 0.f, 0.f};
    bf16x8 At[4][2], B0[2][2], B1[2][2];
    const char* cA = (const char*)g.A + (size_t)cur.pm * tstepA + (size_t)cur.k0 * 2; const char* cB = (const char*)g.Bt + (size_t)cur.pn * tstepB + (size_t)cur.k0 * 2;
    int nt = cur.nt;
    PG8_STAGE(PG8_SB(0, 0), cB, voffB); PG8_STAGE(PG8_SA(0, 0), cA, voffA); PG8_STAGE(PG8_SB(0, 1), cB + hstepB, voffB); PG8_STAGE(PG8_SA(0, 1), cA + hstepA, voffA);
    if (wr == 1) PG8_BAR;
    PG8_WAIT_V(4); PG8_BAR;
    PG8_STAGE(PG8_SB(1, 0), cB + kstep, voffB); PG8_STAGE(PG8_SA(1, 0), cA + kstep, voffA); PG8_STAGE(PG8_SB(1, 1), cB + hstepB + kstep, voffB);
    PG8_WAIT_V(6); PG8_BAR;
    for (;;) {
        const bool has_next = S.next(ui + 1, nxt);
        const char* nA = has_next ? (const char*)g.A + (size_t)nxt.pm * tstepA + (size_t)nxt.k0 * 2 : cA; const char* nB = has_next ? (const char*)g.Bt + (size_t)nxt.pn * tstepB + (size_t)nxt.k0 * 2 : cB;
        for (int t = 0; t < nt; t += 2) {
            const bool last = (t == nt - 2);
            const char* a1 = cA + (size_t)(t + 1) * kstep;
            const char* a2 = last ? nA : cA + (size_t)(t + 2) * kstep; const char* b2 = last ? nB : cB + (size_t)(t + 2) * kstep;
            const char* a3 = a2 + kstep; const char* b3 = b2 + kstep;
            PG8_LDB(B0, 0, 0); PG8_SCHED; PG8_LDA(At, 0, 0); PG8_STAGE(PG8_SA(1, 1), a1 + hstepA, voffA);
            PG8_WAIT_L(8); PG8_BAR; PG8_WAIT_L(0); PG8_MMA(0, 0, At, B0); PG8_BAR; PG8_SCHED;
            PG8_LDB(B1, 0, 1); PG8_STAGE(PG8_SB(0, 0), b2, voffB);
            PG8_BAR; PG8_WAIT_L(0); PG8_MMA(0, 1, At, B1); PG8_BAR;
            PG8_LDA(At, 0, 1); PG8_STAGE(PG8_SA(0, 0), a2, voffA);
            PG8_BAR; PG8_WAIT_L(0); PG8_MMA(1, 0, At, B0); PG8_BAR; PG8_SCHED;
            PG8_STAGE(PG8_SB(0, 1), b2 + hstepB, voffB);
            PG8_WAIT_V(6); PG8_BAR; PG8_MMA(1, 1, At, B1); PG8_BAR;
            PG8_LDB(B0, 1, 0); PG8_SCHED; PG8_LDA(At, 1, 0); PG8_STAGE(PG8_SA(0, 1), a2 + hstepA, voffA);
            PG8_WAIT_L(8); PG8_BAR; PG8_WAIT_L(0); PG8_MMA(0, 0, At, B0); PG8_BAR; PG8_SCHED;
            PG8_LDB(B1, 1, 1); PG8_STAGE(PG8_SB(1, 0), b3, voffB);
            PG8_BAR; PG8_WAIT_L(0); PG8_MMA(0, 1, At, B1); PG8_BAR;
            PG8_LDA(At, 1, 1); PG8_STAGE(PG8_SA(1, 0), a3, voffA);
            PG8_BAR; PG8_WAIT_L(0); PG8_MMA(1, 0, At, B0); PG8_BAR; PG8_SCHED;
            PG8_STAGE(PG8_SB(1, 1), b3 + hstepB, voffB);
            PG8_WAIT_V(6); PG8_BAR; PG8_MMA(1, 1, At, B1); PG8_BAR;
        }
        run_epi(E, acc, cur, wr, wc, fr, fq);
        if (!has_next) break;
#pragma unroll
        for (int a = 0; a < 2; ++a)
#pragma unroll
            for (int b = 0; b < 2; ++b)
#pragma unroll
                for (int m = 0; m < 4; ++m)
#pragma unroll
                    for (int n = 0; n < 2; ++n) acc[a][b][m][n] = (f32x4){0.f, 0.f, 0.f, 0.f};
        cur = nxt; cA = nA; cB = nB; nt = cur.nt; ++ui;
    }
    PG8_WAIT_V(0);
    if (wr == 0) PG8_BAR;
    PG8_BAR;
#undef PG8_SA
#undef PG8_SB
#undef PG8_STAGE
#undef PG8_LDA
#undef PG8_LDB
#undef PG8_MMA
#undef PG8_WAIT_V
#undef PG8_WAIT_L
#undef PG8_BAR
#undef PG8_SCHED
}

struct EpiAny {
    int mode; int l; void* p0; void* p1; float* out; int aux;
    __device__ __forceinline__ void operator()(const f32x4 (&acc)[2][2][4][2], const Unit& u, int wr, int wc, int fr, int fq) const {
        const int row0 = u.pm * BM + wr * 64 + fr;
        if (mode == 1) {
            const int col0 = u.pn * BM + wc * 32 + 4 * fq;
            const float* res = (const float*)p0;
#pragma unroll
            for (int ai = 0; ai < 2; ++ai)
#pragma unroll
                for (int m = 0; m < 4; ++m) {
                    const size_t ro = (size_t)(row0 + ai * HALF + m * 16) * D + col0;
#pragma unroll
                    for (int bj = 0; bj < 2; ++bj)
#pragma unroll
                        for (int n = 0; n < 2; ++n) {
                            float* o = out + ro + bj * HALF + n * 16;
                            if (u.nt == 4) {
                                const int rs = row0 + ai * HALF + m * 16 - TP, cs = col0 + bj * HALF + n * 16;
                                *(f32x4*)((char*)p1 + (size_t)((u.k0 >> 8) * TSM + rs) * (size_t)aux + (size_t)cs * 4) = acc[ai][bj][m][n];
                            } else { const f32x4 r = *(const f32x4*)(res + ro + bj * HALF + n * 16); *(f32x4*)o = acc[ai][bj][m][n] + r; }
                        }
                    __builtin_amdgcn_sched_barrier(0);
                }
        } else if (mode == 0) {
            bf16_t* proj = (bf16_t*)p0;
#pragma unroll
            for (int bj = 0; bj < 2; ++bj) {
                const int cb = u.pn * BM + bj * HALF;
                const int col0 = cb + wc * 32 + 8 * fq;
                const bool iskv = (cb >= C_BK) && (cb < C_CX);
                const bool isv = cb >= C_BV;
                float* kvdst = nullptr;
                if (iskv) { const bool pr = u.pm * BM < TP; const size_t off = pr ? ((isv ? O_PV : O_PK) + (size_t)l * 16777216 + (size_t)row0 * 512) : ((isv ? O_SV : O_SK) + (size_t)l * 524288 + (size_t)(row0 - TP) * 512); kvdst = out + off; }
                const int cc = col0 - (isv ? C_BV : C_BK);
#pragma unroll
                for (int ai = 0; ai < 2; ++ai)
#pragma unroll
                    for (int m = 0; m < 4; ++m) {
                        const int ro = ai * HALF + m * 16;
                        const f32x4 v0 = acc[ai][bj][m][0], v1 = acc[ai][bj][m][1];
                        u32x4 o; o.x = cvt_pk_bf16(v0[0], v0[1]); o.y = cvt_pk_bf16(v0[2], v0[3]); o.z = cvt_pk_bf16(v1[0], v1[1]); o.w = cvt_pk_bf16(v1[2], v1[3]);
                        *(u32x4*)(proj + (size_t)(row0 + ro) * NPROJ + col0) = o;
                        if (iskv) { float* dst = kvdst + (size_t)ro * 512 + cc; *(f32x4*)dst = v0; *(f32x4*)(dst + 4) = v1; }
                    }
            }
        } else {
            bf16_t* ub = (bf16_t*)p0; bf16_t* side = (bf16_t*)p1;
#pragma unroll
            for (int bj = 0; bj < 2; ++bj) {
                const int col0 = u.pn * BM + bj * HALF + wc * 32 + 8 * fq;
#pragma unroll
                for (int ai = 0; ai < 2; ++ai)
#pragma unroll
                    for (int m = 0; m < 4; ++m) {
                        const int row = row0 + ai * HALF + m * 16;
                        const f32x4 v0 = acc[ai][bj][m][0], v1 = acc[ai][bj][m][1];
                        u32x4 o; o.x = cvt_pk_bf16(v0[0], v0[1]); o.y = cvt_pk_bf16(v0[2], v0[3]); o.z = cvt_pk_bf16(v1[0], v1[1]); o.w = cvt_pk_bf16(v1[2], v1[3]);
                        *(u32x4*)(ub + (size_t)row * NFF2 + col0) = o;
                        if ((m & 1) && fr >= 14) {
                            const int rr = fr - 14;
                            *(u32x4*)(side + ((size_t)(row >> 5) * 2 + rr) * NFF2 + col0) = o;
                            float* dst = nullptr;
                            if (row < TP) { if ((row & 2047) >= 2046) dst = out + O_PFFN + (size_t)l * 180224 + ((size_t)(row >> 11) * 2 + rr) * NFF2 + col0; }
                            else if (((row - TP) & 63) >= 62) dst = out + O_SFFN + (size_t)l * 180224 + ((size_t)((row - TP) >> 6) * 2 + rr) * NFF2 + col0;
                            if (dst) { *(f32x4*)dst = v0; *(f32x4*)(dst + 4) = v1; }
                        }
                    }
            }
        }
    }
};
__device__ __forceinline__ void run_epi(const EpiAny& E, const f32x4 (&acc)[2][2][4][2], const Unit& u, int wr, int wc, int fr, int fq) { E(acc, u, wr, wc, fr, fq); }
}

__device__ __forceinline__ void transpose_tile(const float* __restrict__ src, int ldsrc, bf16_t* __restrict__ dst, int lddst, int k0, int n0d, int n0s, float* tile, const int tid) {
#pragma unroll
    for (int i = 0; i < 8; ++i) { const int idx = tid + 512 * i, kk = idx >> 6, nn = idx & 63; tile[kk * 65 + nn] = src[(size_t)(k0 + kk) * ldsrc + n0s + nn]; }
    __syncthreads();
#pragma unroll
    for (int i = 0; i < 4; ++i) { const int idx = tid + 512 * i, nn = idx >> 5, kp = idx & 31;
        *(unsigned*)(dst + (size_t)(n0d + nn) * lddst + k0 + 2 * kp) = pk2(tile[(2 * kp) * 65 + nn], tile[(2 * kp + 1) * 65 + nn]); }
    __syncthreads();
}
__device__ __forceinline__ void phase_weights(const Params& p, unsigned char* smem) {
    float* tile = (float*)smem; const int tid = opaque_tid();
    constexpr int N_IN = 16 * 64, N_OUT = 24 * 16, N_UP = 16 * 88, N_DN = 44 * 16, N_CW = 16, PER_L = N_IN + N_OUT + N_UP + N_DN + N_CW;
    for (int it = blockIdx.x; it < 2 * PER_L; it += gridDim.x) {
        const int l = it / PER_L; int r = it % PER_L;
        if (r < N_IN) { const int kb = r / 64, nb = r % 64, n0 = nb * 64;
            transpose_tile(p.in[9] + (size_t)l * 1024 * INW, INW, (bf16_t*)(p.ws + WS_WIN) + (size_t)l * 4096 * 1024, 1024, kb * 64, n0, n0 < 1536 ? n0 : (n0 < 2048 ? n0 + 1032 : (n0 < 2560 ? n0 + 1032 : (n0 < 3072 ? n0 + 1032 : (n0 < 3584 ? n0 - 1536 : n0 - 1528)))), tile, tid); continue; }
        r -= N_IN;
        if (r < N_OUT) { const int kb = r / 16, nb = r % 16;
            transpose_tile(p.in[19] + (size_t)l * 1536 * 1024, 1024, (bf16_t*)(p.ws + WS_WOUT) + (size_t)l * 1024 * 1536, 1536, kb * 64, nb * 64, nb * 64, tile, tid); continue; }
        r -= N_OUT;
        if (r < N_UP) { const int kb = r / 88, nb = r % 88;
            transpose_tile(p.in[21] + (size_t)l * 1024 * NFF2, NFF2, (bf16_t*)(p.ws + WS_WUP) + (size_t)l * NFF2 * 1024, 1024, kb * 64, nb * 64, nb * 64, tile, tid); continue; }
        r -= N_UP;
        if (r < N_DN) { const int kb = r / 16, nb = r % 16;
            transpose_tile(p.in[24] + (size_t)l * NFF * 1024, 1024, (bf16_t*)(p.ws + WS_WDN) + (size_t)l * 1024 * NFF, NFF, kb * 64, nb * 64, nb * 64, tile, tid); continue; }
        r -= N_DN;
        { const int gi = r >> 2, kb = (r >> 1) & 1, nb = r & 1;
            transpose_tile(p.in[17] + ((size_t)l * 4 + gi) * 16384, 128, (bf16_t*)(p.ws + WS_CW) + ((size_t)l * 4 + gi) * 16384, 128, kb * 64, nb * 64, nb * 64, tile, tid); }
    }
}

__device__ __forceinline__ void phase_norm(const Params& p, unsigned char* smem, int l, int mode, const int nsl = 0, const unsigned char* pbase = nullptr, const int ppitch = 0) {
    const int tid = opaque_tid(), lane = tid & 63, wave = tid >> 6;
    float* wab = (float*)smem;
    const float* gw = mode == 0 ? p.in[8] + l * 1024 : (mode == 1 ? p.in[20] + l * 1024 : p.in[25]);
    if (mode == 0) {
        const float* w = p.in[9] + (size_t)l * 1024 * INW;
        for (int idx = tid; idx < 8192; idx += 512) wab[idx] = w[(size_t)(idx >> 3) * INW + 2048 + (idx & 7)];
        __syncthreads();
    }
    f32x4 gv[4];
#pragma unroll
    for (int j = 0; j < 4; ++j) gv[j] = *(const f32x4*)(gw + 4 * (lane + 64 * j));
    bf16_t* h = (bf16_t*)(p.ws + WS_H);
    float* gb = (float*)(p.ws + WS_GB);
    const bool from_in = (mode == 0 && l == 0);
    for (int row = blockIdx.x * 8 + wave; row < T; row += gridDim.x * 8) {
        const float* xr = from_in ? (row < TP ? p.in[0] + (size_t)row * D : p.in[1] + (size_t)(row - TP) * D) : p.out + (size_t)row * D;
        f32x4 v[4]; float ss = 0.f;
#pragma unroll
        for (int j = 0; j < 4; ++j) { v[j] = *(const f32x4*)(xr + 4 * (lane + 64 * j)); ss += v[j][0] * v[j][0] + v[j][1] * v[j][1] + v[j][2] * v[j][2] + v[j][3] * v[j][3]; }
        ss = wave_sum64(ss);
        if (row >= TP) {
            if (from_in) {
#pragma unroll
                for (int j = 0; j < 4; ++j) *(f32x4*)(p.out + (size_t)row * D + 4 * (lane + 64 * j)) = v[j];
            } else if (nsl > 0) {
                for (int sl = 0; sl < nsl; ++sl) {
                    const unsigned char* pr = pbase + (size_t)(sl * TSM + row - TP) * (size_t)ppitch;
#pragma unroll
                    for (int j = 0; j < 4; ++j) v[j] += *(const f32x4*)(pr + 16 * (lane + 64 * j));
                }
                ss = 0.f;
#pragma unroll
                for (int j = 0; j < 4; ++j) { ss += v[j][0] * v[j][0] + v[j][1] * v[j][1] + v[j][2] * v[j][2] + v[j][3] * v[j][3];
                    if (mode != 2) *(f32x4*)(p.out + (size_t)row * D + 4 * (lane + 64 * j)) = v[j]; }
                ss = wave_sum64(ss);
            }
        }
        const float rstd = rsqrtf(ss * (1.f / D) + EPS);
#pragma unroll
        for (int j = 0; j < 4; ++j) v[j] = v[j] * rstd * gv[j];
        if (mode == 2) {
#pragma unroll
            for (int j = 0; j < 4; ++j) *(f32x4*)(p.out + (size_t)row * D + 4 * (lane + 64 * j)) = v[j];
            continue;
        }
#pragma unroll
        for (int j = 0; j < 4; ++j) { u32x2 o; o.x = pk2(v[j][0], v[j][1]); o.y = pk2(v[j][2], v[j][3]); *(u32x2*)(h + (size_t)row * D + 4 * (lane + 64 * j)) = o; }
        if (mode == 0) {
            float d8[8];
#pragma unroll
            for (int c = 0; c < 8; ++c) d8[c] = 0.f;
#pragma unroll
            for (int j = 0; j < 4; ++j)
#pragma unroll
                for (int i = 0; i < 4; ++i) { const int k = 4 * (lane + 64 * j) + i; const f32x4 w0 = *(const f32x4*)(wab + k * 8), w1 = *(const f32x4*)(wab + k * 8 + 4); const float hv = v[j][i];
                    d8[0] += hv * w0[0]; d8[1] += hv * w0[1]; d8[2] += hv * w0[2]; d8[3] += hv * w0[3]; d8[4] += hv * w1[0]; d8[5] += hv * w1[1]; d8[6] += hv * w1[2]; d8[7] += hv * w1[3]; }
#pragma unroll
            for (int c = 0; c < 8; ++c) d8[c] = wave_sum64(d8[c]);
            if (lane < 8) {
                float val = 0.f;
#pragma unroll
                for (int c = 0; c < 8; ++c) val = (lane == c) ? d8[c] : val;
                float res;
                if (lane < 4) { const float xx = val + p.in[13][l * 4 + lane]; const float sp = xx > 20.f ? xx : log1pf(expf(xx)); res = -expf(p.in[12][l * 4 + lane]) * sp; }
                else res = 1.f / (1.f + expf(-val));
                gb[(size_t)row * 8 + lane] = res;
            }
        }
    }
}

constexpr int DP_QB = 0, DP_KB = 17408, DP_KTT = 34816, DP_VU = 53248, DP_LM = 86016, DP_QKD = 102400, DP_SM = 111616;
__device__ __forceinline__ void delta_prep(const Params& p, unsigned char* smem, int l, int pi) {
    const int tid = opaque_tid(), lane = tid & 63, w = tid >> 6, fr = lane & 15, fq = lane >> 4;
    const bool prompt = pi < 2048;
    const int sid = prompt ? (pi >> 5) : (pi - 2048), n = prompt ? (pi & 31) : 0;
    const int b = sid >> 2, hh = sid & 3;
    const int rowbase = prompt ? b * SEQ : TP + b * 64, L = prompt ? SEQ : 64, t0 = n * 64;
    const bf16_t* proj = (const bf16_t*)(p.ws + WS_R2);
    const float* gb = (const float*)(p.ws + WS_GB);
    bf16_t* QB = (bf16_t*)(smem + DP_QB); bf16_t* KB = (bf16_t*)(smem + DP_KB); bf16_t* KTT = (bf16_t*)(smem + DP_KTT);
    float* VU = (float*)(smem + DP_VU); float* LM = (float*)(smem + DP_LM); bf16_t* QKD = (bf16_t*)(smem + DP_QKD);
    float* sG = (float*)(smem + DP_SM); float* sgam = sG + 64; float* sbeta = sG + 128; float* stail = sG + 192; float* sbg = sG + 256;
    const float* convw = p.in[10] + l * 6144; const float* convb = p.in[11] + l * 1536;
    const float* cbuf = p.in[3] + ((size_t)l * 16 + b) * 3 * 1536;
    u32x4 raw[6][4];
#pragma unroll
    for (int zp = 0; zp < 6; ++zp) {
        const int z = zp >> 1, item = tid + 512 * (zp & 1), row = item >> 4, seg = item & 15, cq = z * 512 + hh * 128 + seg * 8;
#pragma unroll
        for (int i = 0; i < 4; ++i) {
            const int tt = t0 + row - 3 + i;
            if (tt >= 0) raw[zp][i] = *(const u32x4*)(proj + (size_t)(rowbase + tt) * NPROJ + cq);
            else if (!prompt) { const f32x4 c0 = *(const f32x4*)(cbuf + (3 + tt) * 1536 + cq), c1 = *(const f32x4*)(cbuf + (3 + tt) * 1536 + cq + 4);
                raw[zp][i].x = pk2(c0[0], c0[1]); raw[zp][i].y = pk2(c0[2], c0[3]); raw[zp][i].z = pk2(c1[0], c1[1]); raw[zp][i].w = pk2(c1[2], c1[3]); }
            else raw[zp][i] = (u32x4){0u, 0u, 0u, 0u};
        }
    }
    if (tid < 64) {
        const float g = gb[(size_t)(rowbase + t0 + tid) * 8 + hh], be = gb[(size_t)(rowbase + t0 + tid) * 8 + 4 + hh];
        float G = g;
#pragma unroll
        for (int o = 1; o < 64; o <<= 1) { const float t = __shfl_up(G, o); if (lane >= o) G += t; }
        const float Gl = __shfl(G, 63);
        sG[tid] = G; sgam[tid] = __expf(G); sbeta[tid] = be; stail[tid] = __expf(Gl - G); sbg[tid] = be * __expf(G);
    }
    __syncthreads();
#pragma unroll
    for (int zp = 0; zp < 6; ++zp) {
        const int z = zp >> 1, item = tid + 512 * (zp & 1), row = item >> 4, seg = item & 15, cq = z * 512 + hh * 128 + seg * 8;
        float y[8];
        { const f32x4 b0 = *(const f32x4*)(convb + cq), b1 = *(const f32x4*)(convb + cq + 4); y[0] = b0[0]; y[1] = b0[1]; y[2] = b0[2]; y[3] = b0[3]; y[4] = b1[0]; y[5] = b1[1]; y[6] = b1[2]; y[7] = b1[3]; }
#pragma unroll
        for (int i = 0; i < 4; ++i) {
            float x[8]; unpack8(raw[zp][i], x);
            const f32x4 w0 = *(const f32x4*)(convw + i * 1536 + cq), w1 = *(const f32x4*)(convw + i * 1536 + cq + 4);
            y[0] += w0[0] * x[0]; y[1] += w0[1] * x[1]; y[2] += w0[2] * x[2]; y[3] += w0[3] * x[3]; y[4] += w1[0] * x[4]; y[5] += w1[1] * x[5]; y[6] += w1[2] * x[6]; y[7] += w1[3] * x[7];
        }
        float ss = 0.f;
#pragma unroll
        for (int e = 0; e < 8; ++e) { y[e] = siluf(y[e]); ss += y[e] * y[e]; }
        if (z < 2) {
            ss = row_sum16(ss);
            const float sc = rsqrtf(ss + EPS) * (z == 0 ? 0.08838834764831845f : 1.f);
#pragma unroll
            for (int e = 0; e < 8; ++e) y[e] *= sc;
            u32x4 o; o.x = pk2(y[0], y[1]); o.y = pk2(y[2], y[3]); o.z = pk2(y[4], y[5]); o.w = pk2(y[6], y[7]);
            *(u32x4*)((z == 0 ? QB : KB) + row * 136 + seg * 8) = o;
            if (z == 1) { const float tl = stail[row];
#pragma unroll
                for (int e = 0; e < 8; ++e) KTT[(seg * 8 + e) * 72 + row] = f2bf(y[e] * tl); }
        } else {
            const float be = sbeta[row];
            *(f32x4*)(VU + row * 128 + seg * 8) = (f32x4){y[0] * be, y[1] * be, y[2] * be, y[3] * be};
            *(f32x4*)(VU + row * 128 + seg * 8 + 4) = (f32x4){y[4] * be, y[5] * be, y[6] * be, y[7] * be};
        }
        __builtin_amdgcn_sched_barrier(0);
    }
    __syncthreads();
    {
        const int ct = w >> 1;
#pragma unroll
        for (int si = 0; si < 2; ++si) {
            const int st = 2 * (w & 1) + si;
            f32x4 akk = (f32x4){0.f, 0.f, 0.f, 0.f}, aqk = (f32x4){0.f, 0.f, 0.f, 0.f};
#pragma unroll
            for (int ks = 0; ks < 4; ++ks) {
                const bf16x8 xk = *(const bf16x8*)(KB + (16 * ct + fr) * 136 + 32 * ks + 8 * fq);
                const bf16x8 xq = *(const bf16x8*)(QB + (16 * ct + fr) * 136 + 32 * ks + 8 * fq);
                const bf16x8 yk = *(const bf16x8*)(KB + (16 * st + fr) * 136 + 32 * ks + 8 * fq);
                akk = MFMA16(xk, yk, akk); aqk = MFMA16(xq, yk, aqk);
            }
            const int s = 16 * st + fr; const float Gs = sG[s];
#pragma unroll
            for (int j = 0; j < 4; ++j) {
                const int c = 16 * ct + 4 * fq + j; const float dec = __expf(fminf(sG[c] - Gs, 0.f));
                LM[c * 64 + s] = (c > s) ? sbeta[c] * dec * akk[j] : 0.f;
                QKD[c * 72 + s] = f2bf((c >= s) ? dec * aqk[j] : 0.f);
            }
        }
    }
    __syncthreads();
    if (tid < 256) {
        float x[64];
        const bool isv = tid < 128; const int d = tid - 128;
        int vzero; asm volatile("v_mov_b32 %0, 0" : "=v"(vzero));
        const float* LMv = LM + vzero;
        if (isv) {
#pragma unroll
            for (int c = 0; c < 64; ++c) x[c] = VU[c * 128 + tid];
        } else {
#pragma unroll
            for (int c = 0; c < 64; ++c) x[c] = bf2f(KB[c * 136 + d]) * sbg[c];
        }
#pragma unroll
        for (int c = 1; c < 64; ++c) {
            float r0 = x[c], r1 = 0.f;
#pragma unroll
            for (int s4 = 0; s4 < (c + 3) / 4; ++s4) {
                const f32x4 lv = *(const f32x4*)(LMv + c * 64 + 4 * s4);
                r0 -= lv[0] * x[4 * s4]; r1 -= lv[1] * x[4 * s4 + 1]; r0 -= lv[2] * x[4 * s4 + 2]; r1 -= lv[3] * x[4 * s4 + 3];
            }
            x[c] = r0 + r1;
            if ((c & 3) == 3) __builtin_amdgcn_sched_barrier(0);
        }
        if (isv) {
#pragma unroll
            for (int c = 0; c < 64; ++c) VU[c * 128 + tid] = x[c];
        } else {
#pragma unroll
            for (int c = 0; c < 64; ++c) KB[c * 136 + d] = f2bf(x[c]);
        }
    }
    __syncthreads();
    {
        bf16_t* recWU = (bf16_t*)(p.ws + WS_H) + (size_t)pi * 16384;
        bf16_t* recQK = (bf16_t*)(p.ws + WS_QK) + (size_t)pi * 16384;
        unsigned char* recD = p.ws + WS_DD + (size_t)pi * 8448;
#pragma unroll
        for (int k = 0; k < 2; ++k) {
            const int idx = tid + 512 * k, row = idx >> 4, sg = idx & 15;
            *(u32x4*)(recWU + row * 128 + sg * 8) = *(const u32x4*)(KB + row * 136 + sg * 8);
            const f32x4 u0 = *(const f32x4*)(VU + row * 128 + sg * 8), u1 = *(const f32x4*)(VU + row * 128 + sg * 8 + 4);
            u32x4 o; o.x = pk2(u0[0], u0[1]); o.y = pk2(u0[2], u0[3]); o.z = pk2(u1[0], u1[1]); o.w = pk2(u1[2], u1[3]);
            *(u32x4*)(recWU + 8192 + row * 128 + sg * 8) = o;
            *(u32x4*)(recQK + row * 128 + sg * 8) = *(const u32x4*)(QB + row * 136 + sg * 8);
            const int r2 = idx >> 3, s8 = idx & 7;
            *(u32x4*)(recQK + 8192 + r2 * 64 + s8 * 8) = *(const u32x4*)(KTT + r2 * 72 + s8 * 8);
        }
        { const int r2 = tid >> 3, s8 = tid & 7; *(u32x4*)((bf16_t*)recD + r2 * 64 + s8 * 8) = *(const u32x4*)(QKD + r2 * 72 + s8 * 8); }
        if (tid < 64) ((float*)(recD + 8192))[tid] = sgam[tid];
        if (n == (prompt ? 31 : 0)) {
            float* co = p.out + (prompt ? O_PQC : O_SQC) + ((size_t)l * 16 + b) * 3 * 1536;
            for (int idx = tid; idx < 1152; idx += 512) { const int r = idx / 384, rem = idx % 384, z = rem >> 7, c = rem & 127;
                co[r * 1536 + z * 512 + hh * 128 + c] = bf2f(proj[(size_t)(rowbase + L - 3 + r) * NPROJ + z * 512 + hh * 128 + c]); }
        }
    }
}

constexpr int D2_QB = 0, D2_KB = 18432, D2_VU = 35840, D2_LM = 53248, D2_SM = 69632, D2_HALF = 70912;
__device__ __forceinline__ void delta_prep2(const Params& p, unsigned char* smem, int l, int piA, int piB) {
    const int tid = opaque_tid(), half = __builtin_amdgcn_readfirstlane(tid >> 8), t = tid & 255, lane = t & 63, wl = t >> 6, fr = lane & 15, fq = lane >> 4;
    const int pi = (half && piB >= 0) ? piB : piA;
    const bool prompt = pi < 2048;
    const int sid = prompt ? (pi >> 5) : (pi - 2048), n = prompt ? (pi & 31) : 0;
    const int b = sid >> 2, hh = sid & 3;
    const int rowbase = prompt ? b * SEQ : TP + b * 64, L = prompt ? SEQ : 64, t0 = n * 64;
    const bf16_t* proj = (const bf16_t*)(p.ws + WS_R2);
    const float* gb = (const float*)(p.ws + WS_GB);
    unsigned char* sb = smem + half * D2_HALF;
    bf16_t* QB = (bf16_t*)(sb + D2_QB); bf16_t* KTT = QB; bf16_t* KB = (bf16_t*)(sb + D2_KB); bf16_t* VUb = (bf16_t*)(sb + D2_VU); float* LM = (float*)(sb + D2_LM);
    float* sG = (float*)(sb + D2_SM); float* sgam = sG + 64; float* sbeta = sG + 128; float* stail = sG + 192; float* sbg = sG + 256;
    const float* convw = p.in[10] + l * 6144; const float* convb = p.in[11] + l * 1536;
    const float* cbuf = p.in[3] + ((size_t)l * 16 + b) * 3 * 1536;
    bf16_t* recWU = (bf16_t*)(p.ws + WS_H) + (size_t)pi * 16384;
    bf16_t* recQK = (bf16_t*)(p.ws + WS_QK) + (size_t)pi * 16384;
    unsigned char* recD = p.ws + WS_DD + (size_t)pi * 8448;
    if (t < 64) {
        const float g = gb[(size_t)(rowbase + t0 + t) * 8 + hh], be = gb[(size_t)(rowbase + t0 + t) * 8 + 4 + hh];
        float G = g;
#pragma unroll
        for (int o = 1; o < 64; o <<= 1) { const float tt = __shfl_up(G, o); if (lane >= o) G += tt; }
        const float Gl = __shfl(G, 63);
        sG[t] = G; sgam[t] = __expf(G); sbeta[t] = be; stail[t] = __expf(Gl - G); sbg[t] = be * __expf(G);
        ((float*)(recD + 8192))[t] = __expf(G);
    }
    __syncthreads();
    auto load_raw = [&](const int z, u32x4 (&raw)[4][4]) {
#pragma unroll
        for (int k = 0; k < 4; ++k) {
            const int item = t + 256 * k, row = item >> 4, seg = item & 15, cq = z * 512 + hh * 128 + seg * 8;
#pragma unroll
            for (int i = 0; i < 4; ++i) {
                const int tt = t0 + row - 3 + i;
                if (tt >= 0) raw[k][i] = *(const u32x4*)(proj + (size_t)(rowbase + tt) * NPROJ + cq);
                else if (!prompt) { const f32x4 c0 = *(const f32x4*)(cbuf + (3 + tt) * 1536 + cq), c1 = *(const f32x4*)(cbuf + (3 + tt) * 1536 + cq + 4);
                    raw[k][i].x = pk2(c0[0], c0[1]); raw[k][i].y = pk2(c0[2], c0[3]); raw[k][i].z = pk2(c1[0], c1[1]); raw[k][i].w = pk2(c1[2], c1[3]); }
                else raw[k][i] = (u32x4){0u, 0u, 0u, 0u};
            }
        }
    };
    auto conv_tensor = [&](const int z, const u32x4 (&raw)[4][4]) {
#pragma unroll
        for (int k = 0; k < 4; ++k) {
            const int item = t + 256 * k, row = item >> 4, seg = item & 15, cq = z * 512 + hh * 128 + seg * 8;
            float y[8];
            { const f32x4 b0 = *(const f32x4*)(convb + cq), b1 = *(const f32x4*)(convb + cq + 4); y[0] = b0[0]; y[1] = b0[1]; y[2] = b0[2]; y[3] = b0[3]; y[4] = b1[0]; y[5] = b1[1]; y[6] = b1[2]; y[7] = b1[3]; }
#pragma unroll
            for (int i = 0; i < 4; ++i) {
                float x[8]; unpack8(raw[k][i], x);
                const f32x4 w0 = *(const f32x4*)(convw + i * 1536 + cq), w1 = *(const f32x4*)(convw + i * 1536 + cq + 4);
                y[0] += w0[0] * x[0]; y[1] += w0[1] * x[1]; y[2] += w0[2] * x[2]; y[3] += w0[3] * x[3]; y[4] += w1[0] * x[4]; y[5] += w1[1] * x[5]; y[6] += w1[2] * x[6]; y[7] += w1[3] * x[7];
            }
            float ss = 0.f;
#pragma unroll
            for (int e = 0; e < 8; ++e) { y[e] = siluf(y[e]); ss += y[e] * y[e]; }
            if (z < 2) {
                ss = row_sum16(ss);
                const float sc = rsqrtf(ss + EPS) * (z == 0 ? 0.08838834764831845f : 1.f);
                u32x4 o; o.x = pk2(y[0] * sc, y[1] * sc); o.y = pk2(y[2] * sc, y[3] * sc); o.z = pk2(y[4] * sc, y[5] * sc); o.w = pk2(y[6] * sc, y[7] * sc);
                *(u32x4*)((z == 0 ? QB : KB) + row * 136 + seg * 8) = o;
            } else {
                const float be = sbeta[row];
                u32x4 o; o.x = pk2(y[0] * be, y[1] * be); o.y = pk2(y[2] * be, y[3] * be); o.z = pk2(y[4] * be, y[5] * be); o.w = pk2(y[6] * be, y[7] * be);
                *(u32x4*)(VUb + row * 136 + seg * 8) = o;
            }
        }
    };
    {
        u32x4 rawA[4][4], rawB[4][4];
        load_raw(0, rawA); load_raw(1, rawB);
        conv_tensor(0, rawA);
        load_raw(2, rawA);
        conv_tensor(1, rawB);
        conv_tensor(2, rawA);
    }
    __syncthreads();
    {
        const int ct = wl; bf16_t* qkd_g = (bf16_t*)recD;
#pragma unroll 1
        for (int st = 0; st < 4; ++st) {
            f32x4 akk = (f32x4){0.f, 0.f, 0.f, 0.f}, aqk = (f32x4){0.f, 0.f, 0.f, 0.f};
#pragma unroll
            for (int ks = 0; ks < 4; ++ks) {
                const bf16x8 xk = *(const bf16x8*)(KB + (16 * ct + fr) * 136 + 32 * ks + 8 * fq);
                const bf16x8 xq = *(const bf16x8*)(QB + (16 * ct + fr) * 136 + 32 * ks + 8 * fq);
                const bf16x8 yk = *(const bf16x8*)(KB + (16 * st + fr) * 136 + 32 * ks + 8 * fq);
                akk = MFMA16(xk, yk, akk); aqk = MFMA16(xq, yk, aqk);
            }
            const int s = 16 * st + fr; const float Gs = sG[s];
#pragma unroll
            for (int j = 0; j < 4; ++j) {
                const int c = 16 * ct + 4 * fq + j; const float dec = __expf(fminf(sG[c] - Gs, 0.f));
                LM[c * 64 + s] = (c > s) ? sbeta[c] * dec * akk[j] : 0.f;
                qkd_g[c * 64 + s] = f2bf((c >= s) ? dec * aqk[j] : 0.f);
            }
        }
    }
    __syncthreads();
#pragma unroll
    for (int k = 0; k < 4; ++k) { const int idx = t + 256 * k, row = idx >> 4, sg = idx & 15; *(u32x4*)(recQK + row * 128 + sg * 8) = *(const u32x4*)(QB + row * 136 + sg * 8); }
    __syncthreads();
#pragma unroll
    for (int k = 0; k < 4; ++k) {
        const int item = t + 256 * k, row = item >> 4, seg = item & 15;
        float x[8]; unpack8(*(const u32x4*)(KB + row * 136 + seg * 8), x);
        const float tl = stail[row];
#pragma unroll
        for (int e = 0; e < 8; ++e) KTT[(seg * 8 + e) * 72 + row] = f2bf(x[e] * tl);
    }
    __syncthreads();
    int vzero; asm volatile("v_mov_b32 %0, 0" : "=v"(vzero));
    if (vzero == 0) {
        float x[64];
        const bool isv = t < 128; const int d = t - 128;
        const float* LMv = LM + vzero;
        bf16_t* col = isv ? (VUb + t) : (KB + d);
#pragma unroll
        for (int c = 0; c < 64; ++c) x[c] = bf2f(col[c * 136]) * (isv ? 1.f : sbg[c]);
#pragma unroll
        for (int c = 1; c < 64; ++c) {
            float r0 = x[c], r1 = 0.f;
#pragma unroll
            for (int s4 = 0; s4 < (c + 3) / 4; ++s4) {
                const f32x4 lv = *(const f32x4*)(LMv + c * 64 + 4 * s4);
                r0 -= lv[0] * x[4 * s4]; r1 -= lv[1] * x[4 * s4 + 1]; r0 -= lv[2] * x[4 * s4 + 2]; r1 -= lv[3] * x[4 * s4 + 3];
            }
            x[c] = r0 + r1;
            if ((c & 3) == 3) __builtin_amdgcn_sched_barrier(0);
        }
#pragma unroll
        for (int c = 0; c < 64; ++c) col[c * 136] = f2bf(x[c]);
    }
    __syncthreads();
#pragma unroll
    for (int k = 0; k < 4; ++k) {
        const int idx = t + 256 * k, row = idx >> 4, sg = idx & 15;
        *(u32x4*)(recWU + row * 128 + sg * 8) = *(const u32x4*)(KB + row * 136 + sg * 8);
        *(u32x4*)(recWU + 8192 + row * 128 + sg * 8) = *(const u32x4*)(VUb + row * 136 + sg * 8);
        const int r2 = idx >> 3, s8 = idx & 7;
        *(u32x4*)(recQK + 8192 + r2 * 64 + s8 * 8) = *(const u32x4*)(KTT + r2 * 72 + s8 * 8);
    }
    if (n == (prompt ? 31 : 0)) {
        float* co = p.out + (prompt ? O_PQC : O_SQC) + ((size_t)l * 16 + b) * 3 * 1536;
        for (int idx = t; idx < 1152; idx += 256) { const int r = idx / 384, rem = idx % 384, z = rem >> 7, c = rem & 127;
            co[r * 1536 + z * 512 + hh * 128 + c] = bf2f(proj[(size_t)(rowbase + L - 3 + r) * NPROJ + z * 512 + hh * 128 + c]); }
    }
}

constexpr int SC_WB = 0, SC_UB = 17408, SC_QB = 34816, SC_KTT = 52224, SC_QKD = 70656, SC_DT = 79872, SC_STB = 98304, SC_SM = 133120;
__device__ __forceinline__ void delta_scan(const Params& p, unsigned char* smem, int l, int sid) {
    const int tid = opaque_tid(), lane = tid & 63, w = tid >> 6, fr = lane & 15, fq = lane >> 4;
    const bool prompt = sid < 64;
    const int s2 = prompt ? sid : sid - 64, b = s2 >> 2, hh = s2 & 3;
    const int rowbase = prompt ? b * SEQ : TP + b * 64, nch = prompt ? 32 : 1, pi0 = prompt ? s2 * 32 : 2048 + s2;
    bf16_t* proj = (bf16_t*)(p.ws + WS_R2);
    bf16_t* WB = (bf16_t*)(smem + SC_WB); bf16_t* UB = (bf16_t*)(smem + SC_UB); bf16_t* QB = (bf16_t*)(smem + SC_QB); bf16_t* KTT = (bf16_t*)(smem + SC_KTT);
    bf16_t* QKD = (bf16_t*)(smem + SC_QKD); bf16_t* DT = (bf16_t*)(smem + SC_DT) + w * 16 * 72; bf16_t* STB = (bf16_t*)(smem + SC_STB);
    float* sgam = (float*)(smem + SC_SM); float* osq = sgam + 64;
    f32x4 accS[8];
    if (prompt) {
#pragma unroll
        for (int dt = 0; dt < 8; ++dt) accS[dt] = (f32x4){0.f, 0.f, 0.f, 0.f};
    } else {
        const float* s0 = p.in[2] + (((size_t)l * 16 + b) * 4 + hh) * 16384;
#pragma unroll
        for (int dt = 0; dt < 8; ++dt)
#pragma unroll
            for (int j = 0; j < 4; ++j) accS[dt][j] = s0[(16 * dt + 4 * fq + j) * 128 + 16 * w + fr];
    }
#pragma unroll
    for (int dt = 0; dt < 8; ++dt) { u32x2 o; o.x = pk2(accS[dt][0], accS[dt][1]); o.y = pk2(accS[dt][2], accS[dt][3]); *(u32x2*)(STB + (16 * w + fr) * 136 + 16 * dt + 4 * fq) = o; }
    u32x4 pre[9]; float pgam = 0.f; bf16_t zr[16];
    auto load_chunk = [&](int n) {
        const size_t pi = (size_t)(pi0 + n);
        const u32x4* wu = (const u32x4*)((const bf16_t*)(p.ws + WS_H) + pi * 16384);
        const u32x4* qk = (const u32x4*)((const bf16_t*)(p.ws + WS_QK) + pi * 16384);
        const unsigned char* dd = p.ws + WS_DD + pi * 8448;
#pragma unroll
        for (int k = 0; k < 4; ++k) pre[k] = wu[tid + 512 * k];
#pragma unroll
        for (int k = 0; k < 4; ++k) pre[4 + k] = qk[tid + 512 * k];
        pre[8] = ((const u32x4*)dd)[tid];
        if (tid < 64) pgam = ((const float*)(dd + 8192))[tid];
#pragma unroll
        for (int ct = 0; ct < 4; ++ct)
#pragma unroll
            for (int j = 0; j < 4; ++j) zr[ct * 4 + j] = proj[(size_t)(rowbase + n * 64 + 16 * ct + 4 * fq + j) * NPROJ + C_AZ + hh * 128 + 16 * w + fr];
    };
    load_chunk(0);
    const float an = p.in[14][l * 128 + 16 * w + fr];
    for (int n = 0; n < nch; ++n) {
        const int t0 = n * 64;
#pragma unroll
        for (int k = 0; k < 2; ++k) {
            const int idx = tid + 512 * k, row = idx >> 4, sg = idx & 15;
            *(u32x4*)(WB + row * 136 + sg * 8) = pre[k];
            *(u32x4*)(UB + row * 136 + sg * 8) = pre[2 + k];
            *(u32x4*)(QB + row * 136 + sg * 8) = pre[4 + k];
            const int r2 = idx >> 3, s8 = idx & 7;
            *(u32x4*)(KTT + r2 * 72 + s8 * 8) = pre[6 + k];
        }
        { const int r2 = tid >> 3, s8 = tid & 7; *(u32x4*)(QKD + r2 * 72 + s8 * 8) = pre[8]; }
        if (tid < 64) sgam[tid] = pgam;
        bf16_t zc[16];
#pragma unroll
        for (int i = 0; i < 16; ++i) zc[i] = zr[i];
        __syncthreads();
        if (n + 1 < nch) load_chunk(n + 1);
        f32x4 oacc[4];
        {
            bf16x8 ysb[4];
#pragma unroll
            for (int ks = 0; ks < 4; ++ks) ysb[ks] = *(const bf16x8*)(STB + (16 * w + fr) * 136 + 32 * ks + 8 * fq);
#pragma unroll
            for (int ct = 0; ct < 4; ++ct) {
                f32x4 a = (f32x4){0.f, 0.f, 0.f, 0.f};
#pragma unroll
                for (int ks = 0; ks < 4; ++ks) a = MFMA16(*(const bf16x8*)(WB + (16 * ct + fr) * 136 + 32 * ks + 8 * fq), ysb[ks], a);
                float dl[4];
#pragma unroll
                for (int j = 0; j < 4; ++j) dl[j] = bf2f(UB[(16 * ct + 4 * fq + j) * 136 + 16 * w + fr]) - a[j];
                u32x2 o; o.x = pk2(dl[0], dl[1]); o.y = pk2(dl[2], dl[3]);
                *(u32x2*)(DT + fr * 72 + 16 * ct + 4 * fq) = o;
            }
            asm volatile("s_waitcnt lgkmcnt(0)" ::: "memory");
            bf16x8 ydt[2];
#pragma unroll
            for (int ks = 0; ks < 2; ++ks) ydt[ks] = *(const bf16x8*)(DT + fr * 72 + 32 * ks + 8 * fq);
#pragma unroll
            for (int ct = 0; ct < 4; ++ct) {
                f32x4 a1 = (f32x4){0.f, 0.f, 0.f, 0.f}, a2 = (f32x4){0.f, 0.f, 0.f, 0.f};
#pragma unroll
                for (int ks = 0; ks < 4; ++ks) a1 = MFMA16(*(const bf16x8*)(QB + (16 * ct + fr) * 136 + 32 * ks + 8 * fq), ysb[ks], a1);
#pragma unroll
                for (int ks = 0; ks < 2; ++ks) a2 = MFMA16(*(const bf16x8*)(QKD + (16 * ct + fr) * 72 + 32 * ks + 8 * fq), ydt[ks], a2);
#pragma unroll
                for (int j = 0; j < 4; ++j) {
                    const float o = sgam[16 * ct + 4 * fq + j] * a1[j] + a2[j];
                    oacc[ct][j] = o;
                    const float sq = row_sum16(o * o);
                    if (fr == 0) osq[w * 64 + 16 * ct + 4 * fq + j] = sq;
                }
                __builtin_amdgcn_sched_barrier(0);
            }
            const float gl = sgam[63];
#pragma unroll
            for (int dt = 0; dt < 8; ++dt) {
                f32x4 a = accS[dt] * gl;
#pragma unroll
                for (int ks = 0; ks < 2; ++ks) a = MFMA16(*(const bf16x8*)(KTT + (16 * dt + fr) * 72 + 32 * ks + 8 * fq), ydt[ks], a);
                accS[dt] = a;
                u32x2 o; o.x = pk2(a[0], a[1]); o.y = pk2(a[2], a[3]);
                *(u32x2*)(STB + (16 * w + fr) * 136 + 16 * dt + 4 * fq) = o;
                if (dt & 1) __builtin_amdgcn_sched_barrier(0);
            }
        }
        __syncthreads();
#pragma unroll
        for (int ct = 0; ct < 4; ++ct)
#pragma unroll
            for (int j = 0; j < 4; ++j) {
                const int c = 16 * ct + 4 * fq + j;
                float tot = 0.f;
#pragma unroll
                for (int ww = 0; ww < 8; ++ww) tot += osq[ww * 64 + c];
                const float zz = bf2f(zc[ct * 4 + j]);
                proj[(size_t)(rowbase + t0 + c) * NPROJ + C_AZ + hh * 128 + 16 * w + fr] = f2bf(oacc[ct][j] * rsqrtf(tot * (1.f / 128.f) + EPS) * an * siluf(zz));
            }
    }
    {
        float* so = p.out + (prompt ? O_PSD : O_SSD) + (((size_t)l * 16 + b) * 4 + hh) * 16384;
#pragma unroll
        for (int dt = 0; dt < 8; ++dt)
#pragma unroll
            for (int j = 0; j < 4; ++j) so[(16 * dt + 4 * fq + j) * 128 + 16 * w + fr] = accS[dt][j];
    }
    __syncthreads();
}

constexpr int AT_KS = 0, AT_VT = 34816, AT_OB = 71680;
__device__ __forceinline__ void attn_item(const Params& p, unsigned char* smem, int l, bool prompt, int b, int hh, int qc, float lam, float lam_init) {
    const int tid = opaque_tid(), lane = tid & 63, w = tid >> 6, fr = lane & 15, fq = lane >> 4, map = w >> 2, rb = w & 3;
    const bf16_t* proj = (const bf16_t*)(p.ws + WS_R2);
    bf16_t* mixed = (bf16_t*)(p.ws + WS_R2);
    const int row0 = prompt ? b * SEQ + qc * 64 : TP + b * 64;
    const int nt = prompt ? qc + 1 : 33;
    const float* ck = p.in[4] + ((size_t)l * 16 + b) * 2048 * 512 + hh * 128;
    const float* cv = p.in[5] + ((size_t)l * 16 + b) * 2048 * 512 + hh * 128;
    bf16_t* Ks = (bf16_t*)(smem + AT_KS); bf16_t* Vt = (bf16_t*)(smem + AT_VT); float* ob = (float*)(smem + AT_OB);
    bf16x8 qf[2];
#pragma unroll
    for (int ks = 0; ks < 2; ++ks) qf[ks] = *(const bf16x8*)(proj + (size_t)(row0 + rb * 16 + fr) * NPROJ + C_BQ + hh * 128 + map * 64 + 32 * ks + 8 * fq);
    const int lkey = tid >> 3, lseg = tid & 7;
    const int vkp = tid >> 4, ves = tid & 15;
    u32x4 rk[2], rv[2];
    auto load_tile = [&](int t) {
        if (prompt || t == 32) {
            const size_t rbase = prompt ? (size_t)(b * SEQ + t * 64) : (size_t)(TP + b * 64);
            const bf16_t* src = proj + (rbase + lkey) * NPROJ + hh * 128 + lseg * 16;
            rk[0] = *(const u32x4*)(src + C_BK); rk[1] = *(const u32x4*)(src + C_BK + 8);
            const bf16_t* sv = proj + (rbase + 2 * vkp) * NPROJ + C_BV + hh * 128 + ves * 8;
            rv[0] = *(const u32x4*)sv; rv[1] = *(const u32x4*)(sv + NPROJ);
        } else {
            const size_t o = (size_t)(t * 64 + lkey) * 512 + lseg * 16;
#pragma unroll
            for (int i = 0; i < 2; ++i) {
                const f32x4 a = *(const f32x4*)(ck + o + 8 * i), c = *(const f32x4*)(ck + o + 8 * i + 4);
                rk[i].x = pk2(a[0], a[1]); rk[i].y = pk2(a[2], a[3]); rk[i].z = pk2(c[0], c[1]); rk[i].w = pk2(c[2], c[3]);
                const size_t ov = (size_t)(t * 64 + 2 * vkp + i) * 512 + ves * 8;
                const f32x4 a2 = *(const f32x4*)(cv + ov), c2 = *(const f32x4*)(cv + ov + 4);
                rv[i].x = pk2(a2[0], a2[1]); rv[i].y = pk2(a2[2], a2[3]); rv[i].z = pk2(c2[0], c2[1]); rv[i].w = pk2(c2[2], c2[3]);
            }
        }
    };
    auto store_tile = [&](int buf) {
        bf16_t* kd = Ks + buf * 64 * 136 + lkey * 136 + lseg * 16;
        *(u32x4*)kd = rk[0]; *(u32x4*)(kd + 8) = rk[1];
        unsigned* vd = (unsigned*)(Vt + buf * 128 * 72 + (ves * 8) * 72) + (vkp ^ (2 * ves));
        const unsigned a0 = rv[0].x, a1 = rv[0].y, a2 = rv[0].z, a3 = rv[0].w, b0 = rv[1].x, b1 = rv[1].y, b2 = rv[1].z, b3 = rv[1].w;
        vd[0 * 36] = __builtin_amdgcn_perm(b0, a0, 0x05040100u); vd[1 * 36] = __builtin_amdgcn_perm(b0, a0, 0x07060302u);
        vd[2 * 36] = __builtin_amdgcn_perm(b1, a1, 0x05040100u); vd[3 * 36] = __builtin_amdgcn_perm(b1, a1, 0x07060302u);
        vd[4 * 36] = __builtin_amdgcn_perm(b2, a2, 0x05040100u); vd[5 * 36] = __builtin_amdgcn_perm(b2, a2, 0x07060302u);
        vd[6 * 36] = __builtin_amdgcn_perm(b3, a3, 0x05040100u); vd[7 * 36] = __builtin_amdgcn_perm(b3, a3, 0x07060302u);
    };
    f32x4 oacc[8];
#pragma unroll
    for (int et = 0; et < 8; ++et) oacc[et] = (f32x4){0.f, 0.f, 0.f, 0.f};
    float m_run = -INFINITY, l_run = 0.f;
    const float cs = 0.125f * 1.4426950408889634f;
    load_tile(0); store_tile(0);
    __syncthreads();
    asm volatile("" : "+v"(qf[0]), "+v"(qf[1]));
    for (int t = 0; t < nt; ++t) {
        const int buf = t & 1;
        if (t + 1 < nt) load_tile(t + 1);
        const bf16_t* kb = Ks + buf * 64 * 136; const bf16_t* vb = Vt + buf * 128 * 72;
        f32x4 sacc[4];
#pragma unroll
        for (int kt = 0; kt < 4; ++kt) {
            f32x4 a = (f32x4){0.f, 0.f, 0.f, 0.f};
#pragma unroll
            for (int ks = 0; ks < 2; ++ks) a = MFMA16(*(const bf16x8*)(kb + (16 * kt + fr) * 136 + map * 64 + 32 * ks + 8 * fq), qf[ks], a);
            sacc[kt] = a;
        }
        float mx = sacc[0][0];
#pragma unroll
        for (int kt = 0; kt < 4; ++kt)
#pragma unroll
            for (int j = 0; j < 4; ++j) mx = fmaxf(mx, sacc[kt][j]);
        mx = fmaxf(mx, __shfl_xor(mx, 16)); mx = fmaxf(mx, __shfl_xor(mx, 32));
        const float m_new = fmaxf(m_run, mx);
        const float alpha = __builtin_amdgcn_exp2f((m_run - m_new) * cs);
        m_run = m_new;
        float psum = 0.f;
        bf16x8 pf[2];
#pragma unroll
        for (int ks = 0; ks < 2; ++ks) {
            float pv[8];
#pragma unroll
            for (int i = 0; i < 8; ++i) { pv[i] = __builtin_amdgcn_exp2f((sacc[2 * ks + (i >> 2)][i & 3] - m_new) * cs); psum += pv[i]; }
            u32x4 pk; pk.x = pk2(pv[0], pv[1]); pk.y = pk2(pv[2], pv[3]); pk.z = pk2(pv[4], pv[5]); pk.w = pk2(pv[6], pv[7]);
            pf[ks] = __builtin_bit_cast(bf16x8, pk);
        }
        l_run = l_run * alpha + psum;
#pragma unroll
        for (int et = 0; et < 8; ++et) {
            f32x4 a = oacc[et] * alpha;
#pragma unroll
            for (int ks = 0; ks < 2; ++ks) {
                const int sw = 2 * (2 * et + (fr >> 3));
                const bf16x4 v0 = *(const bf16x4*)(vb + (16 * et + fr) * 72 + 2 * ((16 * ks + 2 * fq) ^ sw));
                const bf16x4 v1 = *(const bf16x4*)(vb + (16 * et + fr) * 72 + 2 * ((16 * ks + 8 + 2 * fq) ^ sw));
                const bf16x8 vx = __builtin_shufflevector(v0, v1, 0, 1, 2, 3, 4, 5, 6, 7);
                a = MFMA16(vx, pf[ks], a);
            }
            oacc[et] = a;
        }
        if (t + 1 < nt) store_tile(buf ^ 1);
        __syncthreads();
    }
    float lt = l_run; lt += __shfl_xor(lt, 16); lt += __shfl_xor(lt, 32);
    const float inv = 1.f / lt;
    const int q = rb * 16 + fr;
    if (map == 1) {
#pragma unroll
        for (int et = 0; et < 8; ++et)
#pragma unroll
            for (int j = 0; j < 4; ++j) ob[q * 129 + 16 * et + 4 * fq + j] = oacc[et][j] * inv * lam;
    }
    __syncthreads();
    if (map == 0) {
        float ss = 0.f;
#pragma unroll
        for (int et = 0; et < 8; ++et)
#pragma unroll
            for (int j = 0; j < 4; ++j) { const float o = oacc[et][j] * inv - ob[q * 129 + 16 * et + 4 * fq + j]; oacc[et][j] = o; ss += o * o; }
        ss += __shfl_xor(ss, 16); ss += __shfl_xor(ss, 32);
        const float sc = rsqrtf(ss * (1.f / 128.f) + EPS) * (1.f - lam_init);
        const float* bn = p.in[16] + l * 128;
#pragma unroll
        for (int et = 0; et < 8; ++et) {
            const int e = 16 * et + 4 * fq; const f32x4 g4 = *(const f32x4*)(bn + e);
            u32x2 o; o.x = pk2(oacc[et][0] * sc * g4[0], oacc[et][1] * sc * g4[1]); o.y = pk2(oacc[et][2] * sc * g4[2], oacc[et][3] * sc * g4[3]);
            *(u32x2*)(mixed + (size_t)(row0 + q) * NPROJ + C_BQ + hh * 128 + e) = o;
        }
    }
}

constexpr int PL_XS = 0, PL_PB = 40448;
__device__ __forceinline__ void pool_item(const Params& p, unsigned char* smem, int l, int pt, int gi) {
    const int tid = opaque_tid(), lane = tid & 63, w = tid >> 6, fr = lane & 15, fq = lane >> 4;
    const bf16_t* proj = (const bf16_t*)(p.ws + WS_R2);
    bf16_t* mixed = (bf16_t*)(p.ws + WS_R2);
    const int r0 = pt * 64; const bool prompt = r0 < TP;
    const int b = prompt ? (r0 >> 11) : ((r0 - TP) >> 6), t0 = prompt ? (r0 & 2047) : 0;
    float* xs = (float*)(smem + PL_XS); bf16_t* pb = (bf16_t*)(smem + PL_PB);
    const float* cpool = p.in[6] + ((size_t)l * 16 + b) * 15 * 512 + gi * 128;
    {
        u32x4 raw[3]; f32x4 ca[3], cc[3];
#pragma unroll
        for (int k = 0; k < 3; ++k) {
            const int idx = tid + 512 * k, rr = idx >> 4, sg = idx & 15, tt = t0 + rr - 15;
            raw[k] = (u32x4){0u, 0u, 0u, 0u}; ca[k] = (f32x4){0.f, 0.f, 0.f, 0.f}; cc[k] = ca[k];
            if (idx < 79 * 16) {
                if (tt >= 0) raw[k] = *(const u32x4*)(proj + (size_t)(r0 + rr - 15) * NPROJ + C_CX + gi * 128 + sg * 8);
                else if (!prompt) { ca[k] = *(const f32x4*)(cpool + (15 + tt) * 512 + sg * 8); cc[k] = *(const f32x4*)(cpool + (15 + tt) * 512 + sg * 8 + 4); }
            }
        }
#pragma unroll
        for (int k = 0; k < 3; ++k) {
            const int idx = tid + 512 * k, rr = idx >> 4, sg = idx & 15, tt = t0 + rr - 15;
            if (idx < 79 * 16) {
                float x[8];
                if (tt >= 0) unpack8(raw[k], x);
                else { x[0] = ca[k][0]; x[1] = ca[k][1]; x[2] = ca[k][2]; x[3] = ca[k][3]; x[4] = cc[k][0]; x[5] = cc[k][1]; x[6] = cc[k][2]; x[7] = cc[k][3]; }
                *(f32x4*)(xs + rr * 128 + sg * 8) = (f32x4){x[0], x[1], x[2], x[3]}; *(f32x4*)(xs + rr * 128 + sg * 8 + 4) = (f32x4){x[4], x[5], x[6], x[7]};
            }
        }
    }
    __syncthreads();
    const int win = 2 << gi;
    {
        const int c = tid & 127, tf = (tid >> 7) * 16;
        float s = 0.f;
        for (int j = 0; j < win; ++j) s += xs[(15 + tf - j) * 128 + c];
#pragma unroll 4
        for (int tt = 0; tt < 16; ++tt) {
            const int t = tf + tt; const float xt = xs[(15 + t) * 128 + c];
            if (tt > 0) s += xt - xs[(15 + t - win) * 128 + c];
            const int cnt = prompt ? min(t0 + t + 1, win) : win;
            pb[t * 136 + c] = f2bf(s / (float)cnt - xt);
        }
    }
    if (!prompt || t0 == SEQ - 64) {
        float* po = p.out + (prompt ? O_PPOOL : O_SPOOL) + ((size_t)l * 16 + b) * 15 * 512 + gi * 128;
        for (int idx = tid; idx < 15 * 128; idx += 512) { const int rr = idx >> 7, c = idx & 127; po[rr * 512 + c] = xs[(15 + 49 + rr) * 128 + c]; }
    }
    __syncthreads();
    const bf16_t* cw = (const bf16_t*)(p.ws + WS_CW) + ((size_t)l * 4 + gi) * 16384;
    bf16x8 yf[4];
#pragma unroll
    for (int ks = 0; ks < 4; ++ks) yf[ks] = *(const bf16x8*)(cw + (16 * w + fr) * 128 + 32 * ks + 8 * fq);
    const f32x4 sc4 = *(const f32x4*)(p.in[18] + l * 512 + gi * 128 + 16 * w + 4 * fq);
#pragma unroll
    for (int tt = 0; tt < 4; ++tt) {
        f32x4 a = (f32x4){0.f, 0.f, 0.f, 0.f};
#pragma unroll
        for (int ks = 0; ks < 4; ++ks) a = MFMA16(yf[ks], *(const bf16x8*)(pb + (16 * tt + fr) * 136 + 32 * ks + 8 * fq), a);
        u32x2 o; o.x = pk2(a[0] * sc4[0], a[1] * sc4[1]); o.y = pk2(a[2] * sc4[2], a[3] * sc4[3]);
        *(u32x2*)(mixed + (size_t)(r0 + 16 * tt + fr) * NPROJ + C_PO + gi * 128 + 16 * w + 4 * fq) = o;
    }
}

constexpr int PL2_HALF = 58368;
__device__ __forceinline__ void pool_item2(const Params& p, unsigned char* smem, int l, int itA) {
    const int tid = opaque_tid(), half = __builtin_amdgcn_readfirstlane(tid >> 8), t = tid & 255, lane = t & 63, wl = t >> 6, fr = lane & 15, fq = lane >> 4;
    const int item = itA + half, pt = item >> 2, gi = item & 3;
    const bf16_t* proj = (const bf16_t*)(p.ws + WS_R2);
    bf16_t* mixed = (bf16_t*)(p.ws + WS_R2);
    const int r0 = pt * 64; const bool prompt = r0 < TP;
    const int b = prompt ? (r0 >> 11) : ((r0 - TP) >> 6), t0 = prompt ? (r0 & 2047) : 0;
    float* xs = (float*)(smem + half * PL2_HALF); bf16_t* pb = (bf16_t*)(smem + half * PL2_HALF + 40448);
    const float* cpool = p.in[6] + ((size_t)l * 16 + b) * 15 * 512 + gi * 128;
    {
        u32x4 raw[5]; f32x4 ca[5], cc[5];
#pragma unroll
        for (int k = 0; k < 5; ++k) {
            const int idx = t + 256 * k, rr = idx >> 4, sg = idx & 15, tt = t0 + rr - 15;
            raw[k] = (u32x4){0u, 0u, 0u, 0u}; ca[k] = (f32x4){0.f, 0.f, 0.f, 0.f}; cc[k] = ca[k];
            if (idx < 79 * 16) {
                if (tt >= 0) raw[k] = *(const u32x4*)(proj + (size_t)(r0 + rr - 15) * NPROJ + C_CX + gi * 128 + sg * 8);
                else if (!prompt) { ca[k] = *(const f32x4*)(cpool + (15 + tt) * 512 + sg * 8); cc[k] = *(const f32x4*)(cpool + (15 + tt) * 512 + sg * 8 + 4); }
            }
        }
#pragma unroll
        for (int k = 0; k < 5; ++k) {
            const int idx = t + 256 * k, rr = idx >> 4, sg = idx & 15, tt = t0 + rr - 15;
            if (idx < 79 * 16) {
                float x[8];
                if (tt >= 0) unpack8(raw[k], x);
                else { x[0] = ca[k][0]; x[1] = ca[k][1]; x[2] = ca[k][2]; x[3] = ca[k][3]; x[4] = cc[k][0]; x[5] = cc[k][1]; x[6] = cc[k][2]; x[7] = cc[k][3]; }
                *(f32x4*)(xs + rr * 128 + sg * 8) = (f32x4){x[0], x[1], x[2], x[3]}; *(f32x4*)(xs + rr * 128 + sg * 8 + 4) = (f32x4){x[4], x[5], x[6], x[7]};
            }
        }
    }
    __syncthreads();
    const int win = 2 << gi;
    {
        const int c = t & 127, tf = (t >> 7) * 32;
        float s = 0.f;
        for (int j = 0; j < win; ++j) s += xs[(15 + tf - j) * 128 + c];
#pragma unroll 4
        for (int tt = 0; tt < 32; ++tt) {
            const int tq = tf + tt; const float xt = xs[(15 + tq) * 128 + c];
            if (tt > 0) s += xt - xs[(15 + tq - win) * 128 + c];
            const int cnt = prompt ? min(t0 + tq + 1, win) : win;
            pb[tq * 136 + c] = f2bf(s / (float)cnt - xt);
        }
    }
    if (!prompt || t0 == SEQ - 64) {
        float* po = p.out + (prompt ? O_PPOOL : O_SPOOL) + ((size_t)l * 16 + b) * 15 * 512 + gi * 128;
        for (int idx = t; idx < 15 * 128; idx += 256) { const int rr = idx >> 7, c = idx & 127; po[rr * 512 + c] = xs[(15 + 49 + rr) * 128 + c]; }
    }
    __syncthreads();
    const bf16_t* cw = (const bf16_t*)(p.ws + WS_CW) + ((size_t)l * 4 + gi) * 16384;
#pragma unroll
    for (int dh = 0; dh < 2; ++dh) {
        const int dt = 2 * wl + dh;
        bf16x8 yf[4];
#pragma unroll
        for (int ks = 0; ks < 4; ++ks) yf[ks] = *(const bf16x8*)(cw + (16 * dt + fr) * 128 + 32 * ks + 8 * fq);
        const f32x4 sc4 = *(const f32x4*)(p.in[18] + l * 512 + gi * 128 + 16 * dt + 4 * fq);
#pragma unroll
        for (int tt = 0; tt < 4; ++tt) {
            f32x4 a = (f32x4){0.f, 0.f, 0.f, 0.f};
#pragma unroll
            for (int ks = 0; ks < 4; ++ks) a = MFMA16(yf[ks], *(const bf16x8*)(pb + (16 * tt + fr) * 136 + 32 * ks + 8 * fq), a);
            u32x2 o; o.x = pk2(a[0] * sc4[0], a[1] * sc4[1]); o.y = pk2(a[2] * sc4[2], a[3] * sc4[3]);
            *(u32x2*)(mixed + (size_t)(r0 + 16 * tt + fr) * NPROJ + C_PO + gi * 128 + 16 * dt + 4 * fq) = o;
        }
    }
}

constexpr int N_PREP = 1056, N_PL = 1056, N_AS = 64, N_AP = 2048, N_AP_A = 0;
__device__ __forceinline__ void phase_mix(const Params& p, unsigned char* smem, int l, const bool second) {
    const int tid = opaque_tid();
    const float lam_init = (l == 0) ? 0.2f : 0.35550906759096924f;
    float lam;
    { const float* bl = p.in[15] + l * 256; float s1 = 0.f, s2 = 0.f;
        for (int i = 0; i < 64; ++i) { s1 += bl[i] * bl[64 + i]; s2 += bl[128 + i] * bl[192 + i]; }
        lam = expf(s1) - expf(s2) + lam_init; }
    if (second) { for (int sid = blockIdx.x; sid < 128; sid += gridDim.x) delta_scan(p, smem, l, sid); }
    unsigned* ctr = (unsigned*)(p.ws + WS_CTL) + l * 2 + (second ? 1 : 0);
    int* s_item = (int*)(smem + LDS_BYTES - 16);
    const int nitems = second ? (N_AP - N_AP_A) : (N_PREP + N_AS + N_AP_A + N_PL);
    for (;;) {
        __syncthreads();
        if (tid == 0) *s_item = (int)atomicAdd(ctr, 1u);
        __syncthreads();
        int item = *s_item;
        if (item >= nitems) break;
        if (second) { item += N_AP_A; const int qc = 31 - (item >> 6), bh = item & 63; attn_item(p, smem, l, true, bh >> 2, bh & 3, qc, lam, lam_init); continue; }
        if (item < N_AS) { attn_item(p, smem, l, false, item >> 2, item & 3, 0, lam, lam_init); continue; }
        item -= N_AS;
        if (item < N_PREP) { const int i0 = 2 * item, i1 = 2 * item + 1, c0 = i0 >> 6, q0 = i0 & 63, c1 = i1 >> 6, q1 = i1 & 63;
            delta_prep2(p, smem, l, c0 < 32 ? q0 * 32 + c0 : 2048 + q0, c1 < 32 ? q1 * 32 + c1 : 2048 + q1); continue; }
        item -= N_PREP;
        if (item < N_AP_A) { const int qc = 31 - (item >> 6), bh = item & 63; attn_item(p, smem, l, true, bh >> 2, bh & 3, qc, lam, lam_init); continue; }
        item -= N_AP_A;
        pool_item2(p, smem, l, 2 * item);
    }
}

__device__ __forceinline__ void phase_ffnconv(const Params& p, int l) {
    bf16_t* u = (bf16_t*)(p.ws + WS_R2); const bf16_t* side = (const bf16_t*)(p.ws + WS_SIDE);
    const float* cw = p.in[22] + l * 3 * NFF2; const float* cb = p.in[23] + l * NFF2;
    const int nitems = 1056 * 352;
    const int tid0 = opaque_tid();
    for (int item = blockIdx.x * NTHREADS + tid0; item < nitems; item += gridDim.x * NTHREADS) {
        const int seg = item / 352, j = (item % 352) * 8;
        float wg[3][8], wv[3][8], bg[8], bv[8];
#pragma unroll
        for (int i = 0; i < 3; ++i) {
            const f32x4 a0 = *(const f32x4*)(cw + i * NFF2 + j), a1 = *(const f32x4*)(cw + i * NFF2 + j + 4), c0 = *(const f32x4*)(cw + i * NFF2 + NFF + j), c1 = *(const f32x4*)(cw + i * NFF2 + NFF + j + 4);
#pragma unroll
            for (int e = 0; e < 4; ++e) { wg[i][e] = a0[e]; wg[i][4 + e] = a1[e]; wv[i][e] = c0[e]; wv[i][4 + e] = c1[e]; }
        }
        { const f32x4 a0 = *(const f32x4*)(cb + j), a1 = *(const f32x4*)(cb + j + 4), c0 = *(const f32x4*)(cb + NFF + j), c1 = *(const f32x4*)(cb + NFF + j + 4);
#pragma unroll
            for (int e = 0; e < 4; ++e) { bg[e] = a0[e]; bg[4 + e] = a1[e]; bv[e] = c0[e]; bv[4 + e] = c1[e]; } }
        float g1[8], g2[8], v1[8], v2[8];
        const int r0 = seg * 32;
        if (r0 >= TP && ((r0 - TP) & 63) == 0) {
            const float* c = p.in[7] + ((size_t)l * 16 + ((r0 - TP) >> 6)) * 2 * NFF2;
#pragma unroll
            for (int e = 0; e < 8; ++e) { g1[e] = c[j + e]; v1[e] = c[NFF + j + e]; g2[e] = c[NFF2 + j + e]; v2[e] = c[NFF2 + NFF + j + e]; }
        } else if (r0 < TP && (r0 & 2047) == 0) {
#pragma unroll
            for (int e = 0; e < 8; ++e) { g1[e] = 0.f; g2[e] = 0.f; v1[e] = 0.f; v2[e] = 0.f; }
        } else {
            const bf16_t* sd = side + (size_t)(seg - 1) * 2 * NFF2;
            unpack8(*(const u32x4*)(sd + j), g1); unpack8(*(const u32x4*)(sd + NFF + j), v1); unpack8(*(const u32x4*)(sd + NFF2 + j), g2); unpack8(*(const u32x4*)(sd + NFF2 + NFF + j), v2);
        }
        bf16_t* ur = u + (size_t)r0 * NFF2 + j;
#pragma unroll 4
        for (int r = 0; r < 32; ++r) {
            float g3[8], v3[8];
            unpack8(*(const u32x4*)(ur + (size_t)r * NFF2), g3); unpack8(*(const u32x4*)(ur + (size_t)r * NFF2 + NFF), v3);
            float hh[8];
#pragma unroll
            for (int e = 0; e < 8; ++e) {
                const float cg = bg[e] + wg[0][e] * g1[e] + wg[1][e] * g2[e] + wg[2][e] * g3[e], cv = bv[e] + wv[0][e] * v1[e] + wv[1][e] * v2[e] + wv[2][e] * v3[e];
                hh[e] = siluf(cg) * cv; g1[e] = g2[e]; g2[e] = g3[e]; v1[e] = v2[e]; v2[e] = v3[e];
            }
            u32x4 o; o.x = pk2(hh[0], hh[1]); o.y = pk2(hh[2], hh[3]); o.z = pk2(hh[4], hh[5]); o.w = pk2(hh[6], hh[7]);
            *(u32x4*)(ur + (size_t)r * NFF2) = o;
        }
    }
}

template <int s> __device__ __forceinline__ void run_step(const Params& p, unsigned char* smem) {
    constexpr int l = s / 9, ph = s % 9;
    if constexpr (s == 18) { phase_norm(p, smem, 0, 2, 11, p.ws + WS_R2 + 5632, 11264); }
    else if constexpr (ph == 1 || ph == 4 || ph == 6 || ph == 8) {
        pg8::Gemm g; pg8::EpiAny E; bool perm = true;
        if constexpr (ph == 1) {
            g = pg8::Gemm{(const bf16_t*)(p.ws + WS_H), (const bf16_t*)(p.ws + WS_WIN) + (size_t)l * 4096 * 1024, T, NPN, 1024, 1024};
            E = pg8::EpiAny{0, l, p.ws + WS_R2, nullptr, p.out, 0};
        } else if constexpr (ph == 4) {
            g = pg8::Gemm{(const bf16_t*)(p.ws + WS_R2) + C_AZ, (const bf16_t*)(p.ws + WS_WOUT) + (size_t)l * 1024 * 1536, T, D, NMIX, NPROJ};
            E = pg8::EpiAny{1, l, (void*)(l == 0 ? p.in[0] : p.out), p.ws + WS_QK, p.out, 4096}; perm = false;
        } else if constexpr (ph == 6) {
            g = pg8::Gemm{(const bf16_t*)(p.ws + WS_H), (const bf16_t*)(p.ws + WS_WUP) + (size_t)l * NFF2 * 1024, T, NFF2, 1024, 1024};
            E = pg8::EpiAny{2, l, p.ws + WS_R2, p.ws + WS_SIDE, p.out, 0};
        } else {
            g = pg8::Gemm{(const bf16_t*)(p.ws + WS_R2), (const bf16_t*)(p.ws + WS_WDN) + (size_t)l * 1024 * NFF, T, D, NFF, NFF2};
            E = pg8::EpiAny{1, l, p.out, p.ws + WS_R2 + 5632, p.out, 11264}; perm = false;
        }
        pg8::StaticOrder S; S.init(g.M, g.N, g.K, gridDim.x, blockIdx.x, (ph == 4 || ph == 8) ? TSM : 0);
        pg8::gemm_phase((LAS unsigned char*)smem, g, S, E, perm);
    } else if constexpr (ph == 0) {
        if constexpr (l == 0) phase_weights(p, smem);
        if constexpr (l == 0) phase_norm(p, smem, l, 0); else phase_norm(p, smem, l, 0, 11, p.ws + WS_R2 + 5632, 11264);
    } else if constexpr (ph == 2) phase_mix(p, smem, l, false);
    else if constexpr (ph == 3) phase_mix(p, smem, l, true);
    else if constexpr (ph == 5) phase_norm(p, smem, l, 1, 6, p.ws + WS_QK, 4096);
    else phase_ffnconv(p, l);
}

#define XB_TMO      128
#define XB_XCNT(j)  (256  + 64 * (j))
#define XB_XSUB(j)  (1280 + 64 * (j))
#define XB_XGEN(j)  (2304 + 64 * (j))
#define XB_TOP      3328
#define XB_TOPGEN   3392
#define XCD_BAR_WORDS 3456
#define XB_SPIN_CAP (1u << 18)

__device__ __forceinline__ unsigned xb_ld(unsigned* p)              { return __hip_atomic_load(p, __ATOMIC_RELAXED, __HIP_MEMORY_SCOPE_AGENT); }
__device__ __forceinline__ unsigned xb_add(unsigned* p, unsigned v) { return __hip_atomic_fetch_add(p, v, __ATOMIC_RELAXED, __HIP_MEMORY_SCOPE_AGENT); }
__device__ __forceinline__ unsigned xb_xcc_id() { return (unsigned)__builtin_amdgcn_s_getreg((3 << 11) | 20) & 0xFu; }
#define XB_SPIN(cond, bar) do { unsigned _sp = 0; while (cond) { __builtin_amdgcn_s_sleep(1); \
    if ((++_sp & 255u) == 0u) { if (xb_ld(&(bar)[XB_TMO])) break; if (_sp > XB_SPIN_CAP) { atomicAdd(&(bar)[XB_TMO], 1u); break; } } } } while (0)

struct XcdBarrier {
    unsigned* bar; unsigned x;
    volatile LAS unsigned* st;
};

__device__ __forceinline__ XcdBarrier xcd_barrier_post(unsigned* bar, volatile LAS unsigned* st) {
    XcdBarrier b; b.bar = bar; b.x = xb_xcc_id(); b.st = st;
    if (threadIdx.x == 0) (void)xb_add(&bar[XB_XCNT(b.x)], 1u);
    return b;
}
__device__ __forceinline__ void xcd_barrier_complete(unsigned* bar, unsigned x, unsigned& nloc, unsigned& nx) {
    const unsigned G = gridDim.x * gridDim.y * gridDim.z;
    unsigned sum, cnt, mine, sp = 0u;
    for (;;) {
        sum = 0u; cnt = 0u; mine = 0u;
#pragma unroll
        for (unsigned j = 0; j < 16; ++j) { const unsigned c = xb_ld(&bar[XB_XCNT(j)]); sum += c; cnt += (c > 0u) ? 1u : 0u; mine = (j == x) ? c : mine; }
        if (sum == G) break;
        __builtin_amdgcn_s_sleep(1);
        if ((++sp & 255u) == 0u) { if (xb_ld(&bar[XB_TMO])) break; if (sp > XB_SPIN_CAP) { atomicAdd(&bar[XB_TMO], 1u); break; } }
    }
    nloc = mine > 0u ? mine : 1u; nx = cnt > 0u ? cnt : 1u;
}

__device__ __forceinline__ void xcd_barrier(const XcdBarrier& b) {
    asm volatile("s_waitcnt vmcnt(0)" ::: "memory");
    __syncthreads();
    if (threadIdx.x == 0) {
        unsigned* bar = b.bar;
        __builtin_amdgcn_s_waitcnt(0);
        unsigned nloc = b.st[0], nx = b.st[1];
        if (nloc == 0u) { xcd_barrier_complete(bar, b.x, nloc, nx); b.st[0] = nloc; b.st[1] = nx; }
        const unsigned old = xb_add(&bar[XB_XSUB(b.x)], 1u);
        const unsigned gen = old / nloc;
        if (old + 1u == (gen + 1u) * nloc) {
            __builtin_amdgcn_fence(__ATOMIC_RELEASE, "agent");
            asm volatile("s_waitcnt vmcnt(0)" ::: "memory");
            const unsigned og = xb_add(&bar[XB_TOP], 1u);
            const unsigned tg = og / nx;
            if (og + 1u == (tg + 1u) * nx) xb_add(&bar[XB_TOPGEN], 1u);
            else XB_SPIN(xb_ld(&bar[XB_TOPGEN]) == tg, bar);
            __builtin_amdgcn_fence(__ATOMIC_ACQUIRE, "agent");
            xb_add(&bar[XB_XGEN(b.x)], 1u);
            asm volatile("s_waitcnt vmcnt(0)" ::: "memory");
        } else {
            XB_SPIN(xb_ld(&bar[XB_XGEN(b.x)]) == gen, bar);
            __builtin_amdgcn_fence(__ATOMIC_ACQUIRE, "agent");
            asm volatile("s_waitcnt vmcnt(0)" ::: "memory");
        }
    }
    __syncthreads();
}


__global__ void __launch_bounds__(NTHREADS, 2) fwd_megakernel(Params p) {
    extern __shared__ __attribute__((aligned(16))) unsigned char smem[];
    cg::grid_group grid = cg::this_grid();
    volatile LAS unsigned* xst = (volatile LAS unsigned*)(LAS unsigned char*)(smem + LDS_BYTES - 8);
    if (blockIdx.x == 0) for (int i = threadIdx.x; i < 4096; i += NTHREADS) ((unsigned*)(p.ws + WS_CTL))[i] = 0u;
    if (threadIdx.x == 0) { xst[0] = 0u; xst[1] = 0u; }
    __syncthreads();
    run_step<0>(p, smem); grid.sync();
    const XcdBarrier xb = xcd_barrier_post((unsigned*)(p.ws + WS_BAR), xst);
    run_step<1>(p, smem); xcd_barrier(xb);  run_step<2>(p, smem); xcd_barrier(xb);  run_step<3>(p, smem); xcd_barrier(xb);
    run_step<4>(p, smem); xcd_barrier(xb);  run_step<5>(p, smem); xcd_barrier(xb);  run_step<6>(p, smem); xcd_barrier(xb);  run_step<7>(p, smem); xcd_barrier(xb);
    run_step<8>(p, smem); xcd_barrier(xb);  run_step<9>(p, smem); xcd_barrier(xb);  run_step<10>(p, smem); xcd_barrier(xb); run_step<11>(p, smem); xcd_barrier(xb);
    run_step<12>(p, smem); xcd_barrier(xb); run_step<13>(p, smem); xcd_barrier(xb); run_step<14>(p, smem); xcd_barrier(xb); run_step<15>(p, smem); xcd_barrier(xb);
    run_step<16>(p, smem); xcd_barrier(xb); run_step<17>(p, smem); xcd_barrier(xb); run_step<18>(p, smem);
}

extern "C" void kernel_launch(void* const* d_in, const int* in_sizes, int n_in, void* d_out, int out_size, void* d_ws, size_t ws_size, hipStream_t stream) {
    static int grid_blocks = 0;
    if (grid_blocks == 0) {
        if (n_in != 26 || ws_size < WS_END) { fprintf(stderr, "kernel_launch: unexpected problem (n_in %d, ws %zu < %zu)\n", n_in, ws_size, (size_t)WS_END); grid_blocks = -1; return; }
        int dev = 0, cus = 0, per_cu = 0;
        (void)hipGetDevice(&dev);
        (void)hipDeviceGetAttribute(&cus, hipDeviceAttributeMultiprocessorCount, dev);
        if (hipFuncSetAttribute((const void*)fwd_megakernel, hipFuncAttributeMaxDynamicSharedMemorySize, LDS_BYTES) != hipSuccess) { fprintf(stderr, "hipFuncSetAttribute failed\n"); grid_blocks = -1; return; }
        if (hipOccupancyMaxActiveBlocksPerMultiprocessor(&per_cu, (const void*)fwd_megakernel, NTHREADS, LDS_BYTES) != hipSuccess || per_cu < 1) { fprintf(stderr, "occupancy query failed (%d)\n", per_cu); (void)hipGetLastError(); per_cu = 1; }
        if (per_cu > 1) per_cu = 1;
        grid_blocks = cus * per_cu;
    }
    if (grid_blocks < 0) return;
    Params p{};
    for (int i = 0; i < 26; ++i) p.in[i] = (const float*)d_in[i];
    p.out = (float*)d_out; p.ws = (unsigned char*)d_ws;
    void* args[] = {&p};
    hipError_t e = hipLaunchCooperativeKernel((const void*)fwd_megakernel, dim3(grid_blocks), dim3(NTHREADS), args, LDS_BYTES, stream);
    if (e != hipSuccess) fprintf(stderr, "cooperative launch failed: %s (grid %d)\n", hipGetErrorString(e), grid_blocks);
}
```

```cpp
#include <hip/hip_runtime.h>
#include <hip/hip_cooperative_groups.h>
#include <cstdio>
#include <cstdint>
namespace cg = cooperative_groups;

#define LAS __attribute__((address_space(3)))
typedef unsigned short bf16_t;
typedef short bf16x8 __attribute__((ext_vector_type(8)));
typedef short bf16x4 __attribute__((ext_vector_type(4)));
typedef float f32x4 __attribute__((ext_vector_type(4)));
typedef unsigned u32x4 __attribute__((ext_vector_type(4)));
typedef unsigned u32x2 __attribute__((ext_vector_type(2)));

constexpr int D = 1024, TP = 32768, TSM = 1024, T = TP + TSM, SEQ = 2048;
constexpr int NPROJ = 4608, NPN = 4096, NMIX = 1536, NFF2 = 5632, NFF = 2816, INW = 4104;
constexpr float EPS = 1e-6f;
constexpr int C_BK = 1536, C_BV = 2048, C_CX = 2560, C_AZ = 3072, C_BQ = 3584, C_PO = 4096;
constexpr size_t O_YP = 0, O_YS = 33554432, O_PSD = 34603008, O_SSD = 36700160, O_PQC = 38797312, O_SQC = 38944768, O_PK = 39092224, O_SK = 72646656,
                 O_PV = 73695232, O_SV = 107249664, O_PPOOL = 108298240, O_SPOOL = 108544000, O_PFFN = 108789760, O_SFFN = 109150208;
constexpr size_t WS_CTL = 0, WS_BAR = 1024, WS_GB = 16384,
                 WS_WIN = WS_GB + (size_t)T * 8 * 4, WS_WOUT = WS_WIN + 2ull * 4096 * 1024 * 2, WS_WUP = WS_WOUT + 2ull * 1024 * 1536 * 2,
                 WS_WDN = WS_WUP + 2ull * 5632 * 1024 * 2, WS_CW = WS_WDN + 2ull * 1024 * 2816 * 2, WS_H = WS_CW + 2ull * 4 * 128 * 128 * 2,
                 WS_R2 = WS_H + (size_t)T * 1024 * 2, WS_QK = WS_R2 + (size_t)T * NPROJ * 2, WS_SIDE = WS_R2 + (size_t)T * NFF2 * 2, WS_DD = WS_SIDE,
                 WS_END = WS_SIDE + 1056ull * 2 * NFF2 * 2;
constexpr int LDS_BYTES = 155648;
constexpr int NTHREADS = 512;

struct Params { const float* in[26]; float* out; unsigned char* ws; };

__device__ __forceinline__ bf16_t f2bf(float f) { unsigned u = __float_as_uint(f); u += 0x7FFFu + ((u >> 16) & 1u); return (bf16_t)(u >> 16); }
__device__ __forceinline__ float bf2f(bf16_t b) { return __uint_as_float(((unsigned)b) << 16); }
typedef __bf16 bf16v2_t __attribute__((ext_vector_type(2)));
typedef float f32v2_t __attribute__((ext_vector_type(2)));
__device__ __forceinline__ unsigned pk2(float lo, float hi) { const f32v2_t f = {lo, hi}; const bf16v2_t r = __builtin_convertvector(f, bf16v2_t); return __builtin_bit_cast(unsigned, r); }
__device__ __forceinline__ float bflo(unsigned u) { return __uint_as_float(u << 16); }
__device__ __forceinline__ float bfhi(unsigned u) { return __uint_as_float(u & 0xFFFF0000u); }
__device__ __forceinline__ float siluf(float y) { return y * __builtin_amdgcn_rcpf(1.f + __expf(-y)); }
__device__ __forceinline__ int opaque_tid() { int t = threadIdx.x; asm volatile("" : "+v"(t)); return t; }
template <int CTRL> __device__ __forceinline__ float dpp_mov(float v) { return __builtin_bit_cast(float, __builtin_amdgcn_update_dpp(0, __builtin_bit_cast(int, v), CTRL, 0xF, 0xF, true)); }
__device__ __forceinline__ float row_sum16(float v) { v += dpp_mov<0xB1>(v); v += dpp_mov<0x4E>(v); v += dpp_mov<0x141>(v); v += dpp_mov<0x140>(v); return v; }
__device__ __forceinline__ float wave_sum64(float v) { v = row_sum16(v);
    return (__builtin_amdgcn_readlane(__builtin_bit_cast(int, v), 0) , __builtin_bit_cast(float, __builtin_amdgcn_readlane(__builtin_bit_cast(int, v), 0)) + __builtin_bit_cast(float, __builtin_amdgcn_readlane(__builtin_bit_cast(int, v), 16))
         + __builtin_bit_cast(float, __builtin_amdgcn_readlane(__builtin_bit_cast(int, v), 32)) + __builtin_bit_cast(float, __builtin_amdgcn_readlane(__builtin_bit_cast(int, v), 48))); }
#define MFMA16(a, b, c) __builtin_amdgcn_mfma_f32_16x16x32_bf16(a, b, c, 0, 0, 0)
__device__ __forceinline__ void unpack8(const u32x4 v, float* f) {
    f[0] = bflo(v.x); f[1] = bfhi(v.x); f[2] = bflo(v.y); f[3] = bfhi(v.y); f[4] = bflo(v.z); f[5] = bfhi(v.z); f[6] = bflo(v.w); f[7] = bfhi(v.w);
}

namespace pg8 {
constexpr int BM = 256, BK = 64, HALF = 128, HTB = HALF * BK * 2, STAGE_BYTES = 8 * HTB, NXCD = 8, WGM = 8;
__host__ __device__ __forceinline__ int lds_byte(int r, int c) { const int st = (r >> 4) * 2 + (c >> 5), rr = r & 15, cc = c & 31, ob = rr * 64 + cc * 2; return st * 1024 + (ob ^ (((ob >> 9) & 1) << 5)); }
__host__ __device__ __forceinline__ void stage_rc(int b, int& R, int& C) { const int st = b / 1024, sb = b % 1024, swz = sb ^ (((sb >> 9) & 1) << 5); R = (st >> 1) * 16 + swz / 64; C = (st & 1) * 32 + (swz % 64) / 2; }
__host__ __device__ __forceinline__ int perm32(int rho) { const int n = rho >> 4, i = rho & 15; return 8 * (i >> 2) + 4 * n + (i & 3); }
struct Unit { int pm, pn, k0, nt; };
struct Gemm { const bf16_t* A; const bf16_t* Bt; int M, N, K, lda; };
struct StaticOrder {
    int nM, nN, nwg, G, c, ntk, nslice, ntot;
    __device__ void init(int M, int N, int K, int G_, int c_, int split_rows) {
        nN = N / BM; G = G_; c = c_; ntk = K / BK;
        if (split_rows > 0) { nM = (M - split_rows) / BM; nslice = K / 256; nwg = nM * nN; ntot = nwg + (split_rows / BM) * nN * nslice; }
        else { nM = M / BM; nslice = 0; nwg = nM * nN; ntot = nwg; }
    }
    __device__ bool next(int i, Unit& u) const {
        const long L = (long)i * G + c; if (L >= ntot) return false;
        if (L >= nwg) { const int idx = (int)L - nwg, tile = idx / nslice, sl = idx - tile * nslice; u.pm = nM + tile / nN; u.pn = tile % nN; u.k0 = sl * 256; u.nt = 4; return true; }
        int wgid = (int)L; { const int q = nwg / NXCD, r = nwg % NXCD, xcd = wgid % NXCD, off = wgid / NXCD; wgid = (xcd < r ? xcd * (q + 1) : r * (q + 1) + (xcd - r) * q) + off; }
        const int nig = WGM * nN, gid = wgid / nig, fm = gid * WGM, gsz = (nM - fm) < WGM ? (nM - fm) : WGM;
        u.pm = fm + ((wgid % nig) % gsz); u.pn = (wgid % nig) / gsz; u.k0 = 0; u.nt = ntk; return true;
    }
};
__device__ __forceinline__ unsigned cvt_pk_bf16(float lo, float hi) { unsigned r; asm volatile("v_cvt_pk_bf16_f32 %0, %1, %2" : "=v"(r) : "v"(lo), "v"(hi)); return r; }

struct EpiAny;
__device__ __forceinline__ void run_epi(const EpiAny& E, const f32x4 (&acc)[2][2][4][2], const Unit& u, int wr, int wc, int fr, int fq);
__device__ __forceinline__ void gemm_phase(LAS unsigned char* lds, const Gemm g, const StaticOrder& S, const EpiAny& E, const bool perm) {
    const int tid = opaque_tid(), wid = __builtin_amdgcn_readfirstlane(tid >> 6), lane = tid & 63, wr = wid >> 2, wc = wid & 3, fr = lane & 15, fq = lane >> 4;
    const int K = g.K, lda = g.lda;
    unsigned voffA[2], voffB[2];
#pragma unroll
    for (int i = 0; i < 2; ++i) { int R, C; stage_rc(tid * 16 + i * 8192, R, C); const int Rb = perm ? ((R & ~31) + perm32(R & 31)) : R;
        voffA[i] = (unsigned)(R * lda + C) * 2u; voffB[i] = (unsigned)(Rb * K + C) * 2u; }
    const size_t kstep = (size_t)(BK * 2);
    const size_t hstepA = (size_t)HALF * lda * 2, hstepB = (size_t)HALF * K * 2;
    const size_t tstepA = 2 * hstepA, tstepB = 2 * hstepB;
    const unsigned ldsw = (unsigned)wid * 1024u;
    const int aoff = lds_byte(wr * 64 + fr, fq * 8), boff = lds_byte(wc * 32 + fr, fq * 8);
#define PG8_SA(b, h) (((b) * 2 + (h)) * HTB)
#define PG8_SB(b, h) ((4 + (b) * 2 + (h)) * HTB)
#define PG8_STAGE(bufoff, gbase, voff) do { _Pragma("unroll") for (int _i = 0; _i < 2; ++_i) \
        __builtin_amdgcn_global_load_lds((const unsigned*)((const char*)(gbase) + (voff)[_i]), (LAS unsigned*)(lds + (bufoff) + ldsw + _i * 8192), 16, 0, 0); } while (0)
#define PG8_LDA(dst, b, h) do { _Pragma("unroll") for (int m = 0; m < 4; ++m) _Pragma("unroll") for (int k = 0; k < 2; ++k) dst[m][k] = *(const LAS bf16x8*)(lds + PG8_SA(b, h) + aoff + m * 2048 + k * 1024); } while (0)
#define PG8_LDB(dst, b, h) do { _Pragma("unroll") for (int n = 0; n < 2; ++n) _Pragma("unroll") for (int k = 0; k < 2; ++k) dst[n][k] = *(const LAS bf16x8*)(lds + PG8_SB(b, h) + boff + n * 2048 + k * 1024); } while (0)
#define PG8_MMA(ai, bj, At, Bt) do { __builtin_amdgcn_s_setprio(1); _Pragma("unroll") for (int m = 0; m < 4; ++m) _Pragma("unroll") for (int n = 0; n < 2; ++n) _Pragma("unroll") for (int k = 0; k < 2; ++k) \
        acc[ai][bj][m][n] = __builtin_amdgcn_mfma_f32_16x16x32_bf16(Bt[n][k], At[m][k], acc[ai][bj][m][n], 0, 0, 0); __builtin_amdgcn_s_setprio(0); } while (0)
#define PG8_WAIT_V(n) asm volatile("s_waitcnt vmcnt(" #n ")" ::: "memory")
#define PG8_WAIT_L(n) asm volatile("s_waitcnt lgkmcnt(" #n ")" ::: "memory")
#define PG8_BAR __builtin_amdgcn_s_barrier()
#define PG8_SCHED __builtin_amdgcn_sched_barrier(0)
    Unit cur, nxt; int ui = 0;
    if (!S.next(0, cur)) return;
    f32x4 acc[2][2][4][2];
#pragma unroll
    for (int a = 0; a < 2; ++a)
#pragma unroll
        for (int b = 0; b < 2; ++b)
#pragma unroll
            for (int m = 0; m < 4; ++m)
#pragma unroll
                for (int n = 0; n < 2; ++n) acc[a][b][m][n] = (f32x4){0.f, 0.f, 0.f, 0.f};
    bf16x8 At[4][2], B0[2][2], B1[2][2];
    const char* cA = (const char*)g.A + (size_t)cur.pm * tstepA + (size_t)cur.k0 * 2; const char* cB = (const char*)g.Bt + (size_t)cur.pn * tstepB + (size_t)cur.k0 * 2;
    int nt = cur.nt;
    PG8_STAGE(PG8_SB(0, 0), cB, voffB); PG8_STAGE(PG8_SA(0, 0), cA, voffA); PG8_STAGE(PG8_SB(0, 1), cB + hstepB, voffB); PG8_STAGE(PG8_SA(0, 1), cA + hstepA, voffA);
    if (wr == 1) PG8_BAR;
    PG8_WAIT_V(4); PG8_BAR;
    PG8_STAGE(PG8_SB(1, 0), cB + kstep, voffB); PG8_STAGE(PG8_SA(1, 0), cA + kstep, voffA); PG8_STAGE(PG8_SB(1, 1), cB + hstepB + kstep, voffB);
    PG8_WAIT_V(6); PG8_BAR;
    for (;;) {
        const bool has_next = S.next(ui + 1, nxt);
        const char* nA = has_next ? (const char*)g.A + (size_t)nxt.pm * tstepA + (size_t)nxt.k0 * 2 : cA; const char* nB = has_next ? (const char*)g.Bt + (size_t)nxt.pn * tstepB + (size_t)nxt.k0 * 2 : cB;
        for (int t = 0; t < nt; t += 2) {
            const bool last = (t == nt - 2);
            const char* a1 = cA + (size_t)(t + 1) * kstep;
            const char* a2 = last ? nA : cA + (size_t)(t + 2) * kstep; const char* b2 = last ? nB : cB + (size_t)(t + 2) * kstep;
            const char* a3 = a2 + kstep; const char* b3 = b2 + kstep;
            PG8_LDB(B0, 0, 0); PG8_SCHED; PG8_LDA(At, 0, 0); PG8_STAGE(PG8_SA(1, 1), a1 + hstepA, voffA);
            PG8_WAIT_L(8); PG8_BAR; PG8_WAIT_L(0); PG8_MMA(0, 0, At, B0); PG8_BAR; PG8_SCHED;
            PG8_LDB(B1, 0, 1); PG8_STAGE(PG8_SB(0, 0), b2, voffB);
            PG8_BAR; PG8_WAIT_L(0); PG8_MMA(0, 1, At, B1); PG8_BAR;
            PG8_LDA(At, 0, 1); PG8_STAGE(PG8_SA(0, 0), a2, voffA);
            PG8_BAR; PG8_WAIT_L(0); PG8_MMA(1, 0, At, B0); PG8_BAR; PG8_SCHED;
            PG8_STAGE(PG8_SB(0, 1), b2 + hstepB, voffB);
            PG8_WAIT_V(6); PG8_BAR; PG8_MMA(1, 1, At, B1); PG8_BAR;
            PG8_LDB(B0, 1, 0); PG8_SCHED; PG8_LDA(At, 1, 0); PG8_STAGE(PG8_SA(0, 1), a2 + hstepA, voffA);
            PG8_WAIT_L(8); PG8_BAR; PG8_WAIT_L(0); PG8_MMA(0, 0, At, B0); PG8_BAR; PG8_SCHED;
            PG8_LDB(B1, 1, 1); PG8_STAGE(PG8_SB(1, 0), b3, voffB);
            PG8_BAR; PG8_WAIT_L(0); PG8_MMA(0, 1, At, B1); PG8_BAR;
            PG8_LDA(At, 1, 1); PG8_STAGE(PG8_SA(1, 0), a3, voffA);
            PG8_BAR; PG8_WAIT_L(0); PG8_MMA(1, 0, At, B0); PG8_BAR; PG8_SCHED;
            PG8_STAGE(PG8_SB(1, 1), b3 + hstepB, voffB);
            PG8_WAIT_V(6); PG8_BAR; PG8_MMA(1, 1, At, B1); PG8_BAR;
        }
        run_epi(E, acc, cur, wr, wc, fr, fq);
        if (!has_next) break;
#pragma unroll
        for (int a = 0; a < 2; ++a)
#pragma unroll
            for (int b = 0; b < 2; ++b)
#pragma unroll
                for (int m = 0; m < 4; ++m)
#pragma unroll
                    for (int n = 0; n < 2; ++n) acc[a][b][m][n] = (f32x4){0.f, 0.f, 0.f, 0.f};
        cur = nxt; cA = nA; cB = nB; nt = cur.nt; ++ui;
    }
    PG8_WAIT_V(0);
    if (wr == 0) PG8_BAR;
    PG8_BAR;
#undef PG8_SA
#undef PG8_SB
#undef PG8_STAGE
#undef PG8_LDA
#undef PG8_LDB
#undef PG8_MMA
#undef PG8_WAIT_V
#undef PG8_WAIT_L
#undef PG8_BAR
#undef PG8_SCHED
}

struct EpiAny {
    int mode; int l; void* p0; void* p1; float* out; int aux;
    __device__ __forceinline__ void operator()(const f32x4 (&acc)[2][2][4][2], const Unit& u, int wr, int wc, int fr, int fq) const {
        const int row0 = u.pm * BM + wr * 64 + fr;
        if (mode == 1) {
            const int col0 = u.pn * BM + wc * 32 + 4 * fq;
            const float* res = (const float*)p0;
#pragma unroll
            for (int ai = 0; ai < 2; ++ai)
#pragma unroll
                for (int m = 0; m < 4; ++m) {
                    const size_t ro = (size_t)(row0 + ai * HALF + m * 16) * D + col0;
#pragma unroll
                    for (int bj = 0; bj < 2; ++bj)
#pragma unroll
                        for (int n = 0; n < 2; ++n) {
                            float* o = out + ro + bj * HALF + n * 16;
                            if (u.nt == 4) {
                                const int rs = row0 + ai * HALF + m * 16 - TP, cs = col0 + bj * HALF + n * 16;
                                *(f32x4*)((char*)p1 + (size_t)((u.k0 >> 8) * TSM + rs) * (size_t)aux + (size_t)cs * 4) = acc[ai][bj][m][n];
                            } else { const f32x4 r = *(const f32x4*)(res + ro + bj * HALF + n * 16); *(f32x4*)o = acc[ai][bj][m][n] + r; }
                        }
                    __builtin_amdgcn_sched_barrier(0);
                }
        } else if (mode == 0) {
            bf16_t* proj = (bf16_t*)p0;
#pragma unroll
            for (int bj = 0; bj < 2; ++bj) {
                const int cb = u.pn * BM + bj * HALF;
                const int col0 = cb + wc * 32 + 8 * fq;
                const bool iskv = (cb >= C_BK) && (cb < C_CX);
                const bool isv = cb >= C_BV;
                float* kvdst = nullptr;
                if (iskv) { const bool pr = u.pm * BM < TP; const size_t off = pr ? ((isv ? O_PV : O_PK) + (size_t)l * 16777216 + (size_t)row0 * 512) : ((isv ? O_SV : O_SK) + (size_t)l * 524288 + (size_t)(row0 - TP) * 512); kvdst = out + off; }
                const int cc = col0 - (isv ? C_BV : C_BK);
#pragma unroll
                for (int ai = 0; ai < 2; ++ai)
#pragma unroll
                    for (int m = 0; m < 4; ++m) {
                        const int ro = ai * HALF + m * 16;
                        const f32x4 v0 = acc[ai][bj][m][0], v1 = acc[ai][bj][m][1];
                        u32x4 o; o.x = cvt_pk_bf16(v0[0], v0[1]); o.y = cvt_pk_bf16(v0[2], v0[3]); o.z = cvt_pk_bf16(v1[0], v1[1]); o.w = cvt_pk_bf16(v1[2], v1[3]);
                        *(u32x4*)(proj + (size_t)(row0 + ro) * NPROJ + col0) = o;
                        if (iskv) { float* dst = kvdst + (size_t)ro * 512 + cc; *(f32x4*)dst = v0; *(f32x4*)(dst + 4) = v1; }
                    }
            }
        } else {
            bf16_t* ub = (bf16_t*)p0; bf16_t* side = (bf16_t*)p1;
#pragma unroll
            for (int bj = 0; bj < 2; ++bj) {
                const int col0 = u.pn * BM + bj * HALF + wc * 32 + 8 * fq;
#pragma unroll
                for (int ai = 0; ai < 2; ++ai)
#pragma unroll
                    for (int m = 0; m < 4; ++m) {
                        const int row = row0 + ai * HALF + m * 16;
                        const f32x4 v0 = acc[ai][bj][m][0], v1 = acc[ai][bj][m][1];
                        u32x4 o; o.x = cvt_pk_bf16(v0[0], v0[1]); o.y = cvt_pk_bf16(v0[2], v0[3]); o.z = cvt_pk_bf16(v1[0], v1[1]); o.w = cvt_pk_bf16(v1[2], v1[3]);
                        *(u32x4*)(ub + (size_t)row * NFF2 + col0) = o;
                        if ((m & 1) && fr >= 14) {
                            const int rr = fr - 14;
                            *(u32x4*)(side + ((size_t)(row >> 5) * 2 + rr) * NFF2 + col0) = o;
                            float* dst = nullptr;
                            if (row < TP) { if ((row & 2047) >= 2046) dst = out + O_PFFN + (size_t)l * 180224 + ((size_t)(row >> 11) * 2 + rr) * NFF2 + col0; }
                            else if (((row - TP) & 63) >= 62) dst = out + O_SFFN + (size_t)l * 180224 + ((size_t)((row - TP) >> 6) * 2 + rr) * NFF2 + col0;
                            if (dst) { *(f32x4*)dst = v0; *(f32x4*)(dst + 4) = v1; }
                        }
                    }
            }
        }
    }
};
__device__ __forceinline__ void run_epi(const EpiAny& E, const f32x4 (&acc)[2][2][4][2], const Unit& u, int wr, int wc, int fr, int fq) { E(acc, u, wr, wc, fr, fq); }
}

__device__ __forceinline__ void transpose_tile(const float* __restrict__ src, int ldsrc, bf16_t* __restrict__ dst, int lddst, int k0, int n0d, int n0s, float* tile, const int tid) {
#pragma unroll
    for (int i = 0; i < 8; ++i) { const int idx = tid + 512 * i, kk = idx >> 6, nn = idx & 63; tile[kk * 65 + nn] = src[(size_t)(k0 + kk) * ldsrc + n0s + nn]; }
    __syncthreads();
#pragma unroll
    for (int i = 0; i < 4; ++i) { const int idx = tid + 512 * i, nn = idx >> 5, kp = idx & 31;
        *(unsigned*)(dst + (size_t)(n0d + nn) * lddst + k0 + 2 * kp) = pk2(tile[(2 * kp) * 65 + nn], tile[(2 * kp + 1) * 65 + nn]); }
    __syncthreads();
}
__device__ __forceinline__ void phase_weights(const Params& p, unsigned char* smem) {
    float* tile = (float*)smem; const int tid = opaque_tid();
    constexpr int N_IN = 16 * 64, N_OUT = 24 * 16, N_UP = 16 * 88, N_DN = 44 * 16, N_CW = 16, PER_L = N_IN + N_OUT + N_UP + N_DN + N_CW;
    for (int it = blockIdx.x; it < 2 * PER_L; it += gridDim.x) {
        const int l = it / PER_L; int r = it % PER_L;
        if (r < N_IN) { const int kb = r / 64, nb = r % 64, n0 = nb * 64;
            transpose_tile(p.in[9] + (size_t)l * 1024 * INW, INW, (bf16_t*)(p.ws + WS_WIN) + (size_t)l * 4096 * 1024, 1024, kb * 64, n0, n0 < 1536 ? n0 : (n0 < 2048 ? n0 + 1032 : (n0 < 2560 ? n0 + 1032 : (n0 < 3072 ? n0 + 1032 : (n0 < 3584 ? n0 - 1536 : n0 - 1528)))), tile, tid); continue; }
        r -= N_IN;
        if (r < N_OUT) { const int kb = r / 16, nb = r % 16;
            transpose_tile(p.in[19] + (size_t)l * 1536 * 1024, 1024, (bf16_t*)(p.ws + WS_WOUT) + (size_t)l * 1024 * 1536, 1536, kb * 64, nb * 64, nb * 64, tile, tid); continue; }
        r -= N_OUT;
        if (r < N_UP) { const int kb = r / 88, nb = r % 88;
            transpose_tile(p.in[21] + (size_t)l * 1024 * NFF2, NFF2, (bf16_t*)(p.ws + WS_WUP) + (size_t)l * NFF2 * 1024, 1024, kb * 64, nb * 64, nb * 64, tile, tid); continue; }
        r -= N_UP;
        if (r < N_DN) { const int kb = r / 16, nb = r % 16;
            transpose_tile(p.in[24] + (size_t)l * NFF * 1024, 1024, (bf16_t*)(p.ws + WS_WDN) + (size_t)l * 1024 * NFF, NFF, kb * 64, nb * 64, nb * 64, tile, tid); continue; }
        r -= N_DN;
        { const int gi = r >> 2, kb = (r >> 1) & 1, nb = r & 1;
            transpose_tile(p.in[17] + ((size_t)l * 4 + gi) * 16384, 128, (bf16_t*)(p.ws + WS_CW) + ((size_t)l * 4 + gi) * 16384, 128, kb * 64, nb * 64, nb * 64, tile, tid); }
    }
}

__device__ __forceinline__ void phase_norm(const Params& p, unsigned char* smem, int l, int mode, const int nsl = 0, const unsigned char* pbase = nullptr, const int ppitch = 0) {
    const int tid = opaque_tid(), lane = tid & 63, wave = tid >> 6;
    float* wab = (float*)smem;
    const float* gw = mode == 0 ? p.in[8] + l * 1024 : (mode == 1 ? p.in[20] + l * 1024 : p.in[25]);
    if (mode == 0) {
        const float* w = p.in[9] + (size_t)l * 1024 * INW;
        for (int idx = tid; idx < 8192; idx += 512) wab[idx] = w[(size_t)(idx >> 3) * INW + 2048 + (idx & 7)];
        __syncthreads();
    }
    f32x4 gv[4];
#pragma unroll
    for (int j = 0; j < 4; ++j) gv[j] = *(const f32x4*)(gw + 4 * (lane + 64 * j));
    bf16_t* h = (bf16_t*)(p.ws + WS_H);
    float* gb = (float*)(p.ws + WS_GB);
    const bool from_in = (mode == 0 && l == 0);
    for (int row = blockIdx.x * 8 + wave; row < T; row += gridDim.x * 8) {
        const float* xr = from_in ? (row < TP ? p.in[0] + (size_t)row * D : p.in[1] + (size_t)(row - TP) * D) : p.out + (size_t)row * D;
        f32x4 v[4]; float ss = 0.f;
#pragma unroll
        for (int j = 0; j < 4; ++j) { v[j] = *(const f32x4*)(xr + 4 * (lane + 64 * j)); ss += v[j][0] * v[j][0] + v[j][1] * v[j][1] + v[j][2] * v[j][2] + v[j][3] * v[j][3]; }
        ss = wave_sum64(ss);
        if (row >= TP) {
            if (from_in) {
#pragma unroll
                for (int j = 0; j < 4; ++j) *(f32x4*)(p.out + (size_t)row * D + 4 * (lane + 64 * j)) = v[j];
            } else if (nsl > 0) {
                for (int sl = 0; sl < nsl; ++sl) {
                    const unsigned char* pr = pbase + (size_t)(sl * TSM + row - TP) * (size_t)ppitch;
#pragma unroll
                    for (int j = 0; j < 4; ++j) v[j] += *(const f32x4*)(pr + 16 * (lane + 64 * j));
                }
                ss = 0.f;
#pragma unroll
                for (int j = 0; j < 4; ++j) { ss += v[j][0] * v[j][0] + v[j][1] * v[j][1] + v[j][2] * v[j][2] + v[j][3] * v[j][3];
                    if (mode != 2) *(f32x4*)(p.out + (size_t)row * D + 4 * (lane + 64 * j)) = v[j]; }
                ss = wave_sum64(ss);
            }
        }
        const float rstd = rsqrtf(ss * (1.f / D) + EPS);
#pragma unroll
        for (int j = 0; j < 4; ++j) v[j] = v[j] * rstd * gv[j];
        if (mode == 2) {
#pragma unroll
            for (int j = 0; j < 4; ++j) *(f32x4*)(p.out + (size_t)row * D + 4 * (lane + 64 * j)) = v[j];
            continue;
        }
#pragma unroll
        for (int j = 0; j < 4; ++j) { u32x2 o; o.x = pk2(v[j][0], v[j][1]); o.y = pk2(v[j][2], v[j][3]); *(u32x2*)(h + (size_t)row * D + 4 * (lane + 64 * j)) = o; }
        if (mode == 0) {
            float d8[8];
#pragma unroll
            for (int c = 0; c < 8; ++c) d8[c] = 0.f;
#pragma unroll
            for (int j = 0; j < 4; ++j)
#pragma unroll
                for (int i = 0; i < 4; ++i) { const int k = 4 * (lane + 64 * j) + i; const f32x4 w0 = *(const f32x4*)(wab + k * 8), w1 = *(const f32x4*)(wab + k * 8 + 4); const float hv = v[j][i];
                    d8[0] += hv * w0[0]; d8[1] += hv * w0[1]; d8[2] += hv * w0[2]; d8[3] += hv * w0[3]; d8[4] += hv * w1[0]; d8[5] += hv * w1[1]; d8[6] += hv * w1[2]; d8[7] += hv * w1[3]; }
#pragma unroll
            for (int c = 0; c < 8; ++c) d8[c] = wave_sum64(d8[c]);
            if (lane < 8) {
                float val = 0.f;
#pragma unroll
                for (int c = 0; c < 8; ++c) val = (lane == c) ? d8[c] : val;
                float res;
                if (lane < 4) { const float xx = val + p.in[13][l * 4 + lane]; const float sp = xx > 20.f ? xx : log1pf(expf(xx)); res = -expf(p.in[12][l * 4 + lane]) * sp; }
                else res = 1.f / (1.f + expf(-val));
                gb[(size_t)row * 8 + lane] = res;
            }
        }
    }
}

constexpr int DP_QB = 0, DP_KB = 17408, DP_KTT = 34816, DP_VU = 53248, DP_LM = 86016, DP_QKD = 102400, DP_SM = 111616;
__device__ __forceinline__ void delta_prep(const Params& p, unsigned char* smem, int l, int pi) {
    const int tid = opaque_tid(), lane = tid & 63, w = tid >> 6, fr = lane & 15, fq = lane >> 4;
    const bool prompt = pi < 2048;
    const int sid = prompt ? (pi >> 5) : (pi - 2048), n = prompt ? (pi & 31) : 0;
    const int b = sid >> 2, hh = sid & 3;
    const int rowbase = prompt ? b * SEQ : TP + b * 64, L = prompt ? SEQ : 64, t0 = n * 64;
    const bf16_t* proj = (const bf16_t*)(p.ws + WS_R2);
    const float* gb = (const float*)(p.ws + WS_GB);
    bf16_t* QB = (bf16_t*)(smem + DP_QB); bf16_t* KB = (bf16_t*)(smem + DP_KB); bf16_t* KTT = (bf16_t*)(smem + DP_KTT);
    float* VU = (float*)(smem + DP_VU); float* LM = (float*)(smem + DP_LM); bf16_t* QKD = (bf16_t*)(smem + DP_QKD);
    float* sG = (float*)(smem + DP_SM); float* sgam = sG + 64; float* sbeta = sG + 128; float* stail = sG + 192; float* sbg = sG + 256;
    const float* convw = p.in[10] + l * 6144; const float* convb = p.in[11] + l * 1536;
    const float* cbuf = p.in[3] + ((size_t)l * 16 + b) * 3 * 1536;
    u32x4 raw[6][4];
#pragma unroll
    for (int zp = 0; zp < 6; ++zp) {
        const int z = zp >> 1, item = tid + 512 * (zp & 1), row = item >> 4, seg = item & 15, cq = z * 512 + hh * 128 + seg * 8;
#pragma unroll
        for (int i = 0; i < 4; ++i) {
            const int tt = t0 + row - 3 + i;
            if (tt >= 0) raw[zp][i] = *(const u32x4*)(proj + (size_t)(rowbase + tt) * NPROJ + cq);
            else if (!prompt) { const f32x4 c0 = *(const f32x4*)(cbuf + (3 + tt) * 1536 + cq), c1 = *(const f32x4*)(cbuf + (3 + tt) * 1536 + cq + 4);
                raw[zp][i].x = pk2(c0[0], c0[1]); raw[zp][i].y = pk2(c0[2], c0[3]); raw[zp][i].z = pk2(c1[0], c1[1]); raw[zp][i].w = pk2(c1[2], c1[3]); }
            else raw[zp][i] = (u32x4){0u, 0u, 0u, 0u};
        }
    }
    if (tid < 64) {
        const float g = gb[(size_t)(rowbase + t0 + tid) * 8 + hh], be = gb[(size_t)(rowbase + t0 + tid) * 8 + 4 + hh];
        float G = g;
#pragma unroll
        for (int o = 1; o < 64; o <<= 1) { const float t = __shfl_up(G, o); if (lane >= o) G += t; }
        const float Gl = __shfl(G, 63);
        sG[tid] = G; sgam[tid] = __expf(G); sbeta[tid] = be; stail[tid] = __expf(Gl - G); sbg[tid] = be * __expf(G);
    }
    __syncthreads();
#pragma unroll
    for (int zp = 0; zp < 6; ++zp) {
        const int z = zp >> 1, item = tid + 512 * (zp & 1), row = item >> 4, seg = item & 15, cq = z * 512 + hh * 128 + seg * 8;
        float y[8];
        { const f32x4 b0 = *(const f32x4*)(convb + cq), b1 = *(const f32x4*)(convb + cq + 4); y[0] = b0[0]; y[1] = b0[1]; y[2] = b0[2]; y[3] = b0[3]; y[4] = b1[0]; y[5] = b1[1]; y[6] = b1[2]; y[7] = b1[3]; }
#pragma unroll
        for (int i = 0; i < 4; ++i) {
            float x[8]; unpack8(raw[zp][i], x);
            const f32x4 w0 = *(const f32x4*)(convw + i * 1536 + cq), w1 = *(const f32x4*)(convw + i * 1536 + cq + 4);
            y[0] += w0[0] * x[0]; y[1] += w0[1] * x[1]; y[2] += w0[2] * x[2]; y[3] += w0[3] * x[3]; y[4] += w1[0] * x[4]; y[5] += w1[1] * x[5]; y[6] += w1[2] * x[6]; y[7] += w1[3] * x[7];
        }
        float ss = 0.f;
#pragma unroll
        for (int e = 0; e < 8; ++e) { y[e] = siluf(y[e]); ss += y[e] * y[e]; }
        if (z < 2) {
            ss = row_sum16(ss);
            const float sc = rsqrtf(ss + EPS) * (z == 0 ? 0.08838834764831845f : 1.f);
#pragma unroll
            for (int e = 0; e < 8; ++e) y[e] *= sc;
            u32x4 o; o.x = pk2(y[0], y[1]); o.y = pk2(y[2], y[3]); o.z = pk2(y[4], y[5]); o.w = pk2(y[6], y[7]);
            *(u32x4*)((z == 0 ? QB : KB) + row * 136 + seg * 8) = o;
            if (z == 1) { const float tl = stail[row];
#pragma unroll
                for (int e = 0; e < 8; ++e) KTT[(seg * 8 + e) * 72 + row] = f2bf(y[e] * tl); }
        } else {
            const float be = sbeta[row];
            *(f32x4*)(VU + row * 128 + seg * 8) = (f32x4){y[0] * be, y[1] * be, y[2] * be, y[3] * be};
            *(f32x4*)(VU + row * 128 + seg * 8 + 4) = (f32x4){y[4] * be, y[5] * be, y[6] * be, y[7] * be};
        }
        __builtin_amdgcn_sched_barrier(0);
    }
    __syncthreads();
    {
        const int ct = w >> 1;
#pragma unroll
        for (int si = 0; si < 2; ++si) {
            const int st = 2 * (w & 1) + si;
            f32x4 akk = (f32x4){0.f, 0.f, 0.f, 0.f}, aqk = (f32x4){0.f, 0.f, 0.f, 0.f};
#pragma unroll
            for (int ks = 0; ks < 4; ++ks) {
                const bf16x8 xk = *(const bf16x8*)(KB + (16 * ct + fr) * 136 + 32 * ks + 8 * fq);
                const bf16x8 xq = *(const bf16x8*)(QB + (16 * ct + fr) * 136 + 32 * ks + 8 * fq);
                const bf16x8 yk = *(const bf16x8*)(KB + (16 * st + fr) * 136 + 32 * ks + 8 * fq);
                akk = MFMA16(xk, yk, akk); aqk = MFMA16(xq, yk, aqk);
            }
            const int s = 16 * st + fr; const float Gs = sG[s];
#pragma unroll
            for (int j = 0; j < 4; ++j) {
                const int c = 16 * ct + 4 * fq + j; const float dec = __expf(fminf(sG[c] - Gs, 0.f));
                LM[c * 64 + s] = (c > s) ? sbeta[c] * dec * akk[j] : 0.f;
                QKD[c * 72 + s] = f2bf((c >= s) ? dec * aqk[j] : 0.f);
            }
        }
    }
    __syncthreads();
    if (tid < 256) {
        float x[64];
        const bool isv = tid < 128; const int d = tid - 128;
        int vzero; asm volatile("v_mov_b32 %0, 0" : "=v"(vzero));
        const float* LMv = LM + vzero;
        if (isv) {
#pragma unroll
            for (int c = 0; c < 64; ++c) x[c] = VU[c * 128 + tid];
        } else {
#pragma unroll
            for (int c = 0; c < 64; ++c) x[c] = bf2f(KB[c * 136 + d]) * sbg[c];
        }
#pragma unroll
        for (int c = 1; c < 64; ++c) {
            float r0 = x[c], r1 = 0.f;
#pragma unroll
            for (int s4 = 0; s4 < (c + 3) / 4; ++s4) {
                const f32x4 lv = *(const f32x4*)(LMv + c * 64 + 4 * s4);
                r0 -= lv[0] * x[4 * s4]; r1 -= lv[1] * x[4 * s4 + 1]; r0 -= lv[2] * x[4 * s4 + 2]; r1 -= lv[3] * x[4 * s4 + 3];
            }
            x[c] = r0 + r1;
            if ((c & 3) == 3) __builtin_amdgcn_sched_barrier(0);
        }
        if (isv) {
#pragma unroll
            for (int c = 0; c < 64; ++c) VU[c * 128 + tid] = x[c];
        } else {
#pragma unroll
            for (int c = 0; c < 64; ++c) KB[c * 136 + d] = f2bf(x[c]);
        }
    }
    __syncthreads();
    {
        bf16_t* recWU = (bf16_t*)(p.ws + WS_H) + (size_t)pi * 16384;
        bf16_t* recQK = (bf16_t*)(p.ws + WS_QK) + (size_t)pi * 16384;
        unsigned char* recD = p.ws + WS_DD + (size_t)pi * 8448;
#pragma unroll
        for (int k = 0; k < 2; ++k) {
            const int idx = tid + 512 * k, row = idx >> 4, sg = idx & 15;
            *(u32x4*)(recWU + row * 128 + sg * 8) = *(const u32x4*)(KB + row * 136 + sg * 8);
            const f32x4 u0 = *(const f32x4*)(VU + row * 128 + sg * 8), u1 = *(const f32x4*)(VU + row * 128 + sg * 8 + 4);
            u32x4 o; o.x = pk2(u0[0], u0[1]); o.y = pk2(u0[2], u0[3]); o.z = pk2(u1[0], u1[1]); o.w = pk2(u1[2], u1[3]);
            *(u32x4*)(recWU + 8192 + row * 128 + sg * 8) = o;
            *(u32x4*)(recQK + row * 128 + sg * 8) = *(const u32x4*)(QB + row * 136 + sg * 8);
            const int r2 = idx >> 3, s8 = idx & 7;
            *(u32x4*)(recQK + 8192 + r2 * 64 + s8 * 8) = *(const u32x4*)(KTT + r2 * 72 + s8 * 8);
        }
        { const int r2 = tid >> 3, s8 = tid & 7; *(u32x4*)((bf16_t*)recD + r2 * 64 + s8 * 8) = *(const u32x4*)(QKD + r2 * 72 + s8 * 8); }
        if (tid < 64) ((float*)(recD + 8192))[tid] = sgam[tid];
        if (n == (prompt ? 31 : 0)) {
            float* co = p.out + (prompt ? O_PQC : O_SQC) + ((size_t)l * 16 + b) * 3 * 1536;
            for (int idx = tid; idx < 1152; idx += 512) { const int r = idx / 384, rem = idx % 384, z = rem >> 7, c = rem & 127;
                co[r * 1536 + z * 512 + hh * 128 + c] = bf2f(proj[(size_t)(rowbase + L - 3 + r) * NPROJ + z * 512 + hh * 128 + c]); }
        }
    }
}

constexpr int D2_QB = 0, D2_KB = 18432, D2_VU = 35840, D2_LM = 53248, D2_SM = 69632, D2_HALF = 70912;
__device__ __forceinline__ void delta_prep2(const Params& p, unsigned char* smem, int l, int piA, int piB) {
    const int tid = opaque_tid(), half = __builtin_amdgcn_readfirstlane(tid >> 8), t = tid & 255, lane = t & 63, wl = t >> 6, fr = lane & 15, fq = lane >> 4;
    const int pi = (half && piB >= 0) ? piB : piA;
    const bool prompt = pi < 2048;
    const int sid = prompt ? (pi >> 5) : (pi - 2048), n = prompt ? (pi & 31) : 0;
    const int b = sid >> 2, hh = sid & 3;
    const int rowbase = prompt ? b * SEQ : TP + b * 64, L = prompt ? SEQ : 64, t0 = n * 64;
    const bf16_t* proj = (const bf16_t*)(p.ws + WS_R2);
    const float* gb = (const float*)(p.ws + WS_GB);
    unsigned char* sb = smem + half * D2_HALF;
    bf16_t* QB = (bf16_t*)(sb + D2_QB); bf16_t* KTT = QB; bf16_t* KB = (bf16_t*)(sb + D2_KB); bf16_t* VUb = (bf16_t*)(sb + D2_VU); float* LM = (float*)(sb + D2_LM);
    float* sG = (float*)(sb + D2_SM); float* sgam = sG + 64; float* sbeta = sG + 128; float* stail = sG + 192; float* sbg = sG + 256;
    const float* convw = p.in[10] + l * 6144; const float* convb = p.in[11] + l * 1536;
    const float* cbuf = p.in[3] + ((size_t)l * 16 + b) * 3 * 1536;
    bf16_t* recWU = (bf16_t*)(p.ws + WS_H) + (size_t)pi * 16384;
    bf16_t* recQK = (bf16_t*)(p.ws + WS_QK) + (size_t)pi * 16384;
    unsigned char* recD = p.ws + WS_DD + (size_t)pi * 8448;
    if (t < 64) {
        const float g = gb[(size_t)(rowbase + t0 + t) * 8 + hh], be = gb[(size_t)(rowbase + t0 + t) * 8 + 4 + hh];
        float G = g;
#pragma unroll
        for (int o = 1; o < 64; o <<= 1) { const float tt = __shfl_up(G, o); if (lane >= o) G += tt; }
        const float Gl = __shfl(G, 63);
        sG[t] = G; sgam[t] = __expf(G); sbeta[t] = be; stail[t] = __expf(Gl - G); sbg[t] = be * __expf(G);
        ((float*)(recD + 8192))[t] = __expf(G);
    }
    __syncthreads();
    auto load_raw = [&](const int z, u32x4 (&raw)[4][4]) {
#pragma unroll
        for (int k = 0; k < 4; ++k) {
            const int item = t + 256 * k, row = item >> 4, seg = item & 15, cq = z * 512 + hh * 128 + seg * 8;
#pragma unroll
            for (int i = 0; i < 4; ++i) {
                const int tt = t0 + row - 3 + i;
                if (tt >= 0) raw[k][i] = *(const u32x4*)(proj + (size_t)(rowbase + tt) * NPROJ + cq);
                else if (!prompt) { const f32x4 c0 = *(const f32x4*)(cbuf + (3 + tt) * 1536 + cq), c1 = *(const f32x4*)(cbuf + (3 + tt) * 1536 + cq + 4);
                    raw[k][i].x = pk2(c0[0], c0[1]); raw[k][i].y = pk2(c0[2], c0[3]); raw[k][i].z = pk2(c1[0], c1[1]); raw[k][i].w = pk2(c1[2], c1[3]); }
                else raw[k][i] = (u32x4){0u, 0u, 0u, 0u};
            }
        }
    };
    auto conv_tensor = [&](const int z, const u32x4 (&raw)[4][4]) {
#pragma unroll
        for (int k = 0; k < 4; ++k) {
            const int item = t + 256 * k, row = item >> 4, seg = item & 15, cq = z * 512 + hh * 128 + seg * 8;
            float y[8];
            { const f32x4 b0 = *(const f32x4*)(convb + cq), b1 = *(const f32x4*)(convb + cq + 4); y[0] = b0[0]; y[1] = b0[1]; y[2] = b0[2]; y[3] = b0[3]; y[4] = b1[0]; y[5] = b1[1]; y[6] = b1[2]; y[7] = b1[3]; }
#pragma unroll
            for (int i = 0; i < 4; ++i) {
                float x[8]; unpack8(raw[k][i], x);
                const f32x4 w0 = *(const f32x4*)(convw + i * 1536 + cq), w1 = *(const f32x4*)(convw + i * 1536 + cq + 4);
                y[0] += w0[0] * x[0]; y[1] += w0[1] * x[1]; y[2] += w0[2] * x[2]; y[3] += w0[3] * x[3]; y[4] += w1[0] * x[4]; y[5] += w1[1] * x[5]; y[6] += w1[2] * x[6]; y[7] += w1[3] * x[7];
            }
            float ss = 0.f;
#pragma unroll
            for (int e = 0; e < 8; ++e) { y[e] = siluf(y[e]); ss += y[e] * y[e]; }
            if (z < 2) {
                ss = row_sum16(ss);
                const float sc = rsqrtf(ss + EPS) * (z == 0 ? 0.08838834764831845f : 1.f);
                u32x4 o; o.x = pk2(y[0] * sc, y[1] * sc); o.y = pk2(y[2] * sc, y[3] * sc); o.z = pk2(y[4] * sc, y[5] * sc); o.w = pk2(y[6] * sc, y[7] * sc);
                *(u32x4*)((z == 0 ? QB : KB) + row * 136 + seg * 8) = o;
            } else {
                const float be = sbeta[row];
                u32x4 o; o.x = pk2(y[0] * be, y[1] * be); o.y = pk2(y[2] * be, y[3] * be); o.z = pk2(y[4] * be, y[5] * be); o.w = pk2(y[6] * be, y[7] * be);
                *(u32x4*)(VUb + row * 136 + seg * 8) = o;
            }
        }
    };
    {
        u32x4 rawA[4][4], rawB[4][4];
        load_raw(0, rawA); load_raw(1, rawB);
        conv_tensor(0, rawA);
        load_raw(2, rawA);
        conv_tensor(1, rawB);
        conv_tensor(2, rawA);
    }
    __syncthreads();
    {
        const int ct = wl; bf16_t* qkd_g = (bf16_t*)recD;
#pragma unroll 1
        for (int st = 0; st < 4; ++st) {
            f32x4 akk = (f32x4){0.f, 0.f, 0.f, 0.f}, aqk = (f32x4){0.f, 0.f, 0.f, 0.f};
#pragma unroll
            for (int ks = 0; ks < 4; ++ks) {
                const bf16x8 xk = *(const bf16x8*)(KB + (16 * ct + fr) * 136 + 32 * ks + 8 * fq);
                const bf16x8 xq = *(const bf16x8*)(QB + (16 * ct + fr) * 136 + 32 * ks + 8 * fq);
                const bf16x8 yk = *(const bf16x8*)(KB + (16 * st + fr) * 136 + 32 * ks + 8 * fq);
                akk = MFMA16(xk, yk, akk); aqk = MFMA16(xq, yk, aqk);
            }
            const int s = 16 * st + fr; const float Gs = sG[s];
#pragma unroll
            for (int j = 0; j < 4; ++j) {
                const int c = 16 * ct + 4 * fq + j; const float dec = __expf(fminf(sG[c] - Gs, 0.f));
                LM[c * 64 + s] = (c > s) ? sbeta[c] * dec * akk[j] : 0.f;
                qkd_g[c * 64 + s] = f2bf((c >= s) ? dec * aqk[j] : 0.f);
            }
        }
    }
    __syncthreads();
#pragma unroll
    for (int k = 0; k < 4; ++k) { const int idx = t + 256 * k, row = idx >> 4, sg = idx & 15; *(u32x4*)(recQK + row * 128 + sg * 8) = *(const u32x4*)(QB + row * 136 + sg * 8); }
    __syncthreads();
#pragma unroll
    for (int k = 0; k < 4; ++k) {
        const int item = t + 256 * k, row = item >> 4, seg = item & 15;
        float x[8]; unpack8(*(const u32x4*)(KB + row * 136 + seg * 8), x);
        const float tl = stail[row];
#pragma unroll
        for (int e = 0; e < 8; ++e) KTT[(seg * 8 + e) * 72 + row] = f2bf(x[e] * tl);
    }
    __syncthreads();
    int vzero; asm volatile("v_mov_b32 %0, 0" : "=v"(vzero));
    if (vzero == 0) {
        float x[64];
        const bool isv = t < 128; const int d = t - 128;
        const float* LMv = LM + vzero;
        bf16_t* col = isv ? (VUb + t) : (KB + d);
#pragma unroll
        for (int c = 0; c < 64; ++c) x[c] = bf2f(col[c * 136]) * (isv ? 1.f : sbg[c]);
#pragma unroll
        for (int c = 1; c < 64; ++c) {
            float r0 = x[c], r1 = 0.f;
#pragma unroll
            for (int s4 = 0; s4 < (c + 3) / 4; ++s4) {
                const f32x4 lv = *(const f32x4*)(LMv + c * 64 + 4 * s4);
                r0 -= lv[0] * x[4 * s4]; r1 -= lv[1] * x[4 * s4 + 1]; r0 -= lv[2] * x[4 * s4 + 2]; r1 -= lv[3] * x[4 * s4 + 3];
            }
            x[c] = r0 + r1;
            if ((c & 3) == 3) __builtin_amdgcn_sched_barrier(0);
        }
#pragma unroll
        for (int c = 0; c < 64; ++c) col[c * 136] = f2bf(x[c]);
    }
    __syncthreads();
#pragma unroll
    for (int k = 0; k < 4; ++k) {
        const int idx = t + 256 * k, row = idx >> 4, sg = idx & 15;
        *(u32x4*)(recWU + row * 128 + sg * 8) = *(const u32x4*)(KB + row * 136 + sg * 8);
        *(u32x4*)(recWU + 8192 + row * 128 + sg * 8) = *(const u32x4*)(VUb + row * 136 + sg * 8);
        const int r2 = idx >> 3, s8 = idx & 7;
        *(u32x4*)(recQK + 8192 + r2 * 64 + s8 * 8) = *(const u32x4*)(KTT + r2 * 72 + s8 * 8);
    }
    if (n == (prompt ? 31 : 0)) {
        float* co = p.out + (prompt ? O_PQC : O_SQC) + ((size_t)l * 16 + b) * 3 * 1536;
        for (int idx = t; idx < 1152; idx += 256) { const int r = idx / 384, rem = idx % 384, z = rem >> 7, c = rem & 127;
            co[r * 1536 + z * 512 + hh * 128 + c] = bf2f(proj[(size_t)(rowbase + L - 3 + r) * NPROJ + z * 512 + hh * 128 + c]); }
    }
}

constexpr int SC_WB = 0, SC_UB = 17408, SC_QB = 34816, SC_KTT = 52224, SC_QKD = 70656, SC_DT = 79872, SC_STB = 98304, SC_SM = 133120;
__device__ __forceinline__ void delta_scan(const Params& p, unsigned char* smem, int l, int sid) {
    const int tid = opaque_tid(), lane = tid & 63, w = tid >> 6, fr = lane & 15, fq = lane >> 4;
    const bool prompt = sid < 64;
    const int s2 = prompt ? sid : sid - 64, b = s2 >> 2, hh = s2 & 3;
    const int rowbase = prompt ? b * SEQ : TP + b * 64, nch = prompt ? 32 : 1, pi0 = prompt ? s2 * 32 : 2048 + s2;
    bf16_t* proj = (bf16_t*)(p.ws + WS_R2);
    bf16_t* WB = (bf16_t*)(smem + SC_WB); bf16_t* UB = (bf16_t*)(smem + SC_UB); bf16_t* QB = (bf16_t*)(smem + SC_QB); bf16_t* KTT = (bf16_t*)(smem + SC_KTT);
    bf16_t* QKD = (bf16_t*)(smem + SC_QKD); bf16_t* DT = (bf16_t*)(smem + SC_DT) + w * 16 * 72; bf16_t* STB = (bf16_t*)(smem + SC_STB);
    float* sgam = (float*)(smem + SC_SM); float* osq = sgam + 64;
    f32x4 accS[8];
    if (prompt) {
#pragma unroll
        for (int dt = 0; dt < 8; ++dt) accS[dt] = (f32x4){0.f, 0.f, 0.f, 0.f};
    } else {
        const float* s0 = p.in[2] + (((size_t)l * 16 + b) * 4 + hh) * 16384;
#pragma unroll
        for (int dt = 0; dt < 8; ++dt)
#pragma unroll
            for (int j = 0; j < 4; ++j) accS[dt][j] = s0[(16 * dt + 4 * fq + j) * 128 + 16 * w + fr];
    }
#pragma unroll
    for (int dt = 0; dt < 8; ++dt) { u32x2 o; o.x = pk2(accS[dt][0], accS[dt][1]); o.y = pk2(accS[dt][2], accS[dt][3]); *(u32x2*)(STB + (16 * w + fr) * 136 + 16 * dt + 4 * fq) = o; }
    u32x4 pre[9]; float pgam = 0.f; u32x2 zr[4];
    auto load_chunk = [&](int n) {
        const size_t pi = (size_t)(pi0 + n);
        const u32x4* wu = (const u32x4*)((const bf16_t*)(p.ws + WS_H) + pi * 16384);
        const u32x4* qk = (const u32x4*)((const bf16_t*)(p.ws + WS_QK) + pi * 16384);
        const unsigned char* dd = p.ws + WS_DD + pi * 8448;
#pragma unroll
        for (int k = 0; k < 4; ++k) pre[k] = wu[tid + 512 * k];
#pragma unroll
        for (int k = 0; k < 4; ++k) pre[4 + k] = qk[tid + 512 * k];
        pre[8] = ((const u32x4*)dd)[tid];
        if (tid < 64) pgam = ((const float*)(dd + 8192))[tid];
#pragma unroll
        for (int ct = 0; ct < 4; ++ct) zr[ct] = *(const u32x2*)(proj + (size_t)(rowbase + n * 64 + 16 * ct + fr) * NPROJ + C_AZ + hh * 128 + 16 * w + 4 * fq);
    };
    load_chunk(0);
    const f32x4 an4 = *(const f32x4*)(p.in[14] + l * 128 + 16 * w + 4 * fq);
    for (int n = 0; n < nch; ++n) {
        const int t0 = n * 64;
#pragma unroll
        for (int k = 0; k < 2; ++k) {
            const int idx = tid + 512 * k, row = idx >> 4, sg = idx & 15;
            *(u32x4*)(WB + row * 136 + sg * 8) = pre[k];
            *(u32x4*)(UB + row * 136 + sg * 8) = pre[2 + k];
            *(u32x4*)(QB + row * 136 + sg * 8) = pre[4 + k];
            const int r2 = idx >> 3, s8 = idx & 7;
            *(u32x4*)(KTT + r2 * 72 + s8 * 8) = pre[6 + k];
        }
        { const int r2 = tid >> 3, s8 = tid & 7; *(u32x4*)(QKD + r2 * 72 + s8 * 8) = pre[8]; }
        if (tid < 64) sgam[tid] = pgam;
        u32x2 zc[4];
#pragma unroll
        for (int i = 0; i < 4; ++i) zc[i] = zr[i];
        __syncthreads();
        if (n + 1 < nch) load_chunk(n + 1);
        f32x4 oacc[4];
        {
            bf16x8 ysb[4];
#pragma unroll
            for (int ks = 0; ks < 4; ++ks) ysb[ks] = *(const bf16x8*)(STB + (16 * w + fr) * 136 + 32 * ks + 8 * fq);
#pragma unroll
            for (int ct = 0; ct < 4; ++ct) {
                f32x4 a = (f32x4){0.f, 0.f, 0.f, 0.f};
#pragma unroll
                for (int ks = 0; ks < 4; ++ks) a = MFMA16(*(const bf16x8*)(WB + (16 * ct + fr) * 136 + 32 * ks + 8 * fq), ysb[ks], a);
                float dl[4];
#pragma unroll
                for (int j = 0; j < 4; ++j) dl[j] = bf2f(UB[(16 * ct + 4 * fq + j) * 136 + 16 * w + fr]) - a[j];
                u32x2 o; o.x = pk2(dl[0], dl[1]); o.y = pk2(dl[2], dl[3]);
                *(u32x2*)(DT + fr * 72 + 16 * ct + 4 * fq) = o;
            }
            asm volatile("s_waitcnt lgkmcnt(0)" ::: "memory");
            bf16x8 ydt[2];
#pragma unroll
            for (int ks = 0; ks < 2; ++ks) ydt[ks] = *(const bf16x8*)(DT + fr * 72 + 32 * ks + 8 * fq);
#pragma unroll
            for (int ct = 0; ct < 4; ++ct) {
                f32x4 a1 = (f32x4){0.f, 0.f, 0.f, 0.f}, a2 = (f32x4){0.f, 0.f, 0.f, 0.f};
#pragma unroll
                for (int ks = 0; ks < 4; ++ks) a1 = MFMA16(ysb[ks], *(const bf16x8*)(QB + (16 * ct + fr) * 136 + 32 * ks + 8 * fq), a1);
#pragma unroll
                for (int ks = 0; ks < 2; ++ks) a2 = MFMA16(ydt[ks], *(const bf16x8*)(QKD + (16 * ct + fr) * 72 + 32 * ks + 8 * fq), a2);
                const float gm = sgam[16 * ct + fr];
                const f32x4 o = a1 * gm + a2;
                oacc[ct] = o;
                float sq = (o[0] * o[0] + o[1] * o[1]) + (o[2] * o[2] + o[3] * o[3]);
                sq += __shfl_xor(sq, 16); sq += __shfl_xor(sq, 32);
                if (fq == 0) osq[w * 64 + 16 * ct + fr] = sq;
                __builtin_amdgcn_sched_barrier(0);
            }
            const float gl = sgam[63];
#pragma unroll
            for (int dt = 0; dt < 8; ++dt) {
                f32x4 a = accS[dt] * gl;
#pragma unroll
                for (int ks = 0; ks < 2; ++ks) a = MFMA16(*(const bf16x8*)(KTT + (16 * dt + fr) * 72 + 32 * ks + 8 * fq), ydt[ks], a);
                accS[dt] = a;
                u32x2 o; o.x = pk2(a[0], a[1]); o.y = pk2(a[2], a[3]);
                *(u32x2*)(STB + (16 * w + fr) * 136 + 16 * dt + 4 * fq) = o;
                if (dt & 1) __builtin_amdgcn_sched_barrier(0);
            }
        }
        __syncthreads();
#pragma unroll
        for (int ct = 0; ct < 4; ++ct) {
            const int c = 16 * ct + fr;
            float tot = 0.f;
#pragma unroll
            for (int ww = 0; ww < 8; ++ww) tot += osq[ww * 64 + c];
            const float ri = rsqrtf(tot * (1.f / 128.f) + EPS);
            const float z0 = bflo(zc[ct].x), z1 = bfhi(zc[ct].x), z2 = bflo(zc[ct].y), z3 = bfhi(zc[ct].y);
            u32x2 ov; ov.x = pk2(oacc[ct][0] * ri * an4[0] * siluf(z0), oacc[ct][1] * ri * an4[1] * siluf(z1));
            ov.y = pk2(oacc[ct][2] * ri * an4[2] * siluf(z2), oacc[ct][3] * ri * an4[3] * siluf(z3));
            *(u32x2*)(proj + (size_t)(rowbase + t0 + c) * NPROJ + C_AZ + hh * 128 + 16 * w + 4 * fq) = ov;
        }
    }
    {
        float* so = p.out + (prompt ? O_PSD : O_SSD) + (((size_t)l * 16 + b) * 4 + hh) * 16384;
#pragma unroll
        for (int dt = 0; dt < 8; ++dt)
#pragma unroll
            for (int j = 0; j < 4; ++j) so[(16 * dt + 4 * fq + j) * 128 + 16 * w + fr] = accS[dt][j];
    }
    __syncthreads();
}

constexpr int AT_KS = 0, AT_VT = 34816, AT_OB = 71680;
__device__ __forceinline__ void attn_item(const Params& p, unsigned char* smem, int l, bool prompt, int b, int hh, int qc, float lam, float lam_init) {
    const int tid = opaque_tid(), lane = tid & 63, w = tid >> 6, fr = lane & 15, fq = lane >> 4, map = w >> 2, rb = w & 3;
    const bf16_t* proj = (const bf16_t*)(p.ws + WS_R2);
    bf16_t* mixed = (bf16_t*)(p.ws + WS_R2);
    const int row0 = prompt ? b * SEQ + qc * 64 : TP + b * 64;
    const int nt = prompt ? qc + 1 : 33;
    const float* ck = p.in[4] + ((size_t)l * 16 + b) * 2048 * 512 + hh * 128;
    const float* cv = p.in[5] + ((size_t)l * 16 + b) * 2048 * 512 + hh * 128;
    bf16_t* Ks = (bf16_t*)(smem + AT_KS); bf16_t* Vt = (bf16_t*)(smem + AT_VT); float* ob = (float*)(smem + AT_OB);
    bf16x8 qf[2];
#pragma unroll
    for (int ks = 0; ks < 2; ++ks) qf[ks] = *(const bf16x8*)(proj + (size_t)(row0 + rb * 16 + fr) * NPROJ + C_BQ + hh * 128 + map * 64 + 32 * ks + 8 * fq);
    const int lkey = tid >> 3, lseg = tid & 7;
    const int vkp = tid >> 4, ves = tid & 15;
    u32x4 rk[2], rv[2];
    auto load_tile = [&](int t) {
        if (prompt || t == 32) {
            const size_t rbase = prompt ? (size_t)(b * SEQ + t * 64) : (size_t)(TP + b * 64);
            const bf16_t* src = proj + (rbase + lkey) * NPROJ + hh * 128 + lseg * 16;
            rk[0] = *(const u32x4*)(src + C_BK); rk[1] = *(const u32x4*)(src + C_BK + 8);
            const bf16_t* sv = proj + (rbase + 2 * vkp) * NPROJ + C_BV + hh * 128 + ves * 8;
            rv[0] = *(const u32x4*)sv; rv[1] = *(const u32x4*)(sv + NPROJ);
        } else {
            const size_t o = (size_t)(t * 64 + lkey) * 512 + lseg * 16;
#pragma unroll
            for (int i = 0; i < 2; ++i) {
                const f32x4 a = *(const f32x4*)(ck + o + 8 * i), c = *(const f32x4*)(ck + o + 8 * i + 4);
                rk[i].x = pk2(a[0], a[1]); rk[i].y = pk2(a[2], a[3]); rk[i].z = pk2(c[0], c[1]); rk[i].w = pk2(c[2], c[3]);
                const size_t ov = (size_t)(t * 64 + 2 * vkp + i) * 512 + ves * 8;
                const f32x4 a2 = *(const f32x4*)(cv + ov), c2 = *(const f32x4*)(cv + ov + 4);
                rv[i].x = pk2(a2[0], a2[1]); rv[i].y = pk2(a2[2], a2[3]); rv[i].z = pk2(c2[0], c2[1]); rv[i].w = pk2(c2[2], c2[3]);
            }
        }
    };
    auto store_tile = [&](int buf) {
        bf16_t* kd = Ks + buf * 64 * 136 + lkey * 136 + lseg * 16;
        *(u32x4*)kd = rk[0]; *(u32x4*)(kd + 8) = rk[1];
        unsigned* vd = (unsigned*)(Vt + buf * 128 * 72 + (ves * 8) * 72) + (vkp ^ (2 * ves));
        const unsigned a0 = rv[0].x, a1 = rv[0].y, a2 = rv[0].z, a3 = rv[0].w, b0 = rv[1].x, b1 = rv[1].y, b2 = rv[1].z, b3 = rv[1].w;
        vd[0 * 36] = __builtin_amdgcn_perm(b0, a0, 0x05040100u); vd[1 * 36] = __builtin_amdgcn_perm(b0, a0, 0x07060302u);
        vd[2 * 36] = __builtin_amdgcn_perm(b1, a1, 0x05040100u); vd[3 * 36] = __builtin_amdgcn_perm(b1, a1, 0x07060302u);
        vd[4 * 36] = __builtin_amdgcn_perm(b2, a2, 0x05040100u); vd[5 * 36] = __builtin_amdgcn_perm(b2, a2, 0x07060302u);
        vd[6 * 36] = __builtin_amdgcn_perm(b3, a3, 0x05040100u); vd[7 * 36] = __builtin_amdgcn_perm(b3, a3, 0x07060302u);
    };
    f32x4 oacc[8];
#pragma unroll
    for (int et = 0; et < 8; ++et) oacc[et] = (f32x4){0.f, 0.f, 0.f, 0.f};
    float m_run = -INFINITY, l_run = 0.f;
    const float cs = 0.125f * 1.4426950408889634f;
    load_tile(0); store_tile(0);
    __syncthreads();
    asm volatile("" : "+v"(qf[0]), "+v"(qf[1]));
    for (int t = 0; t < nt; ++t) {
        const int buf = t & 1;
        if (t + 1 < nt) load_tile(t + 1);
        const bf16_t* kb = Ks + buf * 64 * 136; const bf16_t* vb = Vt + buf * 128 * 72;
        f32x4 sacc[4];
#pragma unroll
        for (int kt = 0; kt < 4; ++kt) {
            f32x4 a = (f32x4){0.f, 0.f, 0.f, 0.f};
#pragma unroll
            for (int ks = 0; ks < 2; ++ks) a = MFMA16(*(const bf16x8*)(kb + (16 * kt + fr) * 136 + map * 64 + 32 * ks + 8 * fq), qf[ks], a);
            sacc[kt] = a;
        }
        float mx = sacc[0][0];
#pragma unroll
        for (int kt = 0; kt < 4; ++kt)
#pragma unroll
            for (int j = 0; j < 4; ++j) mx = fmaxf(mx, sacc[kt][j]);
        mx = fmaxf(mx, __shfl_xor(mx, 16)); mx = fmaxf(mx, __shfl_xor(mx, 32));
        const float m_new = fmaxf(m_run, mx);
        const float alpha = __builtin_amdgcn_exp2f((m_run - m_new) * cs);
        m_run = m_new;
        float psum = 0.f;
        bf16x8 pf[2];
#pragma unroll
        for (int ks = 0; ks < 2; ++ks) {
            float pv[8];
#pragma unroll
            for (int i = 0; i < 8; ++i) { pv[i] = __builtin_amdgcn_exp2f((sacc[2 * ks + (i >> 2)][i & 3] - m_new) * cs); psum += pv[i]; }
            u32x4 pk; pk.x = pk2(pv[0], pv[1]); pk.y = pk2(pv[2], pv[3]); pk.z = pk2(pv[4], pv[5]); pk.w = pk2(pv[6], pv[7]);
            pf[ks] = __builtin_bit_cast(bf16x8, pk);
        }
        l_run = l_run * alpha + psum;
#pragma unroll
        for (int et = 0; et < 8; ++et) {
            f32x4 a = oacc[et] * alpha;
#pragma unroll
            for (int ks = 0; ks < 2; ++ks) {
                const int sw = 2 * (2 * et + (fr >> 3));
                const bf16x4 v0 = *(const bf16x4*)(vb + (16 * et + fr) * 72 + 2 * ((16 * ks + 2 * fq) ^ sw));
                const bf16x4 v1 = *(const bf16x4*)(vb + (16 * et + fr) * 72 + 2 * ((16 * ks + 8 + 2 * fq) ^ sw));
                const bf16x8 vx = __builtin_shufflevector(v0, v1, 0, 1, 2, 3, 4, 5, 6, 7);
                a = MFMA16(vx, pf[ks], a);
            }
            oacc[et] = a;
        }
        if (t + 1 < nt) store_tile(buf ^ 1);
        __syncthreads();
    }
    float lt = l_run; lt += __shfl_xor(lt, 16); lt += __shfl_xor(lt, 32);
    const float inv = 1.f / lt;
    const int q = rb * 16 + fr;
    if (map == 1) {
#pragma unroll
        for (int et = 0; et < 8; ++et)
#pragma unroll
            for (int j = 0; j < 4; ++j) ob[q * 129 + 16 * et + 4 * fq + j] = oacc[et][j] * inv * lam;
    }
    __syncthreads();
    if (map == 0) {
        float ss = 0.f;
#pragma unroll
        for (int et = 0; et < 8; ++et)
#pragma unroll
            for (int j = 0; j < 4; ++j) { const float o = oacc[et][j] * inv - ob[q * 129 + 16 * et + 4 * fq + j]; oacc[et][j] = o; ss += o * o; }
        ss += __shfl_xor(ss, 16); ss += __shfl_xor(ss, 32);
        const float sc = rsqrtf(ss * (1.f / 128.f) + EPS) * (1.f - lam_init);
        const float* bn = p.in[16] + l * 128;
#pragma unroll
        for (int et = 0; et < 8; ++et) {
            const int e = 16 * et + 4 * fq; const f32x4 g4 = *(const f32x4*)(bn + e);
            u32x2 o; o.x = pk2(oacc[et][0] * sc * g4[0], oacc[et][1] * sc * g4[1]); o.y = pk2(oacc[et][2] * sc * g4[2], oacc[et][3] * sc * g4[3]);
            *(u32x2*)(mixed + (size_t)(row0 + q) * NPROJ + C_BQ + hh * 128 + e) = o;
        }
    }
}

constexpr int PL_XS = 0, PL_PB = 40448;
__device__ __forceinline__ void pool_item(const Params& p, unsigned char* smem, int l, int pt, int gi) {
    const int tid = opaque_tid(), lane = tid & 63, w = tid >> 6, fr = lane & 15, fq = lane >> 4;
    const bf16_t* proj = (const bf16_t*)(p.ws + WS_R2);
    bf16_t* mixed = (bf16_t*)(p.ws + WS_R2);
    const int r0 = pt * 64; const bool prompt = r0 < TP;
    const int b = prompt ? (r0 >> 11) : ((r0 - TP) >> 6), t0 = prompt ? (r0 & 2047) : 0;
    float* xs = (float*)(smem + PL_XS); bf16_t* pb = (bf16_t*)(smem + PL_PB);
    const float* cpool = p.in[6] + ((size_t)l * 16 + b) * 15 * 512 + gi * 128;
    {
        u32x4 raw[3]; f32x4 ca[3], cc[3];
#pragma unroll
        for (int k = 0; k < 3; ++k) {
            const int idx = tid + 512 * k, rr = idx >> 4, sg = idx & 15, tt = t0 + rr - 15;
            raw[k] = (u32x4){0u, 0u, 0u, 0u}; ca[k] = (f32x4){0.f, 0.f, 0.f, 0.f}; cc[k] = ca[k];
            if (idx < 79 * 16) {
                if (tt >= 0) raw[k] = *(const u32x4*)(proj + (size_t)(r0 + rr - 15) * NPROJ + C_CX + gi * 128 + sg * 8);
                else if (!prompt) { ca[k] = *(const f32x4*)(cpool + (15 + tt) * 512 + sg * 8); cc[k] = *(const f32x4*)(cpool + (15 + tt) * 512 + sg * 8 + 4); }
            }
        }
#pragma unroll
        for (int k = 0; k < 3; ++k) {
            const int idx = tid + 512 * k, rr = idx >> 4, sg = idx & 15, tt = t0 + rr - 15;
            if (idx < 79 * 16) {
                float x[8];
                if (tt >= 0) unpack8(raw[k], x);
                else { x[0] = ca[k][0]; x[1] = ca[k][1]; x[2] = ca[k][2]; x[3] = ca[k][3]; x[4] = cc[k][0]; x[5] = cc[k][1]; x[6] = cc[k][2]; x[7] = cc[k][3]; }
                *(f32x4*)(xs + rr * 128 + sg * 8) = (f32x4){x[0], x[1], x[2], x[3]}; *(f32x4*)(xs + rr * 128 + sg * 8 + 4) = (f32x4){x[4], x[5], x[6], x[7]};
            }
        }
    }
    __syncthreads();
    const int win = 2 << gi;
    {
        const int c = tid & 127, tf = (tid >> 7) * 16;
        float s = 0.f;
        for (int j = 0; j < win; ++j) s += xs[(15 + tf - j) * 128 + c];
#pragma unroll 4
        for (int tt = 0; tt < 16; ++tt) {
            const int t = tf + tt; const float xt = xs[(15 + t) * 128 + c];
            if (tt > 0) s += xt - xs[(15 + t - win) * 128 + c];
            const int cnt = prompt ? min(t0 + t + 1, win) : win;
            pb[t * 136 + c] = f2bf(s / (float)cnt - xt);
        }
    }
    if (!prompt || t0 == SEQ - 64) {
        float* po = p.out + (prompt ? O_PPOOL : O_SPOOL) + ((size_t)l * 16 + b) * 15 * 512 + gi * 128;
        for (int idx = tid; idx < 15 * 128; idx += 512) { const int rr = idx >> 7, c = idx & 127; po[rr * 512 + c] = xs[(15 + 49 + rr) * 128 + c]; }
    }
    __syncthreads();
    const bf16_t* cw = (const bf16_t*)(p.ws + WS_CW) + ((size_t)l * 4 + gi) * 16384;
    bf16x8 yf[4];
#pragma unroll
    for (int ks = 0; ks < 4; ++ks) yf[ks] = *(const bf16x8*)(cw + (16 * w + fr) * 128 + 32 * ks + 8 * fq);
    const f32x4 sc4 = *(const f32x4*)(p.in[18] + l * 512 + gi * 128 + 16 * w + 4 * fq);
#pragma unroll
    for (int tt = 0; tt < 4; ++tt) {
        f32x4 a = (f32x4){0.f, 0.f, 0.f, 0.f};
#pragma unroll
        for (int ks = 0; ks < 4; ++ks) a = MFMA16(yf[ks], *(const bf16x8*)(pb + (16 * tt + fr) * 136 + 32 * ks + 8 * fq), a);
        u32x2 o; o.x = pk2(a[0] * sc4[0], a[1] * sc4[1]); o.y = pk2(a[2] * sc4[2], a[3] * sc4[3]);
        *(u32x2*)(mixed + (size_t)(r0 + 16 * tt + fr) * NPROJ + C_PO + gi * 128 + 16 * w + 4 * fq) = o;
    }
}

constexpr int PL2_HALF = 58368;
__device__ __forceinline__ void pool_item2(const Params& p, unsigned char* smem, int l, int itA) {
    const int tid = opaque_tid(), half = __builtin_amdgcn_readfirstlane(tid >> 8), t = tid & 255, lane = t & 63, wl = t >> 6, fr = lane & 15, fq = lane >> 4;
    const int item = itA + half, pt = item >> 2, gi = item & 3;
    const bf16_t* proj = (const bf16_t*)(p.ws + WS_R2);
    bf16_t* mixed = (bf16_t*)(p.ws + WS_R2);
    const int r0 = pt * 64; const bool prompt = r0 < TP;
    const int b = prompt ? (r0 >> 11) : ((r0 - TP) >> 6), t0 = prompt ? (r0 & 2047) : 0;
    float* xs = (float*)(smem + half * PL2_HALF); bf16_t* pb = (bf16_t*)(smem + half * PL2_HALF + 40448);
    const float* cpool = p.in[6] + ((size_t)l * 16 + b) * 15 * 512 + gi * 128;
    {
        u32x4 raw[5]; f32x4 ca[5], cc[5];
#pragma unroll
        for (int k = 0; k < 5; ++k) {
            const int idx = t + 256 * k, rr = idx >> 4, sg = idx & 15, tt = t0 + rr - 15;
            raw[k] = (u32x4){0u, 0u, 0u, 0u}; ca[k] = (f32x4){0.f, 0.f, 0.f, 0.f}; cc[k] = ca[k];
            if (idx < 79 * 16) {
                if (tt >= 0) raw[k] = *(const u32x4*)(proj + (size_t)(r0 + rr - 15) * NPROJ + C_CX + gi * 128 + sg * 8);
                else if (!prompt) { ca[k] = *(const f32x4*)(cpool + (15 + tt) * 512 + sg * 8); cc[k] = *(const f32x4*)(cpool + (15 + tt) * 512 + sg * 8 + 4); }
            }
        }
#pragma unroll
        for (int k = 0; k < 5; ++k) {
            const int idx = t + 256 * k, rr = idx >> 4, sg = idx & 15, tt = t0 + rr - 15;
            if (idx < 79 * 16) {
                float x[8];
                if (tt >= 0) unpack8(raw[k], x);
                else { x[0] = ca[k][0]; x[1] = ca[k][1]; x[2] = ca[k][2]; x[3] = ca[k][3]; x[4] = cc[k][0]; x[5] = cc[k][1]; x[6] = cc[k][2]; x[7] = cc[k][3]; }
                *(f32x4*)(xs + rr * 128 + sg * 8) = (f32x4){x[0], x[1], x[2], x[3]}; *(f32x4*)(xs + rr * 128 + sg * 8 + 4) = (f32x4){x[4], x[5], x[6], x[7]};
            }
        }
    }
    __syncthreads();
    const int win = 2 << gi;
    {
        const int c = t & 127, tf = (t >> 7) * 32;
        float s = 0.f;
        for (int j = 0; j < win; ++j) s += xs[(15 + tf - j) * 128 + c];
#pragma unroll 4
        for (int tt = 0; tt < 32; ++tt) {
            const int tq = tf + tt; const float xt = xs[(15 + tq) * 128 + c];
            if (tt > 0) s += xt - xs[(15 + tq - win) * 128 + c];
            const int cnt = prompt ? min(t0 + tq + 1, win) : win;
            pb[tq * 136 + c] = f2bf(s / (float)cnt - xt);
        }
    }
    if (!prompt || t0 == SEQ - 64) {
        float* po = p.out + (prompt ? O_PPOOL : O_SPOOL) + ((size_t)l * 16 + b) * 15 * 512 + gi * 128;
        for (int idx = t; idx < 15 * 128; idx += 256) { const int rr = idx >> 7, c = idx & 127; po[rr * 512 + c] = xs[(15 + 49 + rr) * 128 + c]; }
    }
    __syncthreads();
    const bf16_t* cw = (const bf16_t*)(p.ws + WS_CW) + ((size_t)l * 4 + gi) * 16384;
#pragma unroll
    for (int dh = 0; dh < 2; ++dh) {
        const int dt = 2 * wl + dh;
        bf16x8 yf[4];
#pragma unroll
        for (int ks = 0; ks < 4; ++ks) yf[ks] = *(const bf16x8*)(cw + (16 * dt + fr) * 128 + 32 * ks + 8 * fq);
        const f32x4 sc4 = *(const f32x4*)(p.in[18] + l * 512 + gi * 128 + 16 * dt + 4 * fq);
#pragma unroll
        for (int tt = 0; tt < 4; ++tt) {
            f32x4 a = (f32x4){0.f, 0.f, 0.f, 0.f};
#pragma unroll
            for (int ks = 0; ks < 4; ++ks) a = MFMA16(yf[ks], *(const bf16x8*)(pb + (16 * tt + fr) * 136 + 32 * ks + 8 * fq), a);
            u32x2 o; o.x = pk2(a[0] * sc4[0], a[1] * sc4[1]); o.y = pk2(a[2] * sc4[2], a[3] * sc4[3]);
            *(u32x2*)(mixed + (size_t)(r0 + 16 * tt + fr) * NPROJ + C_PO + gi * 128 + 16 * dt + 4 * fq) = o;
        }
    }
}

constexpr int N_PREP = 1056, N_PL = 1056, N_AS = 64, N_AP = 2048, N_AP_A = 0;
__device__ __forceinline__ void phase_mix(const Params& p, unsigned char* smem, int l, const bool second) {
    const int tid = opaque_tid();
    const float lam_init = (l == 0) ? 0.2f : 0.35550906759096924f;
    float lam;
    { const float* bl = p.in[15] + l * 256; float s1 = 0.f, s2 = 0.f;
        for (int i = 0; i < 64; ++i) { s1 += bl[i] * bl[64 + i]; s2 += bl[128 + i] * bl[192 + i]; }
        lam = expf(s1) - expf(s2) + lam_init; }
    if (second) { for (int sid = blockIdx.x; sid < 128; sid += gridDim.x) delta_scan(p, smem, l, sid); }
    unsigned* ctr = (unsigned*)(p.ws + WS_CTL) + l * 2 + (second ? 1 : 0);
    int* s_item = (int*)(smem + LDS_BYTES - 16);
    const int nitems = second ? (N_AP - N_AP_A) : (N_PREP + N_AS + N_AP_A + N_PL);
    for (;;) {
        __syncthreads();
        if (tid == 0) *s_item = (int)atomicAdd(ctr, 1u);
        __syncthreads();
        int item = *s_item;
        if (item >= nitems) break;
        if (second) { item += N_AP_A; const int qc = 31 - (item >> 6), bh = item & 63; attn_item(p, smem, l, true, bh >> 2, bh & 3, qc, lam, lam_init); continue; }
        if (item < N_AS) { attn_item(p, smem, l, false, item >> 2, item & 3, 0, lam, lam_init); continue; }
        item -= N_AS;
        if (item < N_PREP) { const int i0 = 2 * item, i1 = 2 * item + 1, c0 = i0 >> 6, q0 = i0 & 63, c1 = i1 >> 6, q1 = i1 & 63;
            delta_prep2(p, smem, l, c0 < 32 ? q0 * 32 + c0 : 2048 + q0, c1 < 32 ? q1 * 32 + c1 : 2048 + q1); continue; }
        item -= N_PREP;
        if (item < N_AP_A) { const int qc = 31 - (item >> 6), bh = item & 63; attn_item(p, smem, l, true, bh >> 2, bh & 3, qc, lam, lam_init); continue; }
        item -= N_AP_A;
        pool_item2(p, smem, l, 2 * item);
    }
}

__device__ __forceinline__ void phase_ffnconv(const Params& p, int l) {
    bf16_t* u = (bf16_t*)(p.ws + WS_R2); const bf16_t* side = (const bf16_t*)(p.ws + WS_SIDE);
    const float* cw = p.in[22] + l * 3 * NFF2; const float* cb = p.in[23] + l * NFF2;
    const int nitems = 1056 * 352;
    const int tid0 = opaque_tid();
    for (int item = blockIdx.x * NTHREADS + tid0; item < nitems; item += gridDim.x * NTHREADS) {
        const int seg = item / 352, j = (item % 352) * 8;
        float wg[3][8], wv[3][8], bg[8], bv[8];
#pragma unroll
        for (int i = 0; i < 3; ++i) {
            const f32x4 a0 = *(const f32x4*)(cw + i * NFF2 + j), a1 = *(const f32x4*)(cw + i * NFF2 + j + 4), c0 = *(const f32x4*)(cw + i * NFF2 + NFF + j), c1 = *(const f32x4*)(cw + i * NFF2 + NFF + j + 4);
#pragma unroll
            for (int e = 0; e < 4; ++e) { wg[i][e] = a0[e]; wg[i][4 + e] = a1[e]; wv[i][e] = c0[e]; wv[i][4 + e] = c1[e]; }
        }
        { const f32x4 a0 = *(const f32x4*)(cb + j), a1 = *(const f32x4*)(cb + j + 4), c0 = *(const f32x4*)(cb + NFF + j), c1 = *(const f32x4*)(cb + NFF + j + 4);
#pragma unroll
            for (int e = 0; e < 4; ++e) { bg[e] = a0[e]; bg[4 + e] = a1[e]; bv[e] = c0[e]; bv[4 + e] = c1[e]; } }
        float g1[8], g2[8], v1[8], v2[8];
        const int r0 = seg * 32;
        if (r0 >= TP && ((r0 - TP) & 63) == 0) {
            const float* c = p.in[7] + ((size_t)l * 16 + ((r0 - TP) >> 6)) * 2 * NFF2;
#pragma unroll
            for (int e = 0; e < 8; ++e) { g1[e] = c[j + e]; v1[e] = c[NFF + j + e]; g2[e] = c[NFF2 + j + e]; v2[e] = c[NFF2 + NFF + j + e]; }
        } else if (r0 < TP && (r0 & 2047) == 0) {
#pragma unroll
            for (int e = 0; e < 8; ++e) { g1[e] = 0.f; g2[e] = 0.f; v1[e] = 0.f; v2[e] = 0.f; }
        } else {
            const bf16_t* sd = side + (size_t)(seg - 1) * 2 * NFF2;
            unpack8(*(const u32x4*)(sd + j), g1); unpack8(*(const u32x4*)(sd + NFF + j), v1); unpack8(*(const u32x4*)(sd + NFF2 + j), g2); unpack8(*(const u32x4*)(sd + NFF2 + NFF + j), v2);
        }
        bf16_t* ur = u + (size_t)r0 * NFF2 + j;
#pragma unroll 4
        for (int r = 0; r < 32; ++r) {
            float g3[8], v3[8];
            unpack8(*(const u32x4*)(ur + (size_t)r * NFF2), g3); unpack8(*(const u32x4*)(ur + (size_t)r * NFF2 + NFF), v3);
            float hh[8];
#pragma unroll
            for (int e = 0; e < 8; ++e) {
                const float cg = bg[e] + wg[0][e] * g1[e] + wg[1][e] * g2[e] + wg[2][e] * g3[e], cv = bv[e] + wv[0][e] * v1[e] + wv[1][e] * v2[e] + wv[2][e] * v3[e];
                hh[e] = siluf(cg) * cv; g1[e] = g2[e]; g2[e] = g3[e]; v1[e] = v2[e]; v2[e] = v3[e];
            }
            u32x4 o; o.x = pk2(hh[0], hh[1]); o.y = pk2(hh[2], hh[3]); o.z = pk2(hh[4], hh[5]); o.w = pk2(hh[6], hh[7]);
            *(u32x4*)(ur + (size_t)r * NFF2) = o;
        }
    }
}

template <int s> __device__ __forceinline__ void run_step(const Params& p, unsigned char* smem) {
    constexpr int l = s / 9, ph = s % 9;
    if constexpr (s == 18) { phase_norm(p, smem, 0, 2, 11, p.ws + WS_R2 + 5632, 11264); }
    else if constexpr (ph == 1 || ph == 4 || ph == 6 || ph == 8) {
        pg8::Gemm g; pg8::EpiAny E; bool perm = true;
        if constexpr (ph == 1) {
            g = pg8::Gemm{(const bf16_t*)(p.ws + WS_H), (const bf16_t*)(p.ws + WS_WIN) + (size_t)l * 4096 * 1024, T, NPN, 1024, 1024};
            E = pg8::EpiAny{0, l, p.ws + WS_R2, nullptr, p.out, 0};
        } else if constexpr (ph == 4) {
            g = pg8::Gemm{(const bf16_t*)(p.ws + WS_R2) + C_AZ, (const bf16_t*)(p.ws + WS_WOUT) + (size_t)l * 1024 * 1536, T, D, NMIX, NPROJ};
            E = pg8::EpiAny{1, l, (void*)(l == 0 ? p.in[0] : p.out), p.ws + WS_QK, p.out, 4096}; perm = false;
        } else if constexpr (ph == 6) {
            g = pg8::Gemm{(const bf16_t*)(p.ws + WS_H), (const bf16_t*)(p.ws + WS_WUP) + (size_t)l * NFF2 * 1024, T, NFF2, 1024, 1024};
            E = pg8::EpiAny{2, l, p.ws + WS_R2, p.ws + WS_SIDE, p.out, 0};
        } else {
            g = pg8::Gemm{(const bf16_t*)(p.ws + WS_R2), (const bf16_t*)(p.ws + WS_WDN) + (size_t)l * 1024 * NFF, T, D, NFF, NFF2};
            E = pg8::EpiAny{1, l, p.out, p.ws + WS_R2 + 5632, p.out, 11264}; perm = false;
        }
        pg8::StaticOrder S; S.init(g.M, g.N, g.K, gridDim.x, blockIdx.x, (ph == 4 || ph == 8) ? TSM : 0);
        pg8::gemm_phase((LAS unsigned char*)smem, g, S, E, perm);
    } else if constexpr (ph == 0) {
        if constexpr (l == 0) phase_weights(p, smem);
        if constexpr (l == 0) phase_norm(p, smem, l, 0); else phase_norm(p, smem, l, 0, 11, p.ws + WS_R2 + 5632, 11264);
    } else if constexpr (ph == 2) phase_mix(p, smem, l, false);
    else if constexpr (ph == 3) phase_mix(p, smem, l, true);
    else if constexpr (ph == 5) phase_norm(p, smem, l, 1, 6, p.ws + WS_QK, 4096);
    else phase_ffnconv(p, l);
}

#define XB_TMO      128
#define XB_XCNT(j)  (256  + 64 * (j))
#define XB_XSUB(j)  (1280 + 64 * (j))
#define XB_XGEN(j)  (2304 + 64 * (j))
#define XB_TOP      3328
#define XB_TOPGEN   3392
#define XCD_BAR_WORDS 3456
#define XB_SPIN_CAP (1u << 18)

__device__ __forceinline__ unsigned xb_ld(unsigned* p)              { return __hip_atomic_load(p, __ATOMIC_RELAXED, __HIP_MEMORY_SCOPE_AGENT); }
__device__ __forceinline__ unsigned xb_add(unsigned* p, unsigned v) { return __hip_atomic_fetch_add(p, v, __ATOMIC_RELAXED, __HIP_MEMORY_SCOPE_AGENT); }
__device__ __forceinline__ unsigned xb_xcc_id() { return (unsigned)__builtin_amdgcn_s_getreg((3 << 11) | 20) & 0xFu; }
#define XB_SPIN(cond, bar) do { unsigned _sp = 0; while (cond) { __builtin_amdgcn_s_sleep(1); \
    if ((++_sp & 255u) == 0u) { if (xb_ld(&(bar)[XB_TMO])) break; if (_sp > XB_SPIN_CAP) { atomicAdd(&(bar)[XB_TMO], 1u); break; } } } } while (0)

struct XcdBarrier {
    unsigned* bar; unsigned x;
    volatile LAS unsigned* st;
};

__device__ __forceinline__ XcdBarrier xcd_barrier_post(unsigned* bar, volatile LAS unsigned* st) {
    XcdBarrier b; b.bar = bar; b.x = xb_xcc_id(); b.st = st;
    if (threadIdx.x == 0) (void)xb_add(&bar[XB_XCNT(b.x)], 1u);
    return b;
}
__device__ __forceinline__ void xcd_barrier_complete(unsigned* bar, unsigned x, unsigned& nloc, unsigned& nx) {
    const unsigned G = gridDim.x * gridDim.y * gridDim.z;
    unsigned sum, cnt, mine, sp = 0u;
    for (;;) {
        sum = 0u; cnt = 0u; mine = 0u;
#pragma unroll
        for (unsigned j = 0; j < 16; ++j) { const unsigned c = xb_ld(&bar[XB_XCNT(j)]); sum += c; cnt += (c > 0u) ? 1u : 0u; mine = (j == x) ? c : mine; }
        if (sum == G) break;
        __builtin_amdgcn_s_sleep(1);
        if ((++sp & 255u) == 0u) { if (xb_ld(&bar[XB_TMO])) break; if (sp > XB_SPIN_CAP) { atomicAdd(&bar[XB_TMO], 1u); break; } }
    }
    nloc = mine > 0u ? mine : 1u; nx = cnt > 0u ? cnt : 1u;
}

__device__ __forceinline__ void xcd_barrier(const XcdBarrier& b) {
    asm volatile("s_waitcnt vmcnt(0)" ::: "memory");
    __syncthreads();
    if (threadIdx.x == 0) {
        unsigned* bar = b.bar;
        __builtin_amdgcn_s_waitcnt(0);
        unsigned nloc = b.st[0], nx = b.st[1];
        if (nloc == 0u) { xcd_barrier_complete(bar, b.x, nloc, nx); b.st[0] = nloc; b.st[1] = nx; }
        const unsigned old = xb_add(&bar[XB_XSUB(b.x)], 1u);
        const unsigned gen = old / nloc;
        if (old + 1u == (gen + 1u) * nloc) {
            __builtin_amdgcn_fence(__ATOMIC_RELEASE, "agent");
            asm volatile("s_waitcnt vmcnt(0)" ::: "memory");
            const unsigned og = xb_add(&bar[XB_TOP], 1u);
            const unsigned tg = og / nx;
            if (og + 1u == (tg + 1u) * nx) xb_add(&bar[XB_TOPGEN], 1u);
            else XB_SPIN(xb_ld(&bar[XB_TOPGEN]) == tg, bar);
            __builtin_amdgcn_fence(__ATOMIC_ACQUIRE, "agent");
            xb_add(&bar[XB_XGEN(b.x)], 1u);
            asm volatile("s_waitcnt vmcnt(0)" ::: "memory");
        } else {
            XB_SPIN(xb_ld(&bar[XB_XGEN(b.x)]) == gen, bar);
            __builtin_amdgcn_fence(__ATOMIC_ACQUIRE, "agent");
            asm volatile("s_waitcnt vmcnt(0)" ::: "memory");
        }
    }
    __syncthreads();
}


__global__ void __launch_bounds__(NTHREADS, 2) fwd_megakernel(Params p) {
    extern __shared__ __attribute__((aligned(16))) unsigned char smem[];
    cg::grid_group grid = cg::this_grid();
    volatile LAS unsigned* xst = (volatile LAS unsigned*)(LAS unsigned char*)(smem + LDS_BYTES - 8);
    if (blockIdx.x == 0) for (int i = threadIdx.x; i < 4096; i += NTHREADS) ((unsigned*)(p.ws + WS_CTL))[i] = 0u;
    if (threadIdx.x == 0) { xst[0] = 0u; xst[1] = 0u; }
    __syncthreads();
    run_step<0>(p, smem); grid.sync();
    const XcdBarrier xb = xcd_barrier_post((unsigned*)(p.ws + WS_BAR), xst);
    run_step<1>(p, smem); xcd_barrier(xb);  run_step<2>(p, smem); xcd_barrier(xb);  run_step<3>(p, smem); xcd_barrier(xb);
    run_step<4>(p, smem); xcd_barrier(xb);  run_step<5>(p, smem); xcd_barrier(xb);  run_step<6>(p, smem); xcd_barrier(xb);  run_step<7>(p, smem); xcd_barrier(xb);
    run_step<8>(p, smem); xcd_barrier(xb);  run_step<9>(p, smem); xcd_barrier(xb);  run_step<10>(p, smem); xcd_barrier(xb); run_step<11>(p, smem); xcd_barrier(xb);
    run_step<12>(p, smem); xcd_barrier(xb); run_step<13>(p, smem); xcd_barrier(xb); run_step<14>(p, smem); xcd_barrier(xb); run_step<15>(p, smem); xcd_barrier(xb);
    run_step<16>(p, smem); xcd_barrier(xb); run_step<17>(p, smem); xcd_barrier(xb); run_step<18>(p, smem);
}

extern "C" void kernel_launch(void* const* d_in, const int* in_sizes, int n_in, void* d_out, int out_size, void* d_ws, size_t ws_size, hipStream_t stream) {
    static int grid_blocks = 0;
    if (grid_blocks == 0) {
        if (n_in != 26 || ws_size < WS_END) { fprintf(stderr, "kernel_launch: unexpected problem (n_in %d, ws %zu < %zu)\n", n_in, ws_size, (size_t)WS_END); grid_blocks = -1; return; }
        int dev = 0, cus = 0, per_cu = 0;
        (void)hipGetDevice(&dev);
        (void)hipDeviceGetAttribute(&cus, hipDeviceAttributeMultiprocessorCount, dev);
        if (hipFuncSetAttribute((const void*)fwd_megakernel, hipFuncAttributeMaxDynamicSharedMemorySize, LDS_BYTES) != hipSuccess) { fprintf(stderr, "hipFuncSetAttribute failed\n"); grid_blocks = -1; return; }
        if (hipOccupancyMaxActiveBlocksPerMultiprocessor(&per_cu, (const void*)fwd_megakernel, NTHREADS, LDS_BYTES) != hipSuccess || per_cu < 1) { fprintf(stderr, "occupancy query failed (%d)\n", per_cu); (void)hipGetLastError(); per_cu = 1; }
        if (per_cu > 1) per_cu = 1;
        grid_blocks = cus * per_cu;
    }
    if (grid_blocks < 0) return;
    Params p{};
    for (int i = 0; i < 26; ++i) p.in[i] = (const float*)d_in[i];
    p.out = (float*)d_out; p.ws = (unsigned char*)d_ws;
    void* args[] = {&p};
    hipError_t e = hipLaunchCooperativeKernel((const void*)fwd_megakernel, dim3(grid_blocks), dim3(NTHREADS), args, LDS_BYTES, stream);
    if (e != hipSuccess) fprintf(stderr, "cooperative launch failed: %s (grid %d)\n", hipGetErrorString(e), grid_blocks);
}
```

```cpp
#include <hip/hip_runtime.h>
#include <hip/hip_cooperative_groups.h>
#include <cstdio>
#include <cstdint>
namespace cg = cooperative_groups;

#define LAS __attribute__((address_space(3)))
typedef unsigned short bf16_t;
typedef short bf16x8 __attribute__((ext_vector_type(8)));
typedef short bf16x4 __attribute__((ext_vector_type(4)));
typedef float f32x4 __attribute__((ext_vector_type(4)));
typedef unsigned u32x4 __attribute__((ext_vector_type(4)));
typedef unsigned u32x2 __attribute__((ext_vector_type(2)));

constexpr int D = 1024, TP = 32768, TSM = 1024, T = TP + TSM, SEQ = 2048;
constexpr int NPROJ = 4608, NPN = 4096, NMIX = 1536, NFF2 = 5632, NFF = 2816, INW = 4104;
constexpr float EPS = 1e-6f;
constexpr int C_BK = 1536, C_BV = 2048, C_CX = 2560, C_AZ = 3072, C_BQ = 3584, C_PO = 4096;
constexpr size_t O_YP = 0, O_YS = 33554432, O_PSD = 34603008, O_SSD = 36700160, O_PQC = 38797312, O_SQC = 38944768, O_PK = 39092224, O_SK = 72646656,
                 O_PV = 73695232, O_SV = 107249664, O_PPOOL = 108298240, O_SPOOL = 108544000, O_PFFN = 108789760, O_SFFN = 109150208;
constexpr size_t WS_CTL = 0, WS_BAR = 1024, WS_GB = 16384,
                 WS_WIN = WS_GB + (size_t)T * 8 * 4, WS_WOUT = WS_WIN + 2ull * 4096 * 1024 * 2, WS_WUP = WS_WOUT + 2ull * 1024 * 1536 * 2,
                 WS_WDN = WS_WUP + 2ull * 5632 * 1024 * 2, WS_CW = WS_WDN + 2ull * 1024 * 2816 * 2, WS_H = WS_CW + 2ull * 4 * 128 * 128 * 2,
                 WS_R2 = WS_H + (size_t)T * 1024 * 2, WS_QK = WS_R2 + (size_t)T * NPROJ * 2, WS_SIDE = WS_R2 + (size_t)T * NFF2 * 2, WS_DD = WS_SIDE,
                 WS_END = WS_SIDE + 1056ull * 2 * NFF2 * 2;
constexpr int LDS_BYTES = 155648;
constexpr int NTHREADS = 512;

struct Params { const float* in[26]; float* out; unsigned char* ws; };

__device__ __forceinline__ bf16_t f2bf(float f) { unsigned u = __float_as_uint(f); u += 0x7FFFu + ((u >> 16) & 1u); return (bf16_t)(u >> 16); }
__device__ __forceinline__ float bf2f(bf16_t b) { return __uint_as_float(((unsigned)b) << 16); }
typedef __bf16 bf16v2_t __attribute__((ext_vector_type(2)));
typedef float f32v2_t __attribute__((ext_vector_type(2)));
__device__ __forceinline__ unsigned pk2(float lo, float hi) { const f32v2_t f = {lo, hi}; const bf16v2_t r = __builtin_convertvector(f, bf16v2_t); return __builtin_bit_cast(unsigned, r); }
__device__ __forceinline__ float bflo(unsigned u) { return __uint_as_float(u << 16); }
__device__ __forceinline__ float bfhi(unsigned u) { return __uint_as_float(u & 0xFFFF0000u); }
__device__ __forceinline__ float siluf(float y) { return y * __builtin_amdgcn_rcpf(1.f + __expf(-y)); }
__device__ __forceinline__ int opaque_tid() { int t = threadIdx.x; asm volatile("" : "+v"(t)); return t; }
template <int CTRL> __device__ __forceinline__ float dpp_mov(float v) { return __builtin_bit_cast(float, __builtin_amdgcn_update_dpp(0, __builtin_bit_cast(int, v), CTRL, 0xF, 0xF, true)); }
__device__ __forceinline__ float row_sum16(float v) { v += dpp_mov<0xB1>(v); v += dpp_mov<0x4E>(v); v += dpp_mov<0x141>(v); v += dpp_mov<0x140>(v); return v; }
__device__ __forceinline__ float wave_sum64(float v) { v = row_sum16(v);
    return (__builtin_amdgcn_readlane(__builtin_bit_cast(int, v), 0) , __builtin_bit_cast(float, __builtin_amdgcn_readlane(__builtin_bit_cast(int, v), 0)) + __builtin_bit_cast(float, __builtin_amdgcn_readlane(__builtin_bit_cast(int, v), 16))
         + __builtin_bit_cast(float, __builtin_amdgcn_readlane(__builtin_bit_cast(int, v), 32)) + __builtin_bit_cast(float, __builtin_amdgcn_readlane(__builtin_bit_cast(int, v), 48))); }
#define MFMA16(a, b, c) __builtin_amdgcn_mfma_f32_16x16x32_bf16(a, b, c, 0, 0, 0)
__device__ __forceinline__ void unpack8(const u32x4 v, float* f) {
    f[0] = bflo(v.x); f[1] = bfhi(v.x); f[2] = bflo(v.y); f[3] = bfhi(v.y); f[4] = bflo(v.z); f[5] = bfhi(v.z); f[6] = bflo(v.w); f[7] = bfhi(v.w);
}

namespace pg8 {
constexpr int BM = 256, BK = 64, HALF = 128, HTB = HALF * BK * 2, STAGE_BYTES = 8 * HTB, NXCD = 8, WGM = 8;
__host__ __device__ __forceinline__ int lds_byte(int r, int c) { const int st = (r >> 4) * 2 + (c >> 5), rr = r & 15, cc = c & 31, ob = rr * 64 + cc * 2; return st * 1024 + (ob ^ (((ob >> 9) & 1) << 5)); }
__host__ __device__ __forceinline__ void stage_rc(int b, int& R, int& C) { const int st = b / 1024, sb = b % 1024, swz = sb ^ (((sb >> 9) & 1) << 5); R = (st >> 1) * 16 + swz / 64; C = (st & 1) * 32 + (swz % 64) / 2; }
__host__ __device__ __forceinline__ int perm32(int rho) { const int n = rho >> 4, i = rho & 15; return 8 * (i >> 2) + 4 * n + (i & 3); }
struct Unit { int pm, pn, k0, nt; };
struct Gemm { const bf16_t* A; const bf16_t* Bt; int M, N, K, lda; };
struct StaticOrder {
    int nM, nN, nwg, G, c, ntk, nslice, ntot;
    __device__ void init(int M, int N, int K, int G_, int c_, int split_rows) {
        nN = N / BM; G = G_; c = c_; ntk = K / BK;
        if (split_rows > 0) { nM = (M - split_rows) / BM; nslice = K / 256; nwg = nM * nN; ntot = nwg + (split_rows / BM) * nN * nslice; }
        else { nM = M / BM; nslice = 0; nwg = nM * nN; ntot = nwg; }
    }
    __device__ bool next(int i, Unit& u) const {
        const long L = (long)i * G + c; if (L >= ntot) return false;
        if (L >= nwg) { const int idx = (int)L - nwg, tile = idx / nslice, sl = idx - tile * nslice; u.pm = nM + tile / nN; u.pn = tile % nN; u.k0 = sl * 256; u.nt = 4; return true; }
        int wgid = (int)L; { const int q = nwg / NXCD, r = nwg % NXCD, xcd = wgid % NXCD, off = wgid / NXCD; wgid = (xcd < r ? xcd * (q + 1) : r * (q + 1) + (xcd - r) * q) + off; }
        const int nig = WGM * nN, gid = wgid / nig, fm = gid * WGM, gsz = (nM - fm) < WGM ? (nM - fm) : WGM;
        u.pm = fm + ((wgid % nig) % gsz); u.pn = (wgid % nig) / gsz; u.k0 = 0; u.nt = ntk; return true;
    }
};
__device__ __forceinline__ unsigned cvt_pk_bf16(float lo, float hi) { unsigned r; asm volatile("v_cvt_pk_bf16_f32 %0, %1, %2" : "=v"(r) : "v"(lo), "v"(hi)); return r; }

struct EpiAny;
__device__ __forceinline__ void run_epi(const EpiAny& E, const f32x4 (&acc)[2][2][4][2], const Unit& u, int wr, int wc, int fr, int fq);
__device__ __forceinline__ void gemm_phase(LAS unsigned char* lds, const Gemm g, const StaticOrder& S, const EpiAny& E, const bool perm) {
    const int tid = opaque_tid(), wid = __builtin_amdgcn_readfirstlane(tid >> 6), lane = tid & 63, wr = wid >> 2, wc = wid & 3, fr = lane & 15, fq = lane >> 4;
    const int K = g.K, lda = g.lda;
    unsigned voffA[2], voffB[2];
#pragma unroll
    for (int i = 0; i < 2; ++i) { int R, C; stage_rc(tid * 16 + i * 8192, R, C); const int Rb = perm ? ((R & ~31) + perm32(R & 31)) : R;
        voffA[i] = (unsigned)(R * lda + C) * 2u; voffB[i] = (unsigned)(Rb * K + C) * 2u; }
    const size_t kstep = (size_t)(BK * 2);
    const size_t hstepA = (size_t)HALF * lda * 2, hstepB = (size_t)HALF * K * 2;
    const size_t tstepA = 2 * hstepA, tstepB = 2 * hstepB;
    const unsigned ldsw = (unsigned)wid * 1024u;
    const int aoff = lds_byte(wr * 64 + fr, fq * 8), boff = lds_byte(wc * 32 + fr, fq * 8);
#define PG8_SA(b, h) (((b) * 2 + (h)) * HTB)
#define PG8_SB(b, h) ((4 + (b) * 2 + (h)) * HTB)
#define PG8_STAGE(bufoff, gbase, voff) do { _Pragma("unroll") for (int _i = 0; _i < 2; ++_i) \
        __builtin_amdgcn_global_load_lds((const unsigned*)((const char*)(gbase) + (voff)[_i]), (LAS unsigned*)(lds + (bufoff) + ldsw + _i * 8192), 16, 0, 0); } while (0)
#define PG8_LDA(dst, b, h) do { _Pragma("unroll") for (int m = 0; m < 4; ++m) _Pragma("unroll") for (int k = 0; k < 2; ++k) dst[m][k] = *(const LAS bf16x8*)(lds + PG8_SA(b, h) + aoff + m * 2048 + k * 1024); } while (0)
#define PG8_LDB(dst, b, h) do { _Pragma("unroll") for (int n = 0; n < 2; ++n) _Pragma("unroll") for (int k = 0; k < 2; ++k) dst[n][k] = *(const LAS bf16x8*)(lds + PG8_SB(b, h) + boff + n * 2048 + k * 1024); } while (0)
#define PG8_MMA(ai, bj, At, Bt) do { __builtin_amdgcn_s_setprio(1); _Pragma("unroll") for (int m = 0; m < 4; ++m) _Pragma("unroll") for (int n = 0; n < 2; ++n) _Pragma("unroll") for (int k = 0; k < 2; ++k) \
        acc[ai][bj][m][n] = __builtin_amdgcn_mfma_f32_16x16x32_bf16(Bt[n][k], At[m][k], acc[ai][bj][m][n], 0, 0, 0); __builtin_amdgcn_s_setprio(0); } while (0)
#define PG8_WAIT_V(n) asm volatile("s_waitcnt vmcnt(" #n ")" ::: "memory")
#define PG8_WAIT_L(n) asm volatile("s_waitcnt lgkmcnt(" #n ")" ::: "memory")
#define PG8_BAR __builtin_amdgcn_s_barrier()
#define PG8_SCHED __builtin_amdgcn_sched_barrier(0)
    Unit cur, nxt; int ui = 0;
    if (!S.next(0, cur)) return;
    f32x4 acc[2][2][4][2];
#pragma unroll
    for (int a = 0; a < 2; ++a)
#pragma unroll
        for (int b = 0; b < 2; ++b)
#pragma unroll
            for (int m = 0; m < 4; ++m)
#pragma unroll
                for (int n = 0; n < 2; ++n) acc[a][b][m][n] = (f32x4){0.f, 0.f, 0.f, 0.f};
    bf16x8 At[4][2], B0[2][2], B1[2][2];
    const char* cA = (const char*)g.A + (size_t)cur.pm * tstepA + (size_t)cur.k0 * 2; const char* cB = (const char*)g.Bt + (size_t)cur.pn * tstepB + (size_t)cur.k0 * 2;
    int nt = cur.nt;
    PG8_STAGE(PG8_SB(0, 0), cB, voffB); PG8_STAGE(PG8_SA(0, 0), cA, voffA); PG8_STAGE(PG8_SB(0, 1), cB + hstepB, voffB); PG8_STAGE(PG8_SA(0, 1), cA + hstepA, voffA);
    if (wr == 1) PG8_BAR;
    PG8_WAIT_V(4); PG8_BAR;
    PG8_STAGE(PG8_SB(1, 0), cB + kstep, voffB); PG8_STAGE(PG8_SA(1, 0), cA + kstep, voffA); PG8_STAGE(PG8_SB(1, 1), cB + hstepB + kstep, voffB);
    PG8_WAIT_V(6); PG8_BAR;
    for (;;) {
        const bool has_next = S.next(ui + 1, nxt);
        const char* nA = has_next ? (const char*)g.A + (size_t)nxt.pm * tstepA + (size_t)nxt.k0 * 2 : cA; const char* nB = has_next ? (const char*)g.Bt + (size_t)nxt.pn * tstepB + (size_t)nxt.k0 * 2 : cB;
        for (int t = 0; t < nt; t += 2) {
            const bool last = (t == nt - 2);
            const char* a1 = cA + (size_t)(t + 1) * kstep;
            const char* a2 = last ? nA : cA + (size_t)(t + 2) * kstep; const char* b2 = last ? nB : cB + (size_t)(t + 2) * kstep;
            const char* a3 = a2 + kstep; const char* b3 = b2 + kstep;
            PG8_LDB(B0, 0, 0); PG8_SCHED; PG8_LDA(At, 0, 0); PG8_STAGE(PG8_SA(1, 1), a1 + hstepA, voffA);
            PG8_WAIT_L(8); PG8_BAR; PG8_WAIT_L(0); PG8_MMA(0, 0, At, B0); PG8_BAR; PG8_SCHED;
            PG8_LDB(B1, 0, 1); PG8_STAGE(PG8_SB(0, 0), b2, voffB);
            PG8_BAR; PG8_WAIT_L(0); PG8_MMA(0, 1, At, B1); PG8_BAR;
            PG8_LDA(At, 0, 1); PG8_STAGE(PG8_SA(0, 0), a2, voffA);
            PG8_BAR; PG8_WAIT_L(0); PG8_MMA(1, 0, At, B0); PG8_BAR; PG8_SCHED;
            PG8_STAGE(PG8_SB(0, 1), b2 + hstepB, voffB);
            PG8_WAIT_V(6); PG8_BAR; PG8_MMA(1, 1, At, B1); PG8_BAR;
            PG8_LDB(B0, 1, 0); PG8_SCHED; PG8_LDA(At, 1, 0); PG8_STAGE(PG8_SA(0, 1), a2 + hstepA, voffA);
            PG8_WAIT_L(8); PG8_BAR; PG8_WAIT_L(0); PG8_MMA(0, 0, At, B0); PG8_BAR; PG8_SCHED;
            PG8_LDB(B1, 1, 1); PG8_STAGE(PG8_SB(1, 0), b3, voffB);
            PG8_BAR; PG8_WAIT_L(0); PG8_MMA(0, 1, At, B1); PG8_BAR;
            PG8_LDA(At, 1, 1); PG8_STAGE(PG8_SA(1, 0), a3, voffA);
            PG8_BAR; PG8_WAIT_L(0); PG8_MMA(1, 0, At, B0); PG8_BAR; PG8_SCHED;
            PG8_STAGE(PG8_SB(1, 1), b3 + hstepB, voffB);
            PG8_WAIT_V(6); PG8_BAR; PG8_MMA(1, 1, At, B1); PG8_BAR;
        }
        run_epi(E, acc, cur, wr, wc, fr, fq);
        if (!has_next) break;
#pragma unroll
        for (int a = 0; a < 2; ++a)
#pragma unroll
            for (int b = 0; b < 2; ++b)
#pragma unroll
                for (int m = 0; m < 4; ++m)
#pragma unroll
                    for (int n = 0; n < 2; ++n) acc[a][b][m][n] = (f32x4){0.f, 0.f, 0.f, 0.f};
        cur = nxt; cA = nA; cB = nB; nt = cur.nt; ++ui;
    }
    PG8_WAIT_V(0);
    if (wr == 0) PG8_BAR;
    PG8_BAR;
#undef PG8_SA
#undef PG8_SB
#undef PG8_STAGE
#undef PG8_LDA
#undef PG8_LDB
#undef PG8_MMA
#undef PG8_WAIT_V
#undef PG8_WAIT_L
#undef PG8_BAR
#undef PG8_SCHED
}

struct EpiAny {
    int mode; int l; void* p0; void* p1; float* out; int aux;
    __device__ __forceinline__ void operator()(const f32x4 (&acc)[2][2][4][2], const Unit& u, int wr, int wc, int fr, int fq) const {
        const int row0 = u.pm * BM + wr * 64 + fr;
        if (mode == 1) {
            const int col0 = u.pn * BM + wc * 32 + 4 * fq;
            const float* res = (const float*)p0;
#pragma unroll
            for (int ai = 0; ai < 2; ++ai)
#pragma unroll
                for (int m = 0; m < 4; ++m) {
                    const size_t ro = (size_t)(row0 + ai * HALF + m * 16) * D + col0;
#pragma unroll
                    for (int bj = 0; bj < 2; ++bj)
#pragma unroll
                        for (int n = 0; n < 2; ++n) {
                            float* o = out + ro + bj * HALF + n * 16;
                            if (u.nt == 4) {
                                const int rs = row0 + ai * HALF + m * 16 - TP, cs = col0 + bj * HALF + n * 16;
                                *(f32x4*)((char*)p1 + (size_t)((u.k0 >> 8) * TSM + rs) * (size_t)aux + (size_t)cs * 4) = acc[ai][bj][m][n];
                            } else { const f32x4 r = *(const f32x4*)(res + ro + bj * HALF + n * 16); *(f32x4*)o = acc[ai][bj][m][n] + r; }
                        }
                    __builtin_amdgcn_sched_barrier(0);
                }
        } else if (mode == 0) {
            bf16_t* proj = (bf16_t*)p0;
#pragma unroll
            for (int bj = 0; bj < 2; ++bj) {
                const int cb = u.pn * BM + bj * HALF;
                const int col0 = cb + wc * 32 + 8 * fq;
                const bool iskv = (cb >= C_BK) && (cb < C_CX);
                const bool isv = cb >= C_BV;
                float* kvdst = nullptr;
                if (iskv) { const bool pr = u.pm * BM < TP; const size_t off = pr ? ((isv ? O_PV : O_PK) + (size_t)l * 16777216 + (size_t)row0 * 512) : ((isv ? O_SV : O_SK) + (size_t)l * 524288 + (size_t)(row0 - TP) * 512); kvdst = out + off; }
                const int cc = col0 - (isv ? C_BV : C_BK);
#pragma unroll
                for (int ai = 0; ai < 2; ++ai)
#pragma unroll
                    for (int m = 0; m < 4; ++m) {
                        const int ro = ai * HALF + m * 16;
                        const f32x4 v0 = acc[ai][bj][m][0], v1 = acc[ai][bj][m][1];
                        u32x4 o; o.x = cvt_pk_bf16(v0[0], v0[1]); o.y = cvt_pk_bf16(v0[2], v0[3]); o.z = cvt_pk_bf16(v1[0], v1[1]); o.w = cvt_pk_bf16(v1[2], v1[3]);
                        *(u32x4*)(proj + (size_t)(row0 + ro) * NPROJ + col0) = o;
                        if (iskv) { float* dst = kvdst + (size_t)ro * 512 + cc; *(f32x4*)dst = v0; *(f32x4*)(dst + 4) = v1; }
                    }
            }
        } else {
            bf16_t* ub = (bf16_t*)p0; bf16_t* side = (bf16_t*)p1;
#pragma unroll
            for (int bj = 0; bj < 2; ++bj) {
                const int col0 = u.pn * BM + bj * HALF + wc * 32 + 8 * fq;
#pragma unroll
                for (int ai = 0; ai < 2; ++ai)
#pragma unroll
                    for (int m = 0; m < 4; ++m) {
                        const int row = row0 + ai * HALF + m * 16;
                        const f32x4 v0 = acc[ai][bj][m][0], v1 = acc[ai][bj][m][1];
                        u32x4 o; o.x = cvt_pk_bf16(v0[0], v0[1]); o.y = cvt_pk_bf16(v0[2], v0[3]); o.z = cvt_pk_bf16(v1[0], v1[1]); o.w = cvt_pk_bf16(v1[2], v1[3]);
                        *(u32x4*)(ub + (size_t)row * NFF2 + col0) = o;
                        if ((m & 1) && fr >= 14) {
                            const int rr = fr - 14;
                            *(u32x4*)(side + ((size_t)(row >> 5) * 2 + rr) * NFF2 + col0) = o;
                            float* dst = nullptr;
                            if (row < TP) { if ((row & 2047) >= 2046) dst = out + O_PFFN + (size_t)l * 180224 + ((size_t)(row >> 11) * 2 + rr) * NFF2 + col0; }
                            else if (((row - TP) & 63) >= 62) dst = out + O_SFFN + (size_t)l * 180224 + ((size_t)((row - TP) >> 6) * 2 + rr) * NFF2 + col0;
                            if (dst) { *(f32x4*)dst = v0; *(f32x4*)(dst + 4) = v1; }
                        }
                    }
            }
        }
    }
};
__device__ __forceinline__ void run_epi(const EpiAny& E, const f32x4 (&acc)[2][2][4][2], const Unit& u, int wr, int wc, int fr, int fq) { E(acc, u, wr, wc, fr, fq); }
}

__device__ __forceinline__ void transpose_tile(const float* __restrict__ src, int ldsrc, bf16_t* __restrict__ dst, int lddst, int k0, int n0d, int n0s, float* tile, const int tid) {
#pragma unroll
    for (int i = 0; i < 8; ++i) { const int idx = tid + 512 * i, kk = idx >> 6, nn = idx & 63; tile[kk * 65 + nn] = src[(size_t)(k0 + kk) * ldsrc + n0s + nn]; }
    __syncthreads();
#pragma unroll
    for (int i = 0; i < 4; ++i) { const int idx = tid + 512 * i, nn = idx >> 5, kp = idx & 31;
        *(unsigned*)(dst + (size_t)(n0d + nn) * lddst + k0 + 2 * kp) = pk2(tile[(2 * kp) * 65 + nn], tile[(2 * kp + 1) * 65 + nn]); }
    __syncthreads();
}
__device__ __forceinline__ void phase_weights(const Params& p, unsigned char* smem) {
    float* tile = (float*)smem; const int tid = opaque_tid();
    constexpr int N_IN = 16 * 64, N_OUT = 24 * 16, N_UP = 16 * 88, N_DN = 44 * 16, N_CW = 16, PER_L = N_IN + N_OUT + N_UP + N_DN + N_CW;
    for (int it = blockIdx.x; it < 2 * PER_L; it += gridDim.x) {
        const int l = it / PER_L; int r = it % PER_L;
        if (r < N_IN) { const int kb = r / 64, nb = r % 64, n0 = nb * 64;
            transpose_tile(p.in[9] + (size_t)l * 1024 * INW, INW, (bf16_t*)(p.ws + WS_WIN) + (size_t)l * 4096 * 1024, 1024, kb * 64, n0, n0 < 1536 ? n0 : (n0 < 2048 ? n0 + 1032 : (n0 < 2560 ? n0 + 1032 : (n0 < 3072 ? n0 + 1032 : (n0 < 3584 ? n0 - 1536 : n0 - 1528)))), tile, tid); continue; }
        r -= N_IN;
        if (r < N_OUT) { const int kb = r / 16, nb = r % 16;
            transpose_tile(p.in[19] + (size_t)l * 1536 * 1024, 1024, (bf16_t*)(p.ws + WS_WOUT) + (size_t)l * 1024 * 1536, 1536, kb * 64, nb * 64, nb * 64, tile, tid); continue; }
        r -= N_OUT;
        if (r < N_UP) { const int kb = r / 88, nb = r % 88;
            transpose_tile(p.in[21] + (size_t)l * 1024 * NFF2, NFF2, (bf16_t*)(p.ws + WS_WUP) + (size_t)l * NFF2 * 1024, 1024, kb * 64, nb * 64, nb * 64, tile, tid); continue; }
        r -= N_UP;
        if (r < N_DN) { const int kb = r / 16, nb = r % 16;
            transpose_tile(p.in[24] + (size_t)l * NFF * 1024, 1024, (bf16_t*)(p.ws + WS_WDN) + (size_t)l * 1024 * NFF, NFF, kb * 64, nb * 64, nb * 64, tile, tid); continue; }
        r -= N_DN;
        { const int gi = r >> 2, kb = (r >> 1) & 1, nb = r & 1;
            transpose_tile(p.in[17] + ((size_t)l * 4 + gi) * 16384, 128, (bf16_t*)(p.ws + WS_CW) + ((size_t)l * 4 + gi) * 16384, 128, kb * 64, nb * 64, nb * 64, tile, tid); }
    }
}

__device__ __forceinline__ void phase_norm(const Params& p, unsigned char* smem, int l, int mode, const int nsl = 0, const unsigned char* pbase = nullptr, const int ppitch = 0) {
    const int tid = opaque_tid(), lane = tid & 63, wave = tid >> 6;
    float* wab = (float*)smem;
    const float* gw = mode == 0 ? p.in[8] + l * 1024 : (mode == 1 ? p.in[20] + l * 1024 : p.in[25]);
    if (mode == 0) {
        const float* w = p.in[9] + (size_t)l * 1024 * INW;
        for (int idx = tid; idx < 8192; idx += 512) wab[idx] = w[(size_t)(idx >> 3) * INW + 2048 + (idx & 7)];
        __syncthreads();
    }
    f32x4 gv[4];
#pragma unroll
    for (int j = 0; j < 4; ++j) gv[j] = *(const f32x4*)(gw + 4 * (lane + 64 * j));
    bf16_t* h = (bf16_t*)(p.ws + WS_H);
    float* gb = (float*)(p.ws + WS_GB);
    const bool from_in = (mode == 0 && l == 0);
    for (int row = blockIdx.x * 8 + wave; row < T; row += gridDim.x * 8) {
        const float* xr = from_in ? (row < TP ? p.in[0] + (size_t)row * D : p.in[1] + (size_t)(row - TP) * D) : p.out + (size_t)row * D;
        f32x4 v[4]; float ss = 0.f;
#pragma unroll
        for (int j = 0; j < 4; ++j) { v[j] = *(const f32x4*)(xr + 4 * (lane + 64 * j)); ss += v[j][0] * v[j][0] + v[j][1] * v[j][1] + v[j][2] * v[j][2] + v[j][3] * v[j][3]; }
        ss = wave_sum64(ss);
        if (row >= TP) {
            if (from_in) {
#pragma unroll
                for (int j = 0; j < 4; ++j) *(f32x4*)(p.out + (size_t)row * D + 4 * (lane + 64 * j)) = v[j];
            } else if (nsl > 0) {
                for (int sl = 0; sl < nsl; ++sl) {
                    const unsigned char* pr = pbase + (size_t)(sl * TSM + row - TP) * (size_t)ppitch;
#pragma unroll
                    for (int j = 0; j < 4; ++j) v[j] += *(const f32x4*)(pr + 16 * (lane + 64 * j));
                }
                ss = 0.f;
#pragma unroll
                for (int j = 0; j < 4; ++j) { ss += v[j][0] * v[j][0] + v[j][1] * v[j][1] + v[j][2] * v[j][2] + v[j][3] * v[j][3];
                    if (mode != 2) *(f32x4*)(p.out + (size_t)row * D + 4 * (lane + 64 * j)) = v[j]; }
                ss = wave_sum64(ss);
            }
        }
        const float rstd = rsqrtf(ss * (1.f / D) + EPS);
#pragma unroll
        for (int j = 0; j < 4; ++j) v[j] = v[j] * rstd * gv[j];
        if (mode == 2) {
#pragma unroll
            for (int j = 0; j < 4; ++j) *(f32x4*)(p.out + (size_t)row * D + 4 * (lane + 64 * j)) = v[j];
            continue;
        }
#pragma unroll
        for (int j = 0; j < 4; ++j) { u32x2 o; o.x = pk2(v[j][0], v[j][1]); o.y = pk2(v[j][2], v[j][3]); *(u32x2*)(h + (size_t)row * D + 4 * (lane + 64 * j)) = o; }
        if (mode == 0) {
            float d8[8];
#pragma unroll
            for (int c = 0; c < 8; ++c) d8[c] = 0.f;
#pragma unroll
            for (int j = 0; j < 4; ++j)
#pragma unroll
                for (int i = 0; i < 4; ++i) { const int k = 4 * (lane + 64 * j) + i; const f32x4 w0 = *(const f32x4*)(wab + k * 8), w1 = *(const f32x4*)(wab + k * 8 + 4); const float hv = v[j][i];
                    d8[0] += hv * w0[0]; d8[1] += hv * w0[1]; d8[2] += hv * w0[2]; d8[3] += hv * w0[3]; d8[4] += hv * w1[0]; d8[5] += hv * w1[1]; d8[6] += hv * w1[2]; d8[7] += hv * w1[3]; }
#pragma unroll
            for (int c = 0; c < 8; ++c) d8[c] = wave_sum64(d8[c]);
            if (lane < 8) {
                float val = 0.f;
#pragma unroll
                for (int c = 0; c < 8; ++c) val = (lane == c) ? d8[c] : val;
                float res;
                if (lane < 4) { const float xx = val + p.in[13][l * 4 + lane]; const float sp = xx > 20.f ? xx : log1pf(expf(xx)); res = -expf(p.in[12][l * 4 + lane]) * sp; }
                else res = 1.f / (1.f + expf(-val));
                gb[(size_t)row * 8 + lane] = res;
            }
        }
    }
}

constexpr int DP_QB = 0, DP_KB = 17408, DP_KTT = 34816, DP_VU = 53248, DP_LM = 86016, DP_QKD = 102400, DP_SM = 111616;
__device__ __forceinline__ void delta_prep(const Params& p, unsigned char* smem, int l, int pi) {
    const int tid = opaque_tid(), lane = tid & 63, w = tid >> 6, fr = lane & 15, fq = lane >> 4;
    const bool prompt = pi < 2048;
    const int sid = prompt ? (pi >> 5) : (pi - 2048), n = prompt ? (pi & 31) : 0;
    const int b = sid >> 2, hh = sid & 3;
    const int rowbase = prompt ? b * SEQ : TP + b * 64, L = prompt ? SEQ : 64, t0 = n * 64;
    const bf16_t* proj = (const bf16_t*)(p.ws + WS_R2);
    const float* gb = (const float*)(p.ws + WS_GB);
    bf16_t* QB = (bf16_t*)(smem + DP_QB); bf16_t* KB = (bf16_t*)(smem + DP_KB); bf16_t* KTT = (bf16_t*)(smem + DP_KTT);
    float* VU = (float*)(smem + DP_VU); float* LM = (float*)(smem + DP_LM); bf16_t* QKD = (bf16_t*)(smem + DP_QKD);
    float* sG = (float*)(smem + DP_SM); float* sgam = sG + 64; float* sbeta = sG + 128; float* stail = sG + 192; float* sbg = sG + 256;
    const float* convw = p.in[10] + l * 6144; const float* convb = p.in[11] + l * 1536;
    const float* cbuf = p.in[3] + ((size_t)l * 16 + b) * 3 * 1536;
    u32x4 raw[6][4];
#pragma unroll
    for (int zp = 0; zp < 6; ++zp) {
        const int z = zp >> 1, item = tid + 512 * (zp & 1), row = item >> 4, seg = item & 15, cq = z * 512 + hh * 128 + seg * 8;
#pragma unroll
        for (int i = 0; i < 4; ++i) {
            const int tt = t0 + row - 3 + i;
            if (tt >= 0) raw[zp][i] = *(const u32x4*)(proj + (size_t)(rowbase + tt) * NPROJ + cq);
            else if (!prompt) { const f32x4 c0 = *(const f32x4*)(cbuf + (3 + tt) * 1536 + cq), c1 = *(const f32x4*)(cbuf + (3 + tt) * 1536 + cq + 4);
                raw[zp][i].x = pk2(c0[0], c0[1]); raw[zp][i].y = pk2(c0[2], c0[3]); raw[zp][i].z = pk2(c1[0], c1[1]); raw[zp][i].w = pk2(c1[2], c1[3]); }
            else raw[zp][i] = (u32x4){0u, 0u, 0u, 0u};
        }
    }
    if (tid < 64) {
        const float g = gb[(size_t)(rowbase + t0 + tid) * 8 + hh], be = gb[(size_t)(rowbase + t0 + tid) * 8 + 4 + hh];
        float G = g;
#pragma unroll
        for (int o = 1; o < 64; o <<= 1) { const float t = __shfl_up(G, o); if (lane >= o) G += t; }
        const float Gl = __shfl(G, 63);
        sG[tid] = G; sgam[tid] = __expf(G); sbeta[tid] = be; stail[tid] = __expf(Gl - G); sbg[tid] = be * __expf(G);
    }
    __syncthreads();
#pragma unroll
    for (int zp = 0; zp < 6; ++zp) {
        const int z = zp >> 1, item = tid + 512 * (zp & 1), row = item >> 4, seg = item & 15, cq = z * 512 + hh * 128 + seg * 8;
        float y[8];
        { const f32x4 b0 = *(const f32x4*)(convb + cq), b1 = *(const f32x4*)(convb + cq + 4); y[0] = b0[0]; y[1] = b0[1]; y[2] = b0[2]; y[3] = b0[3]; y[4] = b1[0]; y[5] = b1[1]; y[6] = b1[2]; y[7] = b1[3]; }
#pragma unroll
        for (int i = 0; i < 4; ++i) {
            float x[8]; unpack8(raw[zp][i], x);
            const f32x4 w0 = *(const f32x4*)(convw + i * 1536 + cq), w1 = *(const f32x4*)(convw + i * 1536 + cq + 4);
            y[0] += w0[0] * x[0]; y[1] += w0[1] * x[1]; y[2] += w0[2] * x[2]; y[3] += w0[3] * x[3]; y[4] += w1[0] * x[4]; y[5] += w1[1] * x[5]; y[6] += w1[2] * x[6]; y[7] += w1[3] * x[7];
        }
        float ss = 0.f;
#pragma unroll
        for (int e = 0; e < 8; ++e) { y[e] = siluf(y[e]); ss += y[e] * y[e]; }
        if (z < 2) {
            ss = row_sum16(ss);
            const float sc = rsqrtf(ss + EPS) * (z == 0 ? 0.08838834764831845f : 1.f);
#pragma unroll
            for (int e = 0; e < 8; ++e) y[e] *= sc;
            u32x4 o; o.x = pk2(y[0], y[1]); o.y = pk2(y[2], y[3]); o.z = pk2(y[4], y[5]); o.w = pk2(y[6], y[7]);
            *(u32x4*)((z == 0 ? QB : KB) + row * 136 + seg * 8) = o;
            if (z == 1) { const float tl = stail[row];
#pragma unroll
                for (int e = 0; e < 8; ++e) KTT[(seg * 8 + e) * 72 + row] = f2bf(y[e] * tl); }
        } else {
            const float be = sbeta[row];
            *(f32x4*)(VU + row * 128 + seg * 8) = (f32x4){y[0] * be, y[1] * be, y[2] * be, y[3] * be};
            *(f32x4*)(VU + row * 128 + seg * 8 + 4) = (f32x4){y[4] * be, y[5] * be, y[6] * be, y[7] * be};
        }
        __builtin_amdgcn_sched_barrier(0);
    }
    __syncthreads();
    {
        const int ct = w >> 1;
#pragma unroll
        for (int si = 0; si < 2; ++si) {
            const int st = 2 * (w & 1) + si;
            f32x4 akk = (f32x4){0.f, 0.f, 0.f, 0.f}, aqk = (f32x4){0.f, 0.f, 0.f, 0.f};
#pragma unroll
            for (int ks = 0; ks < 4; ++ks) {
                const bf16x8 xk = *(const bf16x8*)(KB + (16 * ct + fr) * 136 + 32 * ks + 8 * fq);
                const bf16x8 xq = *(const bf16x8*)(QB + (16 * ct + fr) * 136 + 32 * ks + 8 * fq);
                const bf16x8 yk = *(const bf16x8*)(KB + (16 * st + fr) * 136 + 32 * ks + 8 * fq);
                akk = MFMA16(xk, yk, akk); aqk = MFMA16(xq, yk, aqk);
            }
            const int s = 16 * st + fr; const float Gs = sG[s];
#pragma unroll
            for (int j = 0; j < 4; ++j) {
                const int c = 16 * ct + 4 * fq + j; const float dec = __expf(fminf(sG[c] - Gs, 0.f));
                LM[c * 64 + s] = (c > s) ? sbeta[c] * dec * akk[j] : 0.f;
                QKD[c * 72 + s] = f2bf((c >= s) ? dec * aqk[j] : 0.f);
            }
        }
    }
    __syncthreads();
    if (tid < 256) {
        float x[64];
        const bool isv = tid < 128; const int d = tid - 128;
        int vzero; asm volatile("v_mov_b32 %0, 0" : "=v"(vzero));
        const float* LMv = LM + vzero;
        if (isv) {
#pragma unroll
            for (int c = 0; c < 64; ++c) x[c] = VU[c * 128 + tid];
        } else {
#pragma unroll
            for (int c = 0; c < 64; ++c) x[c] = bf2f(KB[c * 136 + d]) * sbg[c];
        }
#pragma unroll
        for (int c = 1; c < 64; ++c) {
            float r0 = x[c], r1 = 0.f;
#pragma unroll
            for (int s4 = 0; s4 < (c + 3) / 4; ++s4) {
                const f32x4 lv = *(const f32x4*)(LMv + c * 64 + 4 * s4);
                r0 -= lv[0] * x[4 * s4]; r1 -= lv[1] * x[4 * s4 + 1]; r0 -= lv[2] * x[4 * s4 + 2]; r1 -= lv[3] * x[4 * s4 + 3];
            }
            x[c] = r0 + r1;
            if ((c & 3) == 3) __builtin_amdgcn_sched_barrier(0);
        }
        if (isv) {
#pragma unroll
            for (int c = 0; c < 64; ++c) VU[c * 128 + tid] = x[c];
        } else {
#pragma unroll
            for (int c = 0; c < 64; ++c) KB[c * 136 + d] = f2bf(x[c]);
        }
    }
    __syncthreads();
    {
        bf16_t* recWU = (bf16_t*)(p.ws + WS_H) + (size_t)pi * 16384;
        bf16_t* recQK = (bf16_t*)(p.ws + WS_QK) + (size_t)pi * 16384;
        unsigned char* recD = p.ws + WS_DD + (size_t)pi * 8448;
#pragma unroll
        for (int k = 0; k < 2; ++k) {
            const int idx = tid + 512 * k, row = idx >> 4, sg = idx & 15;
            *(u32x4*)(recWU + row * 128 + sg * 8) = *(const u32x4*)(KB + row * 136 + sg * 8);
            const f32x4 u0 = *(const f32x4*)(VU + row * 128 + sg * 8), u1 = *(const f32x4*)(VU + row * 128 + sg * 8 + 4);
            u32x4 o; o.x = pk2(u0[0], u0[1]); o.y = pk2(u0[2], u0[3]); o.z = pk2(u1[0], u1[1]); o.w = pk2(u1[2], u1[3]);
            *(u32x4*)(recWU + 8192 + row * 128 + sg * 8) = o;
            *(u32x4*)(recQK + row * 128 + sg * 8) = *(const u32x4*)(QB + row * 136 + sg * 8);
            const int r2 = idx >> 3, s8 = idx & 7;
            *(u32x4*)(recQK + 8192 + r2 * 64 + s8 * 8) = *(const u32x4*)(KTT + r2 * 72 + s8 * 8);
        }
        { const int r2 = tid >> 3, s8 = tid & 7; *(u32x4*)((bf16_t*)recD + r2 * 64 + s8 * 8) = *(const u32x4*)(QKD + r2 * 72 + s8 * 8); }
        if (tid < 64) ((float*)(recD + 8192))[tid] = sgam[tid];
        if (n == (prompt ? 31 : 0)) {
            float* co = p.out + (prompt ? O_PQC : O_SQC) + ((size_t)l * 16 + b) * 3 * 1536;
            for (int idx = tid; idx < 1152; idx += 512) { const int r = idx / 384, rem = idx % 384, z = rem >> 7, c = rem & 127;
                co[r * 1536 + z * 512 + hh * 128 + c] = bf2f(proj[(size_t)(rowbase + L - 3 + r) * NPROJ + z * 512 + hh * 128 + c]); }
        }
    }
}

constexpr int D2_QB = 0, D2_KB = 18432, D2_VU = 35840, D2_LM = 53248, D2_SM = 69632, D2_HALF = 70912;
__device__ __forceinline__ void delta_prep2(const Params& p, unsigned char* smem, int l, int piA, int piB) {
    const int tid = opaque_tid(), half = __builtin_amdgcn_readfirstlane(tid >> 8), t = tid & 255, lane = t & 63, wl = t >> 6, fr = lane & 15, fq = lane >> 4;
    const int pi = (half && piB >= 0) ? piB : piA;
    const bool prompt = pi < 2048;
    const int sid = prompt ? (pi >> 5) : (pi - 2048), n = prompt ? (pi & 31) : 0;
    const int b = sid >> 2, hh = sid & 3;
    const int rowbase = prompt ? b * SEQ : TP + b * 64, L = prompt ? SEQ : 64, t0 = n * 64;
    const bf16_t* proj = (const bf16_t*)(p.ws + WS_R2);
    const float* gb = (const float*)(p.ws + WS_GB);
    unsigned char* sb = smem + half * D2_HALF;
    bf16_t* QB = (bf16_t*)(sb + D2_QB); bf16_t* KTT = QB; bf16_t* KB = (bf16_t*)(sb + D2_KB); bf16_t* VUb = (bf16_t*)(sb + D2_VU); float* LM = (float*)(sb + D2_LM);
    float* sG = (float*)(sb + D2_SM); float* sgam = sG + 64; float* sbeta = sG + 128; float* stail = sG + 192; float* sbg = sG + 256;
    const float* convw = p.in[10] + l * 6144; const float* convb = p.in[11] + l * 1536;
    const float* cbuf = p.in[3] + ((size_t)l * 16 + b) * 3 * 1536;
    bf16_t* recWU = (bf16_t*)(p.ws + WS_H) + (size_t)pi * 16384;
    bf16_t* recQK = (bf16_t*)(p.ws + WS_QK) + (size_t)pi * 16384;
    unsigned char* recD = p.ws + WS_DD + (size_t)pi * 8448;
    if (t < 64) {
        const float g = gb[(size_t)(rowbase + t0 + t) * 8 + hh], be = gb[(size_t)(rowbase + t0 + t) * 8 + 4 + hh];
        float G = g;
#pragma unroll
        for (int o = 1; o < 64; o <<= 1) { const float tt = __shfl_up(G, o); if (lane >= o) G += tt; }
        const float Gl = __shfl(G, 63);
        sG[t] = G; sgam[t] = __expf(G); sbeta[t] = be; stail[t] = __expf(Gl - G); sbg[t] = be * __expf(G);
        ((float*)(recD + 8192))[t] = __expf(G);
    }
    __syncthreads();
    auto load_raw = [&](const int z, u32x4 (&raw)[4][4]) {
#pragma unroll
        for (int k = 0; k < 4; ++k) {
            const int item = t + 256 * k, row = item >> 4, seg = item & 15, cq = z * 512 + hh * 128 + seg * 8;
#pragma unroll
            for (int i = 0; i < 4; ++i) {
                const int tt = t0 + row - 3 + i;
                if (tt >= 0) raw[k][i] = *(const u32x4*)(proj + (size_t)(rowbase + tt) * NPROJ + cq);
                else if (!prompt) { const f32x4 c0 = *(const f32x4*)(cbuf + (3 + tt) * 1536 + cq), c1 = *(const f32x4*)(cbuf + (3 + tt) * 1536 + cq + 4);
                    raw[k][i].x = pk2(c0[0], c0[1]); raw[k][i].y = pk2(c0[2], c0[3]); raw[k][i].z = pk2(c1[0], c1[1]); raw[k][i].w = pk2(c1[2], c1[3]); }
                else raw[k][i] = (u32x4){0u, 0u, 0u, 0u};
            }
        }
    };
    auto conv_tensor = [&](const int z, const u32x4 (&raw)[4][4]) {
#pragma unroll
        for (int k = 0; k < 4; ++k) {
            const int item = t + 256 * k, row = item >> 4, seg = item & 15, cq = z * 512 + hh * 128 + seg * 8;
            float y[8];
            { const f32x4 b0 = *(const f32x4*)(convb + cq), b1 = *(const f32x4*)(convb + cq + 4); y[0] = b0[0]; y[1] = b0[1]; y[2] = b0[2]; y[3] = b0[3]; y[4] = b1[0]; y[5] = b1[1]; y[6] = b1[2]; y[7] = b1[3]; }
#pragma unroll
            for (int i = 0; i < 4; ++i) {
                float x[8]; unpack8(raw[k][i], x);
                const f32x4 w0 = *(const f32x4*)(convw + i * 1536 + cq), w1 = *(const f32x4*)(convw + i * 1536 + cq + 4);
                y[0] += w0[0] * x[0]; y[1] += w0[1] * x[1]; y[2] += w0[2] * x[2]; y[3] += w0[3] * x[3]; y[4] += w1[0] * x[4]; y[5] += w1[1] * x[5]; y[6] += w1[2] * x[6]; y[7] += w1[3] * x[7];
            }
            float ss = 0.f;
#pragma unroll
            for (int e = 0; e < 8; ++e) { y[e] = siluf(y[e]); ss += y[e] * y[e]; }
            if (z < 2) {
                ss = row_sum16(ss);
                const float sc = rsqrtf(ss + EPS) * (z == 0 ? 0.08838834764831845f : 1.f);
                u32x4 o; o.x = pk2(y[0] * sc, y[1] * sc); o.y = pk2(y[2] * sc, y[3] * sc); o.z = pk2(y[4] * sc, y[5] * sc); o.w = pk2(y[6] * sc, y[7] * sc);
                *(u32x4*)((z == 0 ? QB : KB) + row * 136 + seg * 8) = o;
            } else {
                const float be = sbeta[row];
                u32x4 o; o.x = pk2(y[0] * be, y[1] * be); o.y = pk2(y[2] * be, y[3] * be); o.z = pk2(y[4] * be, y[5] * be); o.w = pk2(y[6] * be, y[7] * be);
                *(u32x4*)(VUb + row * 136 + seg * 8) = o;
            }
        }
    };
    {
        u32x4 rawA[4][4], rawB[4][4];
        load_raw(0, rawA); load_raw(1, rawB);
        conv_tensor(0, rawA);
        load_raw(2, rawA);
        conv_tensor(1, rawB);
        conv_tensor(2, rawA);
    }
    __syncthreads();
    {
        const int ct = wl; bf16_t* qkd_g = (bf16_t*)recD;
#pragma unroll 1
        for (int st = 0; st < 4; ++st) {
            f32x4 akk = (f32x4){0.f, 0.f, 0.f, 0.f}, aqk = (f32x4){0.f, 0.f, 0.f, 0.f};
#pragma unroll
            for (int ks = 0; ks < 4; ++ks) {
                const bf16x8 xk = *(const bf16x8*)(KB + (16 * ct + fr) * 136 + 32 * ks + 8 * fq);
                const bf16x8 xq = *(const bf16x8*)(QB + (16 * ct + fr) * 136 + 32 * ks + 8 * fq);
                const bf16x8 yk = *(const bf16x8*)(KB + (16 * st + fr) * 136 + 32 * ks + 8 * fq);
                akk = MFMA16(xk, yk, akk); aqk = MFMA16(xq, yk, aqk);
            }
            const int s = 16 * st + fr; const float Gs = sG[s];
#pragma unroll
            for (int j = 0; j < 4; ++j) {
                const int c = 16 * ct + 4 * fq + j; const float dec = __expf(fminf(sG[c] - Gs, 0.f));
                LM[c * 64 + s] = (c > s) ? sbeta[c] * dec * akk[j] : 0.f;
                qkd_g[c * 64 + s] = f2bf((c >= s) ? dec * aqk[j] : 0.f);
            }
        }
    }
    __syncthreads();
#pragma unroll
    for (int k = 0; k < 4; ++k) { const int idx = t + 256 * k, row = idx >> 4, sg = idx & 15; *(u32x4*)(recQK + row * 128 + sg * 8) = *(const u32x4*)(QB + row * 136 + sg * 8); }
    __syncthreads();
#pragma unroll
    for (int k = 0; k < 4; ++k) {
        const int item = t + 256 * k, row = item >> 4, seg = item & 15;
        float x[8]; unpack8(*(const u32x4*)(KB + row * 136 + seg * 8), x);
        const float tl = stail[row];
#pragma unroll
        for (int e = 0; e < 8; ++e) KTT[(seg * 8 + e) * 72 + row] = f2bf(x[e] * tl);
    }
    __syncthreads();
    int vzero; asm volatile("v_mov_b32 %0, 0" : "=v"(vzero));
    if (vzero == 0) {
        float x[64];
        const bool isv = t < 128; const int d = t - 128;
        const float* LMv = LM + vzero;
        bf16_t* col = isv ? (VUb + t) : (KB + d);
#pragma unroll
        for (int c = 0; c < 64; ++c) x[c] = bf2f(col[c * 136]) * (isv ? 1.f : sbg[c]);
#pragma unroll
        for (int c = 1; c < 64; ++c) {
            float r0 = x[c], r1 = 0.f;
#pragma unroll
            for (int s4 = 0; s4 < (c + 3) / 4; ++s4) {
                const f32x4 lv = *(const f32x4*)(LMv + c * 64 + 4 * s4);
                r0 -= lv[0] * x[4 * s4]; r1 -= lv[1] * x[4 * s4 + 1]; r0 -= lv[2] * x[4 * s4 + 2]; r1 -= lv[3] * x[4 * s4 + 3];
            }
            x[c] = r0 + r1;
            if ((c & 3) == 3) __builtin_amdgcn_sched_barrier(0);
        }
#pragma unroll
        for (int c = 0; c < 64; ++c) col[c * 136] = f2bf(x[c]);
    }
    __syncthreads();
#pragma unroll
    for (int k = 0; k < 4; ++k) {
        const int idx = t + 256 * k, row = idx >> 4, sg = idx & 15;
        *(u32x4*)(recWU + row * 128 + sg * 8) = *(const u32x4*)(KB + row * 136 + sg * 8);
        *(u32x4*)(recWU + 8192 + row * 128 + sg * 8) = *(const u32x4*)(VUb + row * 136 + sg * 8);
        const int r2 = idx >> 3, s8 = idx & 7;
        *(u32x4*)(recQK + 8192 + r2 * 64 + s8 * 8) = *(const u32x4*)(KTT + r2 * 72 + s8 * 8);
    }
    if (n == (prompt ? 31 : 0)) {
        float* co = p.out + (prompt ? O_PQC : O_SQC) + ((size_t)l * 16 + b) * 3 * 1536;
        for (int idx = t; idx < 1152; idx += 256) { const int r = idx / 384, rem = idx % 384, z = rem >> 7, c = rem & 127;
            co[r * 1536 + z * 512 + hh * 128 + c] = bf2f(proj[(size_t)(rowbase + L - 3 + r) * NPROJ + z * 512 + hh * 128 + c]); }
    }
}

constexpr int SC_WB = 0, SC_UB = 17408, SC_QB = 34816, SC_KTT = 52224, SC_QKD = 70656, SC_DT = 79872, SC_STB = 98304, SC_SM = 133120;
__device__ __forceinline__ void delta_scan(const Params& p, unsigned char* smem, int l, int sid) {
    const int tid = opaque_tid(), lane = tid & 63, w = tid >> 6, fr = lane & 15, fq = lane >> 4;
    const bool prompt = sid < 64;
    const int s2 = prompt ? sid : sid - 64, b = s2 >> 2, hh = s2 & 3;
    const int rowbase = prompt ? b * SEQ : TP + b * 64, nch = prompt ? 32 : 1, pi0 = prompt ? s2 * 32 : 2048 + s2;
    bf16_t* proj = (bf16_t*)(p.ws + WS_R2);
    bf16_t* WB = (bf16_t*)(smem + SC_WB); bf16_t* UB = (bf16_t*)(smem + SC_UB); bf16_t* QB = (bf16_t*)(smem + SC_QB); bf16_t* KTT = (bf16_t*)(smem + SC_KTT);
    bf16_t* QKD = (bf16_t*)(smem + SC_QKD); bf16_t* DT = (bf16_t*)(smem + SC_DT) + w * 16 * 72; bf16_t* STB = (bf16_t*)(smem + SC_STB);
    float* sgam = (float*)(smem + SC_SM); float* osq = sgam + 64;
    f32x4 accS[8];
    if (prompt) {
#pragma unroll
        for (int dt = 0; dt < 8; ++dt) accS[dt] = (f32x4){0.f, 0.f, 0.f, 0.f};
    } else {
        const float* s0 = p.in[2] + (((size_t)l * 16 + b) * 4 + hh) * 16384;
#pragma unroll
        for (int dt = 0; dt < 8; ++dt)
#pragma unroll
            for (int j = 0; j < 4; ++j) accS[dt][j] = s0[(16 * dt + 4 * fq + j) * 128 + 16 * w + fr];
    }
#pragma unroll
    for (int dt = 0; dt < 8; ++dt) { u32x2 o; o.x = pk2(accS[dt][0], accS[dt][1]); o.y = pk2(accS[dt][2], accS[dt][3]); *(u32x2*)(STB + (16 * w + fr) * 136 + 16 * dt + 4 * fq) = o; }
    u32x4 pre[9]; float pgam = 0.f; u32x2 zr[4];
    auto load_chunk = [&](int n) {
        const size_t pi = (size_t)(pi0 + n);
        const u32x4* wu = (const u32x4*)((const bf16_t*)(p.ws + WS_H) + pi * 16384);
        const u32x4* qk = (const u32x4*)((const bf16_t*)(p.ws + WS_QK) + pi * 16384);
        const unsigned char* dd = p.ws + WS_DD + pi * 8448;
#pragma unroll
        for (int k = 0; k < 4; ++k) pre[k] = wu[tid + 512 * k];
#pragma unroll
        for (int k = 0; k < 4; ++k) pre[4 + k] = qk[tid + 512 * k];
        pre[8] = ((const u32x4*)dd)[tid];
        if (tid < 64) pgam = ((const float*)(dd + 8192))[tid];
#pragma unroll
        for (int ct = 0; ct < 4; ++ct) zr[ct] = *(const u32x2*)(proj + (size_t)(rowbase + n * 64 + 16 * ct + fr) * NPROJ + C_AZ + hh * 128 + 16 * w + 4 * fq);
    };
    load_chunk(0);
    const f32x4 an4 = *(const f32x4*)(p.in[14] + l * 128 + 16 * w + 4 * fq);
    for (int n = 0; n < nch; ++n) {
        const int t0 = n * 64;
#pragma unroll
        for (int k = 0; k < 2; ++k) {
            const int idx = tid + 512 * k, row = idx >> 4, sg = idx & 15;
            *(u32x4*)(WB + row * 136 + sg * 8) = pre[k];
            *(u32x4*)(UB + row * 136 + sg * 8) = pre[2 + k];
            *(u32x4*)(QB + row * 136 + sg * 8) = pre[4 + k];
            const int r2 = idx >> 3, s8 = idx & 7;
            *(u32x4*)(KTT + r2 * 72 + s8 * 8) = pre[6 + k];
        }
        { const int r2 = tid >> 3, s8 = tid & 7; *(u32x4*)(QKD + r2 * 72 + s8 * 8) = pre[8]; }
        if (tid < 64) sgam[tid] = pgam;
        u32x2 zc[4];
#pragma unroll
        for (int i = 0; i < 4; ++i) zc[i] = zr[i];
        __syncthreads();
        if (n + 1 < nch) load_chunk(n + 1);
        f32x4 oacc[4];
        {
            bf16x8 ysb[4];
#pragma unroll
            for (int ks = 0; ks < 4; ++ks) ysb[ks] = *(const bf16x8*)(STB + (16 * w + fr) * 136 + 32 * ks + 8 * fq);
#pragma unroll
            for (int ct = 0; ct < 4; ++ct) {
                f32x4 a = (f32x4){0.f, 0.f, 0.f, 0.f};
#pragma unroll
                for (int ks = 0; ks < 4; ++ks) a = MFMA16(*(const bf16x8*)(WB + (16 * ct + fr) * 136 + 32 * ks + 8 * fq), ysb[ks], a);
                float dl[4];
#pragma unroll
                for (int j = 0; j < 4; ++j) dl[j] = bf2f(UB[(16 * ct + 4 * fq + j) * 136 + 16 * w + fr]) - a[j];
                u32x2 o; o.x = pk2(dl[0], dl[1]); o.y = pk2(dl[2], dl[3]);
                *(u32x2*)(DT + fr * 72 + 16 * ct + 4 * fq) = o;
            }
            asm volatile("s_waitcnt lgkmcnt(0)" ::: "memory");
            bf16x8 ydt[2];
#pragma unroll
            for (int ks = 0; ks < 2; ++ks) ydt[ks] = *(const bf16x8*)(DT + fr * 72 + 32 * ks + 8 * fq);
#pragma unroll
            for (int ct = 0; ct < 4; ++ct) {
                f32x4 a1 = (f32x4){0.f, 0.f, 0.f, 0.f}, a2 = (f32x4){0.f, 0.f, 0.f, 0.f};
#pragma unroll
                for (int ks = 0; ks < 4; ++ks) a1 = MFMA16(ysb[ks], *(const bf16x8*)(QB + (16 * ct + fr) * 136 + 32 * ks + 8 * fq), a1);
#pragma unroll
                for (int ks = 0; ks < 2; ++ks) a2 = MFMA16(ydt[ks], *(const bf16x8*)(QKD + (16 * ct + fr) * 72 + 32 * ks + 8 * fq), a2);
                const float gm = sgam[16 * ct + fr];
                const f32x4 o = a1 * gm + a2;
                oacc[ct] = o;
                float sq = (o[0] * o[0] + o[1] * o[1]) + (o[2] * o[2] + o[3] * o[3]);
                sq += __shfl_xor(sq, 16); sq += __shfl_xor(sq, 32);
                if (fq == 0) osq[w * 64 + 16 * ct + fr] = sq;
                __builtin_amdgcn_sched_barrier(0);
            }
            const float gl = sgam[63];
#pragma unroll
            for (int dt = 0; dt < 8; ++dt) {
                f32x4 a = accS[dt] * gl;
#pragma unroll
                for (int ks = 0; ks < 2; ++ks) a = MFMA16(*(const bf16x8*)(KTT + (16 * dt + fr) * 72 + 32 * ks + 8 * fq), ydt[ks], a);
                accS[dt] = a;
                u32x2 o; o.x = pk2(a[0], a[1]); o.y = pk2(a[2], a[3]);
                *(u32x2*)(STB + (16 * w + fr) * 136 + 16 * dt + 4 * fq) = o;
                if (dt & 1) __builtin_amdgcn_sched_barrier(0);
            }
        }
        __syncthreads();
#pragma unroll
        for (int ct = 0; ct < 4; ++ct) {
            const int c = 16 * ct + fr;
            float tot = 0.f;
#pragma unroll
            for (int ww = 0; ww < 8; ++ww) tot += osq[ww * 64 + c];
            const float ri = rsqrtf(tot * (1.f / 128.f) + EPS);
            const float z0 = bflo(zc[ct].x), z1 = bfhi(zc[ct].x), z2 = bflo(zc[ct].y), z3 = bfhi(zc[ct].y);
            u32x2 ov; ov.x = pk2(oacc[ct][0] * ri * an4[0] * siluf(z0), oacc[ct][1] * ri * an4[1] * siluf(z1));
            ov.y = pk2(oacc[ct][2] * ri * an4[2] * siluf(z2), oacc[ct][3] * ri * an4[3] * siluf(z3));
            *(u32x2*)(proj + (size_t)(rowbase + t0 + c) * NPROJ + C_AZ + hh * 128 + 16 * w + 4 * fq) = ov;
        }
    }
    {
        float* so = p.out + (prompt ? O_PSD : O_SSD) + (((size_t)l * 16 + b) * 4 + hh) * 16384;
#pragma unroll
        for (int dt = 0; dt < 8; ++dt)
#pragma unroll
            for (int j = 0; j < 4; ++j) so[(16 * dt + 4 * fq + j) * 128 + 16 * w + fr] = accS[dt][j];
    }
    __syncthreads();
}

constexpr int AT_KS = 0, AT_VT = 34816, AT_OB = 71680;
__device__ __forceinline__ void attn_item(const Params& p, unsigned char* smem, int l, bool prompt, int b, int hh, int qc, float lam, float lam_init) {
    const int tid = opaque_tid(), lane = tid & 63, w = tid >> 6, fr = lane & 15, fq = lane >> 4, map = w >> 2, rb = w & 3;
    const bf16_t* proj = (const bf16_t*)(p.ws + WS_R2);
    bf16_t* mixed = (bf16_t*)(p.ws + WS_R2);
    const int row0 = prompt ? b * SEQ + qc * 64 : TP + b * 64;
    const int nt = prompt ? qc + 1 : 33;
    const float* ck = p.in[4] + ((size_t)l * 16 + b) * 2048 * 512 + hh * 128;
    const float* cv = p.in[5] + ((size_t)l * 16 + b) * 2048 * 512 + hh * 128;
    bf16_t* Ks = (bf16_t*)(smem + AT_KS); bf16_t* Vt = (bf16_t*)(smem + AT_VT); float* ob = (float*)(smem + AT_OB);
    bf16x8 qf[2];
#pragma unroll
    for (int ks = 0; ks < 2; ++ks) qf[ks] = *(const bf16x8*)(proj + (size_t)(row0 + rb * 16 + fr) * NPROJ + C_BQ + hh * 128 + map * 64 + 32 * ks + 8 * fq);
    const int lkey = tid >> 3, lseg = tid & 7;
    const int vkp = tid >> 4, ves = tid & 15;
    u32x4 rk[2], rv[2];
    auto load_tile = [&](int t) {
        if (prompt || t == 32) {
            const size_t rbase = prompt ? (size_t)(b * SEQ + t * 64) : (size_t)(TP + b * 64);
            const bf16_t* src = proj + (rbase + lkey) * NPROJ + hh * 128 + lseg * 16;
            rk[0] = *(const u32x4*)(src + C_BK); rk[1] = *(const u32x4*)(src + C_BK + 8);
            const bf16_t* sv = proj + (rbase + 2 * vkp) * NPROJ + C_BV + hh * 128 + ves * 8;
            rv[0] = *(const u32x4*)sv; rv[1] = *(const u32x4*)(sv + NPROJ);
        } else {
            const size_t o = (size_t)(t * 64 + lkey) * 512 + lseg * 16;
#pragma unroll
            for (int i = 0; i < 2; ++i) {
                const f32x4 a = *(const f32x4*)(ck + o + 8 * i), c = *(const f32x4*)(ck + o + 8 * i + 4);
                rk[i].x = pk2(a[0], a[1]); rk[i].y = pk2(a[2], a[3]); rk[i].z = pk2(c[0], c[1]); rk[i].w = pk2(c[2], c[3]);
                const size_t ov = (size_t)(t * 64 + 2 * vkp + i) * 512 + ves * 8;
                const f32x4 a2 = *(const f32x4*)(cv + ov), c2 = *(const f32x4*)(cv + ov + 4);
                rv[i].x = pk2(a2[0], a2[1]); rv[i].y = pk2(a2[2], a2[3]); rv[i].z = pk2(c2[0], c2[1]); rv[i].w = pk2(c2[2], c2[3]);
            }
        }
    };
    auto store_tile = [&](int buf) {
        bf16_t* kd = Ks + buf * 64 * 136 + lkey * 136 + lseg * 16;
        *(u32x4*)kd = rk[0]; *(u32x4*)(kd + 8) = rk[1];
        unsigned* vd = (unsigned*)(Vt + buf * 128 * 72 + (ves * 8) * 72) + (vkp ^ (2 * ves));
        const unsigned a0 = rv[0].x, a1 = rv[0].y, a2 = rv[0].z, a3 = rv[0].w, b0 = rv[1].x, b1 = rv[1].y, b2 = rv[1].z, b3 = rv[1].w;
        vd[0 * 36] = __builtin_amdgcn_perm(b0, a0, 0x05040100u); vd[1 * 36] = __builtin_amdgcn_perm(b0, a0, 0x07060302u);
        vd[2 * 36] = __builtin_amdgcn_perm(b1, a1, 0x05040100u); vd[3 * 36] = __builtin_amdgcn_perm(b1, a1, 0x07060302u);
        vd[4 * 36] = __builtin_amdgcn_perm(b2, a2, 0x05040100u); vd[5 * 36] = __builtin_amdgcn_perm(b2, a2, 0x07060302u);
        vd[6 * 36] = __builtin_amdgcn_perm(b3, a3, 0x05040100u); vd[7 * 36] = __builtin_amdgcn_perm(b3, a3, 0x07060302u);
    };
    f32x4 oacc[8];
#pragma unroll
    for (int et = 0; et < 8; ++et) oacc[et] = (f32x4){0.f, 0.f, 0.f, 0.f};
    float m_run = -INFINITY, l_run = 0.f;
    const float cs = 0.125f * 1.4426950408889634f;
    load_tile(0); store_tile(0);
    __syncthreads();
    asm volatile("" : "+v"(qf[0]), "+v"(qf[1]));
    for (int t = 0; t < nt; ++t) {
        const int buf = t & 1;
        if (t + 1 < nt) load_tile(t + 1);
        const bf16_t* kb = Ks + buf * 64 * 136; const bf16_t* vb = Vt + buf * 128 * 72;
        f32x4 sacc[4];
#pragma unroll
        for (int kt = 0; kt < 4; ++kt) {
            f32x4 a = (f32x4){0.f, 0.f, 0.f, 0.f};
#pragma unroll
            for (int ks = 0; ks < 2; ++ks) a = MFMA16(*(const bf16x8*)(kb + (16 * kt + fr) * 136 + map * 64 + 32 * ks + 8 * fq), qf[ks], a);
            sacc[kt] = a;
        }
        float mx = sacc[0][0];
#pragma unroll
        for (int kt = 0; kt < 4; ++kt)
#pragma unroll
            for (int j = 0; j < 4; ++j) mx = fmaxf(mx, sacc[kt][j]);
        mx = fmaxf(mx, __shfl_xor(mx, 16)); mx = fmaxf(mx, __shfl_xor(mx, 32));
        const float m_new = fmaxf(m_run, mx);
        const float alpha = __builtin_amdgcn_exp2f((m_run - m_new) * cs);
        m_run = m_new;
        float psum = 0.f;
        bf16x8 pf[2];
#pragma unroll
        for (int ks = 0; ks < 2; ++ks) {
            float pv[8];
#pragma unroll
            for (int i = 0; i < 8; ++i) { pv[i] = __builtin_amdgcn_exp2f((sacc[2 * ks + (i >> 2)][i & 3] - m_new) * cs); psum += pv[i]; }
            u32x4 pk; pk.x = pk2(pv[0], pv[1]); pk.y = pk2(pv[2], pv[3]); pk.z = pk2(pv[4], pv[5]); pk.w = pk2(pv[6], pv[7]);
            pf[ks] = __builtin_bit_cast(bf16x8, pk);
        }
        l_run = l_run * alpha + psum;
#pragma unroll
        for (int et = 0; et < 8; ++et) {
            f32x4 a = oacc[et] * alpha;
#pragma unroll
            for (int ks = 0; ks < 2; ++ks) {
                const int sw = 2 * (2 * et + (fr >> 3));
                const bf16x4 v0 = *(const bf16x4*)(vb + (16 * et + fr) * 72 + 2 * ((16 * ks + 2 * fq) ^ sw));
                const bf16x4 v1 = *(const bf16x4*)(vb + (16 * et + fr) * 72 + 2 * ((16 * ks + 8 + 2 * fq) ^ sw));
                const bf16x8 vx = __builtin_shufflevector(v0, v1, 0, 1, 2, 3, 4, 5, 6, 7);
                a = MFMA16(vx, pf[ks], a);
            }
            oacc[et] = a;
        }
        if (t + 1 < nt) store_tile(buf ^ 1);
        __syncthreads();
    }
    float lt = l_run; lt += __shfl_xor(lt, 16); lt += __shfl_xor(lt, 32);
    const float inv = 1.f / lt;
    const int q = rb * 16 + fr;
    if (map == 1) {
#pragma unroll
        for (int et = 0; et < 8; ++et)
#pragma unroll
            for (int j = 0; j < 4; ++j) ob[q * 129 + 16 * et + 4 * fq + j] = oacc[et][j] * inv * lam;
    }
    __syncthreads();
    if (map == 0) {
        float ss = 0.f;
#pragma unroll
        for (int et = 0; et < 8; ++et)
#pragma unroll
            for (int j = 0; j < 4; ++j) { const float o = oacc[et][j] * inv - ob[q * 129 + 16 * et + 4 * fq + j]; oacc[et][j] = o; ss += o * o; }
        ss += __shfl_xor(ss, 16); ss += __shfl_xor(ss, 32);
        const float sc = rsqrtf(ss * (1.f / 128.f) + EPS) * (1.f - lam_init);
        const float* bn = p.in[16] + l * 128;
#pragma unroll
        for (int et = 0; et < 8; ++et) {
            const int e = 16 * et + 4 * fq; const f32x4 g4 = *(const f32x4*)(bn + e);
            u32x2 o; o.x = pk2(oacc[et][0] * sc * g4[0], oacc[et][1] * sc * g4[1]); o.y = pk2(oacc[et][2] * sc * g4[2], oacc[et][3] * sc * g4[3]);
            *(u32x2*)(mixed + (size_t)(row0 + q) * NPROJ + C_BQ + hh * 128 + e) = o;
        }
    }
}

constexpr int PL_XS = 0, PL_PB = 40448;
__device__ __forceinline__ void pool_item(const Params& p, unsigned char* smem, int l, int pt, int gi) {
    const int tid = opaque_tid(), lane = tid & 63, w = tid >> 6, fr = lane & 15, fq = lane >> 4;
    const bf16_t* proj = (const bf16_t*)(p.ws + WS_R2);
    bf16_t* mixed = (bf16_t*)(p.ws + WS_R2);
    const int r0 = pt * 64; const bool prompt = r0 < TP;
    const int b = prompt ? (r0 >> 11) : ((r0 - TP) >> 6), t0 = prompt ? (r0 & 2047) : 0;
    float* xs = (float*)(smem + PL_XS); bf16_t* pb = (bf16_t*)(smem + PL_PB);
    const float* cpool = p.in[6] + ((size_t)l * 16 + b) * 15 * 512 + gi * 128;
    {
        u32x4 raw[3]; f32x4 ca[3], cc[3];
#pragma unroll
        for (int k = 0; k < 3; ++k) {
            const int idx = tid + 512 * k, rr = idx >> 4, sg = idx & 15, tt = t0 + rr - 15;
            raw[k] = (u32x4){0u, 0u, 0u, 0u}; ca[k] = (f32x4){0.f, 0.f, 0.f, 0.f}; cc[k] = ca[k];
            if (idx < 79 * 16) {
                if (tt >= 0) raw[k] = *(const u32x4*)(proj + (size_t)(r0 + rr - 15) * NPROJ + C_CX + gi * 128 + sg * 8);
                else if (!prompt) { ca[k] = *(const f32x4*)(cpool + (15 + tt) * 512 + sg * 8); cc[k] = *(const f32x4*)(cpool + (15 + tt) * 512 + sg * 8 + 4); }
            }
        }
#pragma unroll
        for (int k = 0; k < 3; ++k) {
            const int idx = tid + 512 * k, rr = idx >> 4, sg = idx & 15, tt = t0 + rr - 15;
            if (idx < 79 * 16) {
                float x[8];
                if (tt >= 0) unpack8(raw[k], x);
                else { x[0] = ca[k][0]; x[1] = ca[k][1]; x[2] = ca[k][2]; x[3] = ca[k][3]; x[4] = cc[k][0]; x[5] = cc[k][1]; x[6] = cc[k][2]; x[7] = cc[k][3]; }
                *(f32x4*)(xs + rr * 128 + sg * 8) = (f32x4){x[0], x[1], x[2], x[3]}; *(f32x4*)(xs + rr * 128 + sg * 8 + 4) = (f32x4){x[4], x[5], x[6], x[7]};
            }
        }
    }
    __syncthreads();
    const int win = 2 << gi;
    {
        const int c = tid & 127, tf = (tid >> 7) * 16;
        float s = 0.f;
        for (int j = 0; j < win; ++j) s += xs[(15 + tf - j) * 128 + c];
#pragma unroll 4
        for (int tt = 0; tt < 16; ++tt) {
            const int t = tf + tt; const float xt = xs[(15 + t) * 128 + c];
            if (tt > 0) s += xt - xs[(15 + t - win) * 128 + c];
            const int cnt = prompt ? min(t0 + t + 1, win) : win;
            pb[t * 136 + c] = f2bf(s / (float)cnt - xt);
        }
    }
    if (!prompt || t0 == SEQ - 64) {
        float* po = p.out + (prompt ? O_PPOOL : O_SPOOL) + ((size_t)l * 16 + b) * 15 * 512 + gi * 128;
        for (int idx = tid; idx < 15 * 128; idx += 512) { const int rr = idx >> 7, c = idx & 127; po[rr * 512 + c] = xs[(15 + 49 + rr) * 128 + c]; }
    }
    __syncthreads();
    const bf16_t* cw = (const bf16_t*)(p.ws + WS_CW) + ((size_t)l * 4 + gi) * 16384;
    bf16x8 yf[4];
#pragma unroll
    for (int ks = 0; ks < 4; ++ks) yf[ks] = *(const bf16x8*)(cw + (16 * w + fr) * 128 + 32 * ks + 8 * fq);
    const f32x4 sc4 = *(const f32x4*)(p.in[18] + l * 512 + gi * 128 + 16 * w + 4 * fq);
#pragma unroll
    for (int tt = 0; tt < 4; ++tt) {
        f32x4 a = (f32x4){0.f, 0.f, 0.f, 0.f};
#pragma unroll
        for (int ks = 0; ks < 4; ++ks) a = MFMA16(yf[ks], *(const bf16x8*)(pb + (16 * tt + fr) * 136 + 32 * ks + 8 * fq), a);
        u32x2 o; o.x = pk2(a[0] * sc4[0], a[1] * sc4[1]); o.y = pk2(a[2] * sc4[2], a[3] * sc4[3]);
        *(u32x2*)(mixed + (size_t)(r0 + 16 * tt + fr) * NPROJ + C_PO + gi * 128 + 16 * w + 4 * fq) = o;
    }
}

constexpr int PL2_HALF = 58368;
__device__ __forceinline__ void pool_item2(const Params& p, unsigned char* smem, int l, int itA) {
    const int tid = opaque_tid(), half = __builtin_amdgcn_readfirstlane(tid >> 8), t = tid & 255, lane = t & 63, wl = t >> 6, fr = lane & 15, fq = lane >> 4;
    const int item = itA + half, pt = item >> 2, gi = item & 3;
    const bf16_t* proj = (const bf16_t*)(p.ws + WS_R2);
    bf16_t* mixed = (bf16_t*)(p.ws + WS_R2);
    const int r0 = pt * 64; const bool prompt = r0 < TP;
    const int b = prompt ? (r0 >> 11) : ((r0 - TP) >> 6), t0 = prompt ? (r0 & 2047) : 0;
    float* xs = (float*)(smem + half * PL2_HALF); bf16_t* pb = (bf16_t*)(smem + half * PL2_HALF + 40448);
    const float* cpool = p.in[6] + ((size_t)l * 16 + b) * 15 * 512 + gi * 128;
    {
        u32x4 raw[5]; f32x4 ca[5], cc[5];
#pragma unroll
        for (int k = 0; k < 5; ++k) {
            const int idx = t + 256 * k, rr = idx >> 4, sg = idx & 15, tt = t0 + rr - 15;
            raw[k] = (u32x4){0u, 0u, 0u, 0u}; ca[k] = (f32x4){0.f, 0.f, 0.f, 0.f}; cc[k] = ca[k];
            if (idx < 79 * 16) {
                if (tt >= 0) raw[k] = *(const u32x4*)(proj + (size_t)(r0 + rr - 15) * NPROJ + C_CX + gi * 128 + sg * 8);
                else if (!prompt) { ca[k] = *(const f32x4*)(cpool + (15 + tt) * 512 + sg * 8); cc[k] = *(const f32x4*)(cpool + (15 + tt) * 512 + sg * 8 + 4); }
            }
        }
#pragma unroll
        for (int k = 0; k < 5; ++k) {
            const int idx = t + 256 * k, rr = idx >> 4, sg = idx & 15, tt = t0 + rr - 15;
            if (idx < 79 * 16) {
                float x[8];
                if (tt >= 0) unpack8(raw[k], x);
                else { x[0] = ca[k][0]; x[1] = ca[k][1]; x[2] = ca[k][2]; x[3] = ca[k][3]; x[4] = cc[k][0]; x[5] = cc[k][1]; x[6] = cc[k][2]; x[7] = cc[k][3]; }
                *(f32x4*)(xs + rr * 128 + sg * 8) = (f32x4){x[0], x[1], x[2], x[3]}; *(f32x4*)(xs + rr * 128 + sg * 8 + 4) = (f32x4){x[4], x[5], x[6], x[7]};
            }
        }
    }
    __syncthreads();
    const int win = 2 << gi;
    {
        const int c = t & 127, tf = (t >> 7) * 32;
        float s = 0.f;
        for (int j = 0; j < win; ++j) s += xs[(15 + tf - j) * 128 + c];
#pragma unroll 4
        for (int tt = 0; tt < 32; ++tt) {
            const int tq = tf + tt; const float xt = xs[(15 + tq) * 128 + c];
            if (tt > 0) s += xt - xs[(15 + tq - win) * 128 + c];
            const int cnt = prompt ? min(t0 + tq + 1, win) : win;
            pb[tq * 136 + c] = f2bf(s / (float)cnt - xt);
        }
    }
    if (!prompt || t0 == SEQ - 64) {
        float* po = p.out + (prompt ? O_PPOOL : O_SPOOL) + ((size_t)l * 16 + b) * 15 * 512 + gi * 128;
        for (int idx = t; idx < 15 * 128; idx += 256) { const int rr = idx >> 7, c = idx & 127; po[rr * 512 + c] = xs[(15 + 49 + rr) * 128 + c]; }
    }
    __syncthreads();
    const bf16_t* cw = (const bf16_t*)(p.ws + WS_CW) + ((size_t)l * 4 + gi) * 16384;
#pragma unroll
    for (int dh = 0; dh < 2; ++dh) {
        const int dt = 2 * wl + dh;
        bf16x8 yf[4];
#pragma unroll
        for (int ks = 0; ks < 4; ++ks) yf[ks] = *(const bf16x8*)(cw + (16 * dt + fr) * 128 + 32 * ks + 8 * fq);
        const f32x4 sc4 = *(const f32x4*)(p.in[18] + l * 512 + gi * 128 + 16 * dt + 4 * fq);
#pragma unroll
        for (int tt = 0; tt < 4; ++tt) {
            f32x4 a = (f32x4){0.f, 0.f, 0.f, 0.f};
#pragma unroll
            for (int ks = 0; ks < 4; ++ks) a = MFMA16(yf[ks], *(const bf16x8*)(pb + (16 * tt + fr) * 136 + 32 * ks + 8 * fq), a);
            u32x2 o; o.x = pk2(a[0] * sc4[0], a[1] * sc4[1]); o.y = pk2(a[2] * sc4[2], a[3] * sc4[3]);
            *(u32x2*)(mixed + (size_t)(r0 + 16 * tt + fr) * NPROJ + C_PO + gi * 128 + 16 * dt + 4 * fq) = o;
        }
    }
}

constexpr int N_PREP = 1056, N_PL = 1056, N_AS = 64, N_AP = 2048, N_AP_A = 0;
__device__ __forceinline__ void phase_mix(const Params& p, unsigned char* smem, int l, const bool second) {
    const int tid = opaque_tid();
    const float lam_init = (l == 0) ? 0.2f : 0.35550906759096924f;
    float lam;
    { const float* bl = p.in[15] + l * 256; float s1 = 0.f, s2 = 0.f;
        for (int i = 0; i < 64; ++i) { s1 += bl[i] * bl[64 + i]; s2 += bl[128 + i] * bl[192 + i]; }
        lam = expf(s1) - expf(s2) + lam_init; }
    if (second) { for (int sid = blockIdx.x; sid < 128; sid += gridDim.x) delta_scan(p, smem, l, sid); }
    unsigned* ctr = (unsigned*)(p.ws + WS_CTL) + l * 2 + (second ? 1 : 0);
    int* s_item = (int*)(smem + LDS_BYTES - 16);
    const int nitems = second ? (N_AP - N_AP_A) : (N_PREP + N_AS + N_AP_A + N_PL);
    for (;;) {
        __syncthreads();
        if (tid == 0) *s_item = (int)atomicAdd(ctr, 1u);
        __syncthreads();
        int item = *s_item;
        if (item >= nitems) break;
        if (second) { item += N_AP_A; const int qc = 31 - (item >> 6), bh = item & 63; attn_item(p, smem, l, true, bh >> 2, bh & 3, qc, lam, lam_init); continue; }
        if (item < N_AS) { attn_item(p, smem, l, false, item >> 2, item & 3, 0, lam, lam_init); continue; }
        item -= N_AS;
        if (item < N_PREP) { const int i0 = 2 * item, i1 = 2 * item + 1, c0 = i0 >> 6, q0 = i0 & 63, c1 = i1 >> 6, q1 = i1 & 63;
            delta_prep2(p, smem, l, c0 < 32 ? q0 * 32 + c0 : 2048 + q0, c1 < 32 ? q1 * 32 + c1 : 2048 + q1); continue; }
        item -= N_PREP;
        if (item < N_AP_A) { const int qc = 31 - (item >> 6), bh = item & 63; attn_item(p, smem, l, true, bh >> 2, bh & 3, qc, lam, lam_init); continue; }
        item -= N_AP_A;
        pool_item2(p, smem, l, 2 * item);
    }
}

__device__ __forceinline__ void phase_ffnconv(const Params& p, int l) {
    bf16_t* u = (bf16_t*)(p.ws + WS_R2); const bf16_t* side = (const bf16_t*)(p.ws + WS_SIDE);
    const float* cw = p.in[22] + l * 3 * NFF2; const float* cb = p.in[23] + l * NFF2;
    const int nitems = 1056 * 352;
    const int tid0 = opaque_tid();
    for (int item = blockIdx.x * NTHREADS + tid0; item < nitems; item += gridDim.x * NTHREADS) {
        const int seg = item / 352, j = (item % 352) * 8;
        float wg[3][8], wv[3][8], bg[8], bv[8];
#pragma unroll
        for (int i = 0; i < 3; ++i) {
            const f32x4 a0 = *(const f32x4*)(cw + i * NFF2 + j), a1 = *(const f32x4*)(cw + i * NFF2 + j + 4), c0 = *(const f32x4*)(cw + i * NFF2 + NFF + j), c1 = *(const f32x4*)(cw + i * NFF2 + NFF + j + 4);
#pragma unroll
            for (int e = 0; e < 4; ++e) { wg[i][e] = a0[e]; wg[i][4 + e] = a1[e]; wv[i][e] = c0[e]; wv[i][4 + e] = c1[e]; }
        }
        { const f32x4 a0 = *(const f32x4*)(cb + j), a1 = *(const f32x4*)(cb + j + 4), c0 = *(const f32x4*)(cb + NFF + j), c1 = *(const f32x4*)(cb + NFF + j + 4);
#pragma unroll
            for (int e = 0; e < 4; ++e) { bg[e] = a0[e]; bg[4 + e] = a1[e]; bv[e] = c0[e]; bv[4 + e] = c1[e]; } }
        float g1[8], g2[8], v1[8], v2[8];
        const int r0 = seg * 32;
        if (r0 >= TP && ((r0 - TP) & 63) == 0) {
            const float* c = p.in[7] + ((size_t)l * 16 + ((r0 - TP) >> 6)) * 2 * NFF2;
#pragma unroll
            for (int e = 0; e < 8; ++e) { g1[e] = c[j + e]; v1[e] = c[NFF + j + e]; g2[e] = c[NFF2 + j + e]; v2[e] = c[NFF2 + NFF + j + e]; }
        } else if (r0 < TP && (r0 & 2047) == 0) {
#pragma unroll
            for (int e = 0; e < 8; ++e) { g1[e] = 0.f; g2[e] = 0.f; v1[e] = 0.f; v2[e] = 0.f; }
        } else {
            const bf16_t* sd = side + (size_t)(seg - 1) * 2 * NFF2;
            unpack8(*(const u32x4*)(sd + j), g1); unpack8(*(const u32x4*)(sd + NFF + j), v1); unpack8(*(const u32x4*)(sd + NFF2 + j), g2); unpack8(*(const u32x4*)(sd + NFF2 + NFF + j), v2);
        }
        bf16_t* ur = u + (size_t)r0 * NFF2 + j;
#pragma unroll 4
        for (int r = 0; r < 32; ++r) {
            float g3[8], v3[8];
            unpack8(*(const u32x4*)(ur + (size_t)r * NFF2), g3); unpack8(*(const u32x4*)(ur + (size_t)r * NFF2 + NFF), v3);
            float hh[8];
#pragma unroll
            for (int e = 0; e < 8; ++e) {
                const float cg = bg[e] + wg[0][e] * g1[e] + wg[1][e] * g2[e] + wg[2][e] * g3[e], cv = bv[e] + wv[0][e] * v1[e] + wv[1][e] * v2[e] + wv[2][e] * v3[e];
                hh[e] = siluf(cg) * cv; g1[e] = g2[e]; g2[e] = g3[e]; v1[e] = v2[e]; v2[e] = v3[e];
            }
            u32x4 o; o.x = pk2(hh[0], hh[1]); o.y = pk2(hh[2], hh[3]); o.z = pk2(hh[4], hh[5]); o.w = pk2(hh[6], hh[7]);
            *(u32x4*)(ur + (size_t)r * NFF2) = o;
        }
    }
}

template <int s> __device__ __forceinline__ void run_step(const Params& p, unsigned char* smem) {
    constexpr int l = s / 9, ph = s % 9;
    if constexpr (s == 18) { phase_norm(p, smem, 0, 2, 11, p.ws + WS_R2 + 5632, 11264); }
    else if constexpr (ph == 1 || ph == 4 || ph == 6 || ph == 8) {
        pg8::Gemm g; pg8::EpiAny E; bool perm = true;
        if constexpr (ph == 1) {
            g = pg8::Gemm{(const bf16_t*)(p.ws + WS_H), (const bf16_t*)(p.ws + WS_WIN) + (size_t)l * 4096 * 1024, T, NPN, 1024, 1024};
            E = pg8::EpiAny{0, l, p.ws + WS_R2, nullptr, p.out, 0};
        } else if constexpr (ph == 4) {
            g = pg8::Gemm{(const bf16_t*)(p.ws + WS_R2) + C_AZ, (const bf16_t*)(p.ws + WS_WOUT) + (size_t)l * 1024 * 1536, T, D, NMIX, NPROJ};
            E = pg8::EpiAny{1, l, (void*)(l == 0 ? p.in[0] : p.out), p.ws + WS_QK, p.out, 4096}; perm = false;
        } else if constexpr (ph == 6) {
            g = pg8::Gemm{(const bf16_t*)(p.ws + WS_H), (const bf16_t*)(p.ws + WS_WUP) + (size_t)l * NFF2 * 1024, T, NFF2, 1024, 1024};
            E = pg8::EpiAny{2, l, p.ws + WS_R2, p.ws + WS_SIDE, p.out, 0};
        } else {
            g = pg8::Gemm{(const bf16_t*)(p.ws + WS_R2), (const bf16_t*)(p.ws + WS_WDN) + (size_t)l * 1024 * NFF, T, D, NFF, NFF2};
            E = pg8::EpiAny{1, l, p.out, p.ws + WS_R2 + 5632, p.out, 11264}; perm = false;
        }
        pg8::StaticOrder S; S.init(g.M, g.N, g.K, gridDim.x, blockIdx.x, (ph == 4 || ph == 8) ? TSM : 0);
        pg8::gemm_phase((LAS unsigned char*)smem, g, S, E, perm);
    } else if constexpr (ph == 0) {
        if constexpr (l == 0) phase_weights(p, smem);
        if constexpr (l == 0) phase_norm(p, smem, l, 0); else phase_norm(p, smem, l, 0, 11, p.ws + WS_R2 + 5632, 11264);
    } else if constexpr (ph == 2) phase_mix(p, smem, l, false);
    else if constexpr (ph == 3) phase_mix(p, smem, l, true);
    else if constexpr (ph == 5) phase_norm(p, smem, l, 1, 6, p.ws + WS_QK, 4096);
    else phase_ffnconv(p, l);
}

#define XB_TMO      128
#define XB_XCNT(j)  (256  + 64 * (j))
#define XB_XSUB(j)  (1280 + 64 * (j))
#define XB_XGEN(j)  (2304 + 64 * (j))
#define XB_TOP      3328
#define XB_TOPGEN   3392
#define XCD_BAR_WORDS 3456
#define XB_SPIN_CAP (1u << 18)

__device__ __forceinline__ unsigned xb_ld(unsigned* p)              { return __hip_atomic_load(p, __ATOMIC_RELAXED, __HIP_MEMORY_SCOPE_AGENT); }
__device__ __forceinline__ unsigned xb_add(unsigned* p, unsigned v) { return __hip_atomic_fetch_add(p, v, __ATOMIC_RELAXED, __HIP_MEMORY_SCOPE_AGENT); }
__device__ __forceinline__ unsigned xb_xcc_id() { return (unsigned)__builtin_amdgcn_s_getreg((3 << 11) | 20) & 0xFu; }
#define XB_SPIN(cond, bar) do { unsigned _sp = 0; while (cond) { __builtin_amdgcn_s_sleep(1); \
    if ((++_sp & 255u) == 0u) { if (xb_ld(&(bar)[XB_TMO])) break; if (_sp > XB_SPIN_CAP) { atomicAdd(&(bar)[XB_TMO], 1u); break; } } } } while (0)

struct XcdBarrier {
    unsigned* bar; unsigned x;
    volatile LAS unsigned* st;
};

__device__ __forceinline__ XcdBarrier xcd_barrier_post(unsigned* bar, volatile LAS unsigned* st) {
    XcdBarrier b; b.bar = bar; b.x = xb_xcc_id(); b.st = st;
    if (threadIdx.x == 0) (void)xb_add(&bar[XB_XCNT(b.x)], 1u);
    return b;
}
__device__ __forceinline__ void xcd_barrier_complete(unsigned* bar, unsigned x, unsigned& nloc, unsigned& nx) {
    const unsigned G = gridDim.x * gridDim.y * gridDim.z;
    unsigned sum, cnt, mine, sp = 0u;
    for (;;) {
        sum = 0u; cnt = 0u; mine = 0u;
#pragma unroll
        for (unsigned j = 0; j < 16; ++j) { const unsigned c = xb_ld(&bar[XB_XCNT(j)]); sum += c; cnt += (c > 0u) ? 1u : 0u; mine = (j == x) ? c : mine; }
        if (sum == G) break;
        __builtin_amdgcn_s_sleep(1);
        if ((++sp & 255u) == 0u) { if (xb_ld(&bar[XB_TMO])) break; if (sp > XB_SPIN_CAP) { atomicAdd(&bar[XB_TMO], 1u); break; } }
    }
    nloc = mine > 0u ? mine : 1u; nx = cnt > 0u ? cnt : 1u;
}

__device__ __forceinline__ void xcd_barrier(const XcdBarrier& b) {
    asm volatile("s_waitcnt vmcnt(0)" ::: "memory");
    __syncthreads();
    if (threadIdx.x == 0) {
        unsigned* bar = b.bar;
        __builtin_amdgcn_s_waitcnt(0);
        unsigned nloc = b.st[0], nx = b.st[1];
        if (nloc == 0u) { xcd_barrier_complete(bar, b.x, nloc, nx); b.st[0] = nloc; b.st[1] = nx; }
        const unsigned old = xb_add(&bar[XB_XSUB(b.x)], 1u);
        const unsigned gen = old / nloc;
        if (old + 1u == (gen + 1u) * nloc) {
            __builtin_amdgcn_fence(__ATOMIC_RELEASE, "agent");
            asm volatile("s_waitcnt vmcnt(0)" ::: "memory");
            const unsigned og = xb_add(&bar[XB_TOP], 1u);
            const unsigned tg = og / nx;
            if (og + 1u == (tg + 1u) * nx) xb_add(&bar[XB_TOPGEN], 1u);
            else XB_SPIN(xb_ld(&bar[XB_TOPGEN]) == tg, bar);
            __builtin_amdgcn_fence(__ATOMIC_ACQUIRE, "agent");
            xb_add(&bar[XB_XGEN(b.x)], 1u);
            asm volatile("s_waitcnt vmcnt(0)" ::: "memory");
        } else {
            XB_SPIN(xb_ld(&bar[XB_XGEN(b.x)]) == gen, bar);
            __builtin_amdgcn_fence(__ATOMIC_ACQUIRE, "agent");
            asm volatile("s_waitcnt vmcnt(0)" ::: "memory");
        }
    }
    __syncthreads();
}


__global__ void __launch_bounds__(NTHREADS, 2) fwd_megakernel(Params p) {
    extern __shared__ __attribute__((aligned(16))) unsigned char smem[];
    cg::grid_group grid = cg::this_grid();
    volatile LAS unsigned* xst = (volatile LAS unsigned*)(LAS unsigned char*)(smem + LDS_BYTES - 8);
    if (p.ws == nullptr) grid.sync();
    if (threadIdx.x == 0) { xst[0] = 0u; xst[1] = 0u; }
    __syncthreads();
    const XcdBarrier xb = xcd_barrier_post((unsigned*)(p.ws + WS_BAR), xst);
    run_step<0>(p, smem); xcd_barrier(xb);
    run_step<1>(p, smem); xcd_barrier(xb);  run_step<2>(p, smem); xcd_barrier(xb);  run_step<3>(p, smem); xcd_barrier(xb);
    run_step<4>(p, smem); xcd_barrier(xb);  run_step<5>(p, smem); xcd_barrier(xb);  run_step<6>(p, smem); xcd_barrier(xb);  run_step<7>(p, smem); xcd_barrier(xb);
    run_step<8>(p, smem); xcd_barrier(xb);  run_step<9>(p, smem); xcd_barrier(xb);  run_step<10>(p, smem); xcd_barrier(xb); run_step<11>(p, smem); xcd_barrier(xb);
    run_step<12>(p, smem); xcd_barrier(xb); run_step<13>(p, smem); xcd_barrier(xb); run_step<14>(p, smem); xcd_barrier(xb); run_step<15>(p, smem); xcd_barrier(xb);
    run_step<16>(p, smem); xcd_barrier(xb); run_step<17>(p, smem); xcd_barrier(xb); run_step<18>(p, smem);
}

extern "C" void kernel_launch(void* const* d_in, const int* in_sizes, int n_in, void* d_out, int out_size, void* d_ws, size_t ws_size, hipStream_t stream) {
    static int grid_blocks = 0;
    if (grid_blocks == 0) {
        if (n_in != 26 || ws_size < WS_END) { fprintf(stderr, "kernel_launch: unexpected problem (n_in %d, ws %zu < %zu)\n", n_in, ws_size, (size_t)WS_END); grid_blocks = -1; return; }
        int dev = 0, cus = 0, per_cu = 0;
        (void)hipGetDevice(&dev);
        (void)hipDeviceGetAttribute(&cus, hipDeviceAttributeMultiprocessorCount, dev);
        if (hipFuncSetAttribute((const void*)fwd_megakernel, hipFuncAttributeMaxDynamicSharedMemorySize, LDS_BYTES) != hipSuccess) { fprintf(stderr, "hipFuncSetAttribute failed\n"); grid_blocks = -1; return; }
        if (hipOccupancyMaxActiveBlocksPerMultiprocessor(&per_cu, (const void*)fwd_megakernel, NTHREADS, LDS_BYTES) != hipSuccess || per_cu < 1) { fprintf(stderr, "occupancy query failed (%d)\n", per_cu); (void)hipGetLastError(); per_cu = 1; }
        if (per_cu > 1) per_cu = 1;
        grid_blocks = cus * per_cu;
    }
    if (grid_blocks < 0) return;
    Params p{};
    for (int i = 0; i < 26; ++i) p.in[i] = (const float*)d_in[i];
    p.out = (float*)d_out; p.ws = (unsigned char*)d_ws;
    void* args[] = {&p};
    if (hipMemsetAsync((char*)d_ws + WS_CTL, 0, 16384, stream) != hipSuccess) { fprintf(stderr, "kernel_launch: hipMemsetAsync of the control words failed\n"); return; }
    hipError_t e = hipLaunchCooperativeKernel((const void*)fwd_megakernel, dim3(grid_blocks), dim3(NTHREADS), args, LDS_BYTES, stream);
    if (e != hipSuccess) fprintf(stderr, "cooperative launch failed: %s (grid %d)\n", hipGetErrorString(e), grid_blocks);
}
```

```cpp
#include <hip/hip_runtime.h>
#include <hip/hip_cooperative_groups.h>
#include <cstdio>
#include <cstdint>
namespace cg = cooperative_groups;

#define LAS __attribute__((address_space(3)))
typedef unsigned short bf16_t;
typedef short bf16x8 __attribute__((ext_vector_type(8)));
typedef short bf16x4 __attribute__((ext_vector_type(4)));
typedef float f32x4 __attribute__((ext_vector_type(4)));
typedef unsigned u32x4 __attribute__((ext_vector_type(4)));
typedef unsigned u32x2 __attribute__((ext_vector_type(2)));

constexpr int D = 1024, TP = 32768, TSM = 1024, T = TP + TSM, SEQ = 2048;
constexpr int NPROJ = 4608, NPN = 4096, NMIX = 1536, NFF2 = 5632, NFF = 2816, INW = 4104;
constexpr float EPS = 1e-6f;
constexpr int C_BK = 1536, C_BV = 2048, C_CX = 2560, C_AZ = 3072, C_BQ = 3584, C_PO = 4096;
constexpr size_t O_YP = 0, O_YS = 33554432, O_PSD = 34603008, O_SSD = 36700160, O_PQC = 38797312, O_SQC = 38944768, O_PK = 39092224, O_SK = 72646656,
                 O_PV = 73695232, O_SV = 107249664, O_PPOOL = 108298240, O_SPOOL = 108544000, O_PFFN = 108789760, O_SFFN = 109150208;
constexpr size_t WS_CTL = 0, WS_BAR = 1024, WS_GB = 16384,
                 WS_WIN = WS_GB + (size_t)T * 8 * 4, WS_WOUT = WS_WIN + 2ull * 4096 * 1024 * 2, WS_WUP = WS_WOUT + 2ull * 1024 * 1536 * 2,
                 WS_WDN = WS_WUP + 2ull * 5632 * 1024 * 2, WS_CW = WS_WDN + 2ull * 1024 * 2816 * 2, WS_H = WS_CW + 2ull * 4 * 128 * 128 * 2,
                 WS_R2 = WS_H + (size_t)T * 1024 * 2, WS_QK = WS_R2 + (size_t)T * NPROJ * 2, WS_SIDE = WS_R2 + (size_t)T * NFF2 * 2, WS_DD = WS_SIDE,
                 WS_END = WS_SIDE + 1056ull * 2 * NFF2 * 2;
constexpr int LDS_BYTES = 155648;
constexpr int NTHREADS = 512;

struct Params { const float* in[26]; float* out; unsigned char* ws; };

__device__ __forceinline__ bf16_t f2bf(float f) { unsigned u = __float_as_uint(f); u += 0x7FFFu + ((u >> 16) & 1u); return (bf16_t)(u >> 16); }
__device__ __forceinline__ float bf2f(bf16_t b) { return __uint_as_float(((unsigned)b) << 16); }
typedef __bf16 bf16v2_t __attribute__((ext_vector_type(2)));
typedef float f32v2_t __attribute__((ext_vector_type(2)));
__device__ __forceinline__ unsigned pk2(float lo, float hi) { const f32v2_t f = {lo, hi}; const bf16v2_t r = __builtin_convertvector(f, bf16v2_t); return __builtin_bit_cast(unsigned, r); }
__device__ __forceinline__ float bflo(unsigned u) { return __uint_as_float(u << 16); }
__device__ __forceinline__ float bfhi(unsigned u) { return __uint_as_float(u & 0xFFFF0000u); }
__device__ __forceinline__ float siluf(float y) { return y * __builtin_amdgcn_rcpf(1.f + __expf(-y)); }
__device__ __forceinline__ int opaque_tid() { int t = threadIdx.x; asm volatile("" : "+v"(t)); return t; }
template <int CTRL> __device__ __forceinline__ float dpp_mov(float v) { return __builtin_bit_cast(float, __builtin_amdgcn_update_dpp(0, __builtin_bit_cast(int, v), CTRL, 0xF, 0xF, true)); }
__device__ __forceinline__ float row_sum16(float v) { v += dpp_mov<0xB1>(v); v += dpp_mov<0x4E>(v); v += dpp_mov<0x141>(v); v += dpp_mov<0x140>(v); return v; }
__device__ __forceinline__ float wave_sum64(float v) { v = row_sum16(v);
    return (__builtin_amdgcn_readlane(__builtin_bit_cast(int, v), 0) , __builtin_bit_cast(float, __builtin_amdgcn_readlane(__builtin_bit_cast(int, v), 0)) + __builtin_bit_cast(float, __builtin_amdgcn_readlane(__builtin_bit_cast(int, v), 16))
         + __builtin_bit_cast(float, __builtin_amdgcn_readlane(__builtin_bit_cast(int, v), 32)) + __builtin_bit_cast(float, __builtin_amdgcn_readlane(__builtin_bit_cast(int, v), 48))); }
#define MFMA16(a, b, c) __builtin_amdgcn_mfma_f32_16x16x32_bf16(a, b, c, 0, 0, 0)
__device__ __forceinline__ void unpack8(const u32x4 v, float* f) {
    f[0] = bflo(v.x); f[1] = bfhi(v.x); f[2] = bflo(v.y); f[3] = bfhi(v.y); f[4] = bflo(v.z); f[5] = bfhi(v.z); f[6] = bflo(v.w); f[7] = bfhi(v.w);
}

namespace pg8 {
constexpr int BM = 256, BK = 64, HALF = 128, HTB = HALF * BK * 2, STAGE_BYTES = 8 * HTB, NXCD = 8, WGM = 8;
__host__ __device__ __forceinline__ int lds_byte(int r, int c) { const int st = (r >> 4) * 2 + (c >> 5), rr = r & 15, cc = c & 31, ob = rr * 64 + cc * 2; return st * 1024 + (ob ^ (((ob >> 9) & 1) << 5)); }
__host__ __device__ __forceinline__ void stage_rc(int b, int& R, int& C) { const int st = b / 1024, sb = b % 1024, swz = sb ^ (((sb >> 9) & 1) << 5); R = (st >> 1) * 16 + swz / 64; C = (st & 1) * 32 + (swz % 64) / 2; }
__host__ __device__ __forceinline__ int perm32(int rho) { const int n = rho >> 4, i = rho & 15; return 8 * (i >> 2) + 4 * n + (i & 3); }
struct Unit { int pm, pn, k0, nt; };
struct Gemm { const bf16_t* A; const bf16_t* Bt; int M, N, K, lda; };
struct StaticOrder {
    int nM, nN, nwg, G, c, ntk, nslice, ntot;
    __device__ void init(int M, int N, int K, int G_, int c_, int split_rows) {
        nN = N / BM; G = G_; c = c_; ntk = K / BK;
        if (split_rows > 0) { nM = (M - split_rows) / BM; nslice = K / 256; nwg = nM * nN; ntot = nwg + (split_rows / BM) * nN * nslice; }
        else { nM = M / BM; nslice = 0; nwg = nM * nN; ntot = nwg; }
    }
    __device__ bool next(int i, Unit& u) const {
        const long L = (long)i * G + c; if (L >= ntot) return false;
        if (L >= nwg) { const int idx = (int)L - nwg, tile = idx / nslice, sl = idx - tile * nslice; u.pm = nM + tile / nN; u.pn = tile % nN; u.k0 = sl * 256; u.nt = 4; return true; }
        int wgid = (int)L; { const int q = nwg / NXCD, r = nwg % NXCD, xcd = wgid % NXCD, off = wgid / NXCD; wgid = (xcd < r ? xcd * (q + 1) : r * (q + 1) + (xcd - r) * q) + off; }
        const int nig = WGM * nN, gid = wgid / nig, fm = gid * WGM, gsz = (nM - fm) < WGM ? (nM - fm) : WGM;
        u.pm = fm + ((wgid % nig) % gsz); u.pn = (wgid % nig) / gsz; u.k0 = 0; u.nt = ntk; return true;
    }
};
__device__ __forceinline__ unsigned cvt_pk_bf16(float lo, float hi) { unsigned r; asm volatile("v_cvt_pk_bf16_f32 %0, %1, %2" : "=v"(r) : "v"(lo), "v"(hi)); return r; }

struct EpiAny;
__device__ __forceinline__ void run_epi(const EpiAny& E, const f32x4 (&acc)[2][2][4][2], const Unit& u, int wr, int wc, int fr, int fq);
__device__ __forceinline__ void gemm_phase(LAS unsigned char* lds, const Gemm g, const StaticOrder& S, const EpiAny& E, const bool perm) {
    const int tid = opaque_tid(), wid = __builtin_amdgcn_readfirstlane(tid >> 6), lane = tid & 63, wr = wid >> 2, wc = wid & 3, fr = lane & 15, fq = lane >> 4;
    const int K = g.K, lda = g.lda;
    unsigned voffA[2], voffB[2];
#pragma unroll
    for (int i = 0; i < 2; ++i) { int R, C; stage_rc(tid * 16 + i * 8192, R, C); const int Rb = perm ? ((R & ~31) + perm32(R & 31)) : R;
        voffA[i] = (unsigned)(R * lda + C) * 2u; voffB[i] = (unsigned)(Rb * K + C) * 2u; }
    const size_t kstep = (size_t)(BK * 2);
    const size_t hstepA = (size_t)HALF * lda * 2, hstepB = (size_t)HALF * K * 2;
    const size_t tstepA = 2 * hstepA, tstepB = 2 * hstepB;
    const unsigned ldsw = (unsigned)wid * 1024u;
    const int aoff = lds_byte(wr * 64 + fr, fq * 8), boff = lds_byte(wc * 32 + fr, fq * 8);
#define PG8_SA(b, h) (((b) * 2 + (h)) * HTB)
#define PG8_SB(b, h) ((4 + (b) * 2 + (h)) * HTB)
#define PG8_STAGE(bufoff, gbase, voff) do { _Pragma("unroll") for (int _i = 0; _i < 2; ++_i) \
        __builtin_amdgcn_global_load_lds((const unsigned*)((const char*)(gbase) + (voff)[_i]), (LAS unsigned*)(lds + (bufoff) + ldsw + _i * 8192), 16, 0, 0); } while (0)
#define PG8_LDA(dst, b, h) do { _Pragma("unroll") for (int m = 0; m < 4; ++m) _Pragma("unroll") for (int k = 0; k < 2; ++k) dst[m][k] = *(const LAS bf16x8*)(lds + PG8_SA(b, h) + aoff + m * 2048 + k * 1024); } while (0)
#define PG8_LDB(dst, b, h) do { _Pragma("unroll") for (int n = 0; n < 2; ++n) _Pragma("unroll") for (int k = 0; k < 2; ++k) dst[n][k] = *(const LAS bf16x8*)(lds + PG8_SB(b, h) + boff + n * 2048 + k * 1024); } while (0)
#define PG8_MMA(ai, bj, At, Bt) do { __builtin_amdgcn_s_setprio(1); _Pragma("unroll") for (int m = 0; m < 4; ++m) _Pragma("unroll") for (int n = 0; n < 2; ++n) _Pragma("unroll") for (int k = 0; k < 2; ++k) \
        acc[ai][bj][m][n] = __builtin_amdgcn_mfma_f32_16x16x32_bf16(Bt[n][k], At[m][k], acc[ai][bj][m][n], 0, 0, 0); __builtin_amdgcn_s_setprio(0); } while (0)
#define PG8_WAIT_V(n) asm volatile("s_waitcnt vmcnt(" #n ")" ::: "memory")
#define PG8_WAIT_L(n) asm volatile("s_waitcnt lgkmcnt(" #n ")" ::: "memory")
#define PG8_BAR __builtin_amdgcn_s_barrier()
#define PG8_SCHED __builtin_amdgcn_sched_barrier(0)
    Unit cur, nxt; int ui = 0;
    if (!S.next(0, cur)) return;
    f32x4 acc[2][2][4][2];
#pragma unroll
    for (int a = 0; a < 2; ++a)
#pragma unroll
        for (int b = 0; b < 2; ++b)
#pragma unroll
            for (int m = 0; m < 4; ++m)
#pragma unroll
                for (int n = 0; n < 2; ++n) acc[a][b][m][n] = (f32x4){0.f, 0.f, 0.f, 0.f};
    bf16x8 At[4][2], B0[2][2], B1[2][2];
    const char* cA = (const char*)g.A + (size_t)cur.pm * tstepA + (size_t)cur.k0 * 2; const char* cB = (const char*)g.Bt + (size_t)cur.pn * tstepB + (size_t)cur.k0 * 2;
    int nt = cur.nt;
    PG8_STAGE(PG8_SB(0, 0), cB, voffB); PG8_STAGE(PG8_SA(0, 0), cA, voffA); PG8_STAGE(PG8_SB(0, 1), cB + hstepB, voffB); PG8_STAGE(PG8_SA(0, 1), cA + hstepA, voffA);
    if (wr == 1) PG8_BAR;
    PG8_WAIT_V(4); PG8_BAR;
    PG8_STAGE(PG8_SB(1, 0), cB + kstep, voffB); PG8_STAGE(PG8_SA(1, 0), cA + kstep, voffA); PG8_STAGE(PG8_SB(1, 1), cB + hstepB + kstep, voffB);
    PG8_WAIT_V(6); PG8_BAR;
    for (;;) {
        const bool has_next = S.next(ui + 1, nxt);
        const char* nA = has_next ? (const char*)g.A + (size_t)nxt.pm * tstepA + (size_t)nxt.k0 * 2 : cA; const char* nB = has_next ? (const char*)g.Bt + (size_t)nxt.pn * tstepB + (size_t)nxt.k0 * 2 : cB;
        for (int t = 0; t < nt; t += 2) {
            const bool last = (t == nt - 2);
            const char* a1 = cA + (size_t)(t + 1) * kstep;
            const char* a2 = last ? nA : cA + (size_t)(t + 2) * kstep; const char* b2 = last ? nB : cB + (size_t)(t + 2) * kstep;
            const char* a3 = a2 + kstep; const char* b3 = b2 + kstep;
            PG8_LDB(B0, 0, 0); PG8_SCHED; PG8_LDA(At, 0, 0); PG8_STAGE(PG8_SA(1, 1), a1 + hstepA, voffA);
            PG8_WAIT_L(8); PG8_BAR; PG8_WAIT_L(0); PG8_MMA(0, 0, At, B0); PG8_BAR; PG8_SCHED;
            PG8_LDB(B1, 0, 1); PG8_STAGE(PG8_SB(0, 0), b2, voffB);
            PG8_BAR; PG8_WAIT_L(0); PG8_MMA(0, 1, At, B1); PG8_BAR;
            PG8_LDA(At, 0, 1); PG8_STAGE(PG8_SA(0, 0), a2, voffA);
            PG8_BAR; PG8_WAIT_L(0); PG8_MMA(1, 0, At, B0); PG8_BAR; PG8_SCHED;
            PG8_STAGE(PG8_SB(0, 1), b2 + hstepB, voffB);
            PG8_WAIT_V(6); PG8_BAR; PG8_MMA(1, 1, At, B1); PG8_BAR;
            PG8_LDB(B0, 1, 0); PG8_SCHED; PG8_LDA(At, 1, 0); PG8_STAGE(PG8_SA(0, 1), a2 + hstepA, voffA);
            PG8_WAIT_L(8); PG8_BAR; PG8_WAIT_L(0); PG8_MMA(0, 0, At, B0); PG8_BAR; PG8_SCHED;
            PG8_LDB(B1, 1, 1); PG8_STAGE(PG8_SB(1, 0), b3, voffB);
            PG8_BAR; PG8_WAIT_L(0); PG8_MMA(0, 1, At, B1); PG8_BAR;
            PG8_LDA(At, 1, 1); PG8_STAGE(PG8_SA(1, 0), a3, voffA);
            PG8_BAR; PG8_WAIT_L(0); PG8_MMA(1, 0, At, B0); PG8_BAR; PG8_SCHED;
            PG8_STAGE(PG8_SB(1, 1), b3 + hstepB, voffB);
            PG8_WAIT_V(6); PG8_BAR; PG8_MMA(1, 1, At, B1); PG8_BAR;
        }
        run_epi(E, acc, cur, wr, wc, fr, fq);
        if (!has_next) break;
#pragma unroll
        for (int a = 0; a < 2; ++a)
#pragma unroll
            for (int b = 0; b < 2; ++b)
#pragma unroll
                for (int m = 0; m < 4; ++m)
#pragma unroll
                    for (int n = 0; n < 2; ++n) acc[a][b][m][n] = (f32x4){0.f, 0.f, 0.f, 0.f};
        cur = nxt; cA = nA; cB = nB; nt = cur.nt; ++ui;
    }
    PG8_WAIT_V(0);
    if (wr == 0) PG8_BAR;
    PG8_BAR;
#undef PG8_SA
#undef PG8_SB
#undef PG8_STAGE
#undef PG8_LDA
#undef PG8_LDB
#undef PG8_MMA
#undef PG8_WAIT_V
#undef PG8_WAIT_L
#undef PG8_BAR
#undef PG8_SCHED
}

struct EpiAny {
    int mode; int l; void* p0; void* p1; float* out; int aux;
    __device__ __forceinline__ void operator()(const f32x4 (&acc)[2][2][4][2], const Unit& u, int wr, int wc, int fr, int fq) const {
        const int row0 = u.pm * BM + wr * 64 + fr;
        if (mode == 1) {
            const int col0 = u.pn * BM + wc * 32 + 4 * fq;
            const float* res = (const float*)p0;
#pragma unroll
            for (int ai = 0; ai < 2; ++ai)
#pragma unroll
                for (int m = 0; m < 4; ++m) {
                    const size_t ro = (size_t)(row0 + ai * HALF + m * 16) * D + col0;
#pragma unroll
                    for (int bj = 0; bj < 2; ++bj)
#pragma unroll
                        for (int n = 0; n < 2; ++n) {
                            float* o = out + ro + bj * HALF + n * 16;
                            if (u.nt == 4) {
                                const int rs = row0 + ai * HALF + m * 16 - TP, cs = col0 + bj * HALF + n * 16;
                                *(f32x4*)((char*)p1 + (size_t)((u.k0 >> 8) * TSM + rs) * (size_t)aux + (size_t)cs * 4) = acc[ai][bj][m][n];
                            } else { const f32x4 r = *(const f32x4*)(res + ro + bj * HALF + n * 16); *(f32x4*)o = acc[ai][bj][m][n] + r; }
                        }
                    __builtin_amdgcn_sched_barrier(0);
                }
        } else if (mode == 0) {
            bf16_t* proj = (bf16_t*)p0;
#pragma unroll
            for (int bj = 0; bj < 2; ++bj) {
                const int cb = u.pn * BM + bj * HALF;
                const int col0 = cb + wc * 32 + 8 * fq;
                const bool iskv = (cb >= C_BK) && (cb < C_CX);
                const bool isv = cb >= C_BV;
                float* kvdst = nullptr;
                if (iskv) { const bool pr = u.pm * BM < TP; const size_t off = pr ? ((isv ? O_PV : O_PK) + (size_t)l * 16777216 + (size_t)row0 * 512) : ((isv ? O_SV : O_SK) + (size_t)l * 524288 + (size_t)(row0 - TP) * 512); kvdst = out + off; }
                const int cc = col0 - (isv ? C_BV : C_BK);
#pragma unroll
                for (int ai = 0; ai < 2; ++ai)
#pragma unroll
                    for (int m = 0; m < 4; ++m) {
                        const int ro = ai * HALF + m * 16;
                        const f32x4 v0 = acc[ai][bj][m][0], v1 = acc[ai][bj][m][1];
                        u32x4 o; o.x = cvt_pk_bf16(v0[0], v0[1]); o.y = cvt_pk_bf16(v0[2], v0[3]); o.z = cvt_pk_bf16(v1[0], v1[1]); o.w = cvt_pk_bf16(v1[2], v1[3]);
                        *(u32x4*)(proj + (size_t)(row0 + ro) * NPROJ + col0) = o;
                        if (iskv) { float* dst = kvdst + (size_t)ro * 512 + cc; *(f32x4*)dst = v0; *(f32x4*)(dst + 4) = v1; }
                    }
            }
        } else {
            bf16_t* ub = (bf16_t*)p0; bf16_t* side = (bf16_t*)p1;
#pragma unroll
            for (int bj = 0; bj < 2; ++bj) {
                const int col0 = u.pn * BM + bj * HALF + wc * 32 + 8 * fq;
#pragma unroll
                for (int ai = 0; ai < 2; ++ai)
#pragma unroll
                    for (int m = 0; m < 4; ++m) {
                        const int row = row0 + ai * HALF + m * 16;
                        const f32x4 v0 = acc[ai][bj][m][0], v1 = acc[ai][bj][m][1];
                        u32x4 o; o.x = cvt_pk_bf16(v0[0], v0[1]); o.y = cvt_pk_bf16(v0[2], v0[3]); o.z = cvt_pk_bf16(v1[0], v1[1]); o.w = cvt_pk_bf16(v1[2], v1[3]);
                        *(u32x4*)(ub + (size_t)row * NFF2 + col0) = o;
                        if ((m & 1) && fr >= 14) {
                            const int rr = fr - 14;
                            *(u32x4*)(side + ((size_t)(row >> 5) * 2 + rr) * NFF2 + col0) = o;
                            float* dst = nullptr;
                            if (row < TP) { if ((row & 2047) >= 2046) dst = out + O_PFFN + (size_t)l * 180224 + ((size_t)(row >> 11) * 2 + rr) * NFF2 + col0; }
                            else if (((row - TP) & 63) >= 62) dst = out + O_SFFN + (size_t)l * 180224 + ((size_t)((row - TP) >> 6) * 2 + rr) * NFF2 + col0;
                            if (dst) { *(f32x4*)dst = v0; *(f32x4*)(dst + 4) = v1; }
                        }
                    }
            }
        }
    }
};
__device__ __forceinline__ void run_epi(const EpiAny& E, const f32x4 (&acc)[2][2][4][2], const Unit& u, int wr, int wc, int fr, int fq) { E(acc, u, wr, wc, fr, fq); }
}

__device__ __forceinline__ void transpose_tile(const float* __restrict__ src, int ldsrc, bf16_t* __restrict__ dst, int lddst, int k0, int n0d, int n0s, float* tile, const int tid) {
#pragma unroll
    for (int i = 0; i < 8; ++i) { const int idx = tid + 512 * i, kk = idx >> 6, nn = idx & 63; tile[kk * 65 + nn] = src[(size_t)(k0 + kk) * ldsrc + n0s + nn]; }
    __syncthreads();
#pragma unroll
    for (int i = 0; i < 4; ++i) { const int idx = tid + 512 * i, nn = idx >> 5, kp = idx & 31;
        *(unsigned*)(dst + (size_t)(n0d + nn) * lddst + k0 + 2 * kp) = pk2(tile[(2 * kp) * 65 + nn], tile[(2 * kp + 1) * 65 + nn]); }
    __syncthreads();
}
__device__ __forceinline__ void phase_weights(const Params& p, unsigned char* smem) {
    float* tile = (float*)smem; const int tid = opaque_tid();
    constexpr int N_IN = 16 * 64, N_OUT = 24 * 16, N_UP = 16 * 88, N_DN = 44 * 16, N_CW = 16, PER_L = N_IN + N_OUT + N_UP + N_DN + N_CW;
    for (int it = blockIdx.x; it < 2 * PER_L; it += gridDim.x) {
        const int l = it / PER_L; int r = it % PER_L;
        if (r < N_IN) { const int kb = r / 64, nb = r % 64, n0 = nb * 64;
            transpose_tile(p.in[9] + (size_t)l * 1024 * INW, INW, (bf16_t*)(p.ws + WS_WIN) + (size_t)l * 4096 * 1024, 1024, kb * 64, n0, n0 < 1536 ? n0 : (n0 < 2048 ? n0 + 1032 : (n0 < 2560 ? n0 + 1032 : (n0 < 3072 ? n0 + 1032 : (n0 < 3584 ? n0 - 1536 : n0 - 1528)))), tile, tid); continue; }
        r -= N_IN;
        if (r < N_OUT) { const int kb = r / 16, nb = r % 16;
            transpose_tile(p.in[19] + (size_t)l * 1536 * 1024, 1024, (bf16_t*)(p.ws + WS_WOUT) + (size_t)l * 1024 * 1536, 1536, kb * 64, nb * 64, nb * 64, tile, tid); continue; }
        r -= N_OUT;
        if (r < N_UP) { const int kb = r / 88, nb = r % 88;
            transpose_tile(p.in[21] + (size_t)l * 1024 * NFF2, NFF2, (bf16_t*)(p.ws + WS_WUP) + (size_t)l * NFF2 * 1024, 1024, kb * 64, nb * 64, nb * 64, tile, tid); continue; }
        r -= N_UP;
        if (r < N_DN) { const int kb = r / 16, nb = r % 16;
            transpose_tile(p.in[24] + (size_t)l * NFF * 1024, 1024, (bf16_t*)(p.ws + WS_WDN) + (size_t)l * 1024 * NFF, NFF, kb * 64, nb * 64, nb * 64, tile, tid); continue; }
        r -= N_DN;
        { const int gi = r >> 2, kb = (r >> 1) & 1, nb = r & 1;
            transpose_tile(p.in[17] + ((size_t)l * 4 + gi) * 16384, 128, (bf16_t*)(p.ws + WS_CW) + ((size_t)l * 4 + gi) * 16384, 128, kb * 64, nb * 64, nb * 64, tile, tid); }
    }
}

__device__ __forceinline__ void phase_norm(const Params& p, unsigned char* smem, int l, int mode, const int nsl = 0, const unsigned char* pbase = nullptr, const int ppitch = 0) {
    const int tid = opaque_tid(), lane = tid & 63, wave = tid >> 6;
    float* wab = (float*)smem;
    const float* gw = mode == 0 ? p.in[8] + l * 1024 : (mode == 1 ? p.in[20] + l * 1024 : p.in[25]);
    if (mode == 0) {
        const float* w = p.in[9] + (size_t)l * 1024 * INW;
        for (int idx = tid; idx < 8192; idx += 512) wab[idx] = w[(size_t)(idx >> 3) * INW + 2048 + (idx & 7)];
        __syncthreads();
    }
    f32x4 gv[4];
#pragma unroll
    for (int j = 0; j < 4; ++j) gv[j] = *(const f32x4*)(gw + 4 * (lane + 64 * j));
    bf16_t* h = (bf16_t*)(p.ws + WS_H);
    float* gb = (float*)(p.ws + WS_GB);
    const bool from_in = (mode == 0 && l == 0);
    for (int row = blockIdx.x * 8 + wave; row < T; row += gridDim.x * 8) {
        const float* xr = from_in ? (row < TP ? p.in[0] + (size_t)row * D : p.in[1] + (size_t)(row - TP) * D) : p.out + (size_t)row * D;
        f32x4 v[4]; float ss = 0.f;
#pragma unroll
        for (int j = 0; j < 4; ++j) { v[j] = *(const f32x4*)(xr + 4 * (lane + 64 * j)); ss += v[j][0] * v[j][0] + v[j][1] * v[j][1] + v[j][2] * v[j][2] + v[j][3] * v[j][3]; }
        ss = wave_sum64(ss);
        if (row >= TP) {
            if (from_in) {
#pragma unroll
                for (int j = 0; j < 4; ++j) *(f32x4*)(p.out + (size_t)row * D + 4 * (lane + 64 * j)) = v[j];
            } else if (nsl > 0) {
                for (int sl = 0; sl < nsl; ++sl) {
                    const unsigned char* pr = pbase + (size_t)(sl * TSM + row - TP) * (size_t)ppitch;
#pragma unroll
                    for (int j = 0; j < 4; ++j) v[j] += *(const f32x4*)(pr + 16 * (lane + 64 * j));
                }
                ss = 0.f;
#pragma unroll
                for (int j = 0; j < 4; ++j) { ss += v[j][0] * v[j][0] + v[j][1] * v[j][1] + v[j][2] * v[j][2] + v[j][3] * v[j][3];
                    if (mode != 2) *(f32x4*)(p.out + (size_t)row * D + 4 * (lane + 64 * j)) = v[j]; }
                ss = wave_sum64(ss);
            }
        }
        const float rstd = rsqrtf(ss * (1.f / D) + EPS);
#pragma unroll
        for (int j = 0; j < 4; ++j) v[j] = v[j] * rstd * gv[j];
        if (mode == 2) {
#pragma unroll
            for (int j = 0; j < 4; ++j) *(f32x4*)(p.out + (size_t)row * D + 4 * (lane + 64 * j)) = v[j];
            continue;
        }
#pragma unroll
        for (int j = 0; j < 4; ++j) { u32x2 o; o.x = pk2(v[j][0], v[j][1]); o.y = pk2(v[j][2], v[j][3]); *(u32x2*)(h + (size_t)row * D + 4 * (lane + 64 * j)) = o; }
        if (mode == 0) {
            float d8[8];
#pragma unroll
            for (int c = 0; c < 8; ++c) d8[c] = 0.f;
#pragma unroll
            for (int j = 0; j < 4; ++j)
#pragma unroll
                for (int i = 0; i < 4; ++i) { const int k = 4 * (lane + 64 * j) + i; const f32x4 w0 = *(const f32x4*)(wab + k * 8), w1 = *(const f32x4*)(wab + k * 8 + 4); const float hv = v[j][i];
                    d8[0] += hv * w0[0]; d8[1] += hv * w0[1]; d8[2] += hv * w0[2]; d8[3] += hv * w0[3]; d8[4] += hv * w1[0]; d8[5] += hv * w1[1]; d8[6] += hv * w1[2]; d8[7] += hv * w1[3]; }
#pragma unroll
            for (int c = 0; c < 8; ++c) d8[c] = wave_sum64(d8[c]);
            if (lane < 8) {
                float val = 0.f;
#pragma unroll
                for (int c = 0; c < 8; ++c) val = (lane == c) ? d8[c] : val;
                float res;
                if (lane < 4) { const float xx = val + p.in[13][l * 4 + lane]; const float sp = xx > 20.f ? xx : log1pf(expf(xx)); res = -expf(p.in[12][l * 4 + lane]) * sp; }
                else res = 1.f / (1.f + expf(-val));
                gb[(size_t)row * 8 + lane] = res;
            }
        }
    }
}

constexpr int DP_QB = 0, DP_KB = 17408, DP_KTT = 34816, DP_VU = 53248, DP_LM = 86016, DP_QKD = 102400, DP_SM = 111616;
__device__ __forceinline__ void delta_prep(const Params& p, unsigned char* smem, int l, int pi) {
    const int tid = opaque_tid(), lane = tid & 63, w = tid >> 6, fr = lane & 15, fq = lane >> 4;
    const bool prompt = pi < 2048;
    const int sid = prompt ? (pi >> 5) : (pi - 2048), n = prompt ? (pi & 31) : 0;
    const int b = sid >> 2, hh = sid & 3;
    const int rowbase = prompt ? b * SEQ : TP + b * 64, L = prompt ? SEQ : 64, t0 = n * 64;
    const bf16_t* proj = (const bf16_t*)(p.ws + WS_R2);
    const float* gb = (const float*)(p.ws + WS_GB);
    bf16_t* QB = (bf16_t*)(smem + DP_QB); bf16_t* KB = (bf16_t*)(smem + DP_KB); bf16_t* KTT = (bf16_t*)(smem + DP_KTT);
    float* VU = (float*)(smem + DP_VU); float* LM = (float*)(smem + DP_LM); bf16_t* QKD = (bf16_t*)(smem + DP_QKD);
    float* sG = (float*)(smem + DP_SM); float* sgam = sG + 64; float* sbeta = sG + 128; float* stail = sG + 192; float* sbg = sG + 256;
    const float* convw = p.in[10] + l * 6144; const float* convb = p.in[11] + l * 1536;
    const float* cbuf = p.in[3] + ((size_t)l * 16 + b) * 3 * 1536;
    u32x4 raw[6][4];
#pragma unroll
    for (int zp = 0; zp < 6; ++zp) {
        const int z = zp >> 1, item = tid + 512 * (zp & 1), row = item >> 4, seg = item & 15, cq = z * 512 + hh * 128 + seg * 8;
#pragma unroll
        for (int i = 0; i < 4; ++i) {
            const int tt = t0 + row - 3 + i;
            if (tt >= 0) raw[zp][i] = *(const u32x4*)(proj + (size_t)(rowbase + tt) * NPROJ + cq);
            else if (!prompt) { const f32x4 c0 = *(const f32x4*)(cbuf + (3 + tt) * 1536 + cq), c1 = *(const f32x4*)(cbuf + (3 + tt) * 1536 + cq + 4);
                raw[zp][i].x = pk2(c0[0], c0[1]); raw[zp][i].y = pk2(c0[2], c0[3]); raw[zp][i].z = pk2(c1[0], c1[1]); raw[zp][i].w = pk2(c1[2], c1[3]); }
            else raw[zp][i] = (u32x4){0u, 0u, 0u, 0u};
        }
    }
    if (tid < 64) {
        const float g = gb[(size_t)(rowbase + t0 + tid) * 8 + hh], be = gb[(size_t)(rowbase + t0 + tid) * 8 + 4 + hh];
        float G = g;
#pragma unroll
        for (int o = 1; o < 64; o <<= 1) { const float t = __shfl_up(G, o); if (lane >= o) G += t; }
        const float Gl = __shfl(G, 63);
        sG[tid] = G; sgam[tid] = __expf(G); sbeta[tid] = be; stail[tid] = __expf(Gl - G); sbg[tid] = be * __expf(G);
    }
    __syncthreads();
#pragma unroll
    for (int zp = 0; zp < 6; ++zp) {
        const int z = zp >> 1, item = tid + 512 * (zp & 1), row = item >> 4, seg = item & 15, cq = z * 512 + hh * 128 + seg * 8;
        float y[8];
        { const f32x4 b0 = *(const f32x4*)(convb + cq), b1 = *(const f32x4*)(convb + cq + 4); y[0] = b0[0]; y[1] = b0[1]; y[2] = b0[2]; y[3] = b0[3]; y[4] = b1[0]; y[5] = b1[1]; y[6] = b1[2]; y[7] = b1[3]; }
#pragma unroll
        for (int i = 0; i < 4; ++i) {
            float x[8]; unpack8(raw[zp][i], x);
            const f32x4 w0 = *(const f32x4*)(convw + i * 1536 + cq), w1 = *(const f32x4*)(convw + i * 1536 + cq + 4);
            y[0] += w0[0] * x[0]; y[1] += w0[1] * x[1]; y[2] += w0[2] * x[2]; y[3] += w0[3] * x[3]; y[4] += w1[0] * x[4]; y[5] += w1[1] * x[5]; y[6] += w1[2] * x[6]; y[7] += w1[3] * x[7];
        }
        float ss = 0.f;
#pragma unroll
        for (int e = 0; e < 8; ++e) { y[e] = siluf(y[e]); ss += y[e] * y[e]; }
        if (z < 2) {
            ss = row_sum16(ss);
            const float sc = rsqrtf(ss + EPS) * (z == 0 ? 0.08838834764831845f : 1.f);
#pragma unroll
            for (int e = 0; e < 8; ++e) y[e] *= sc;
            u32x4 o; o.x = pk2(y[0], y[1]); o.y = pk2(y[2], y[3]); o.z = pk2(y[4], y[5]); o.w = pk2(y[6], y[7]);
            *(u32x4*)((z == 0 ? QB : KB) + row * 136 + seg * 8) = o;
            if (z == 1) { const float tl = stail[row];
#pragma unroll
                for (int e = 0; e < 8; ++e) KTT[(seg * 8 + e) * 72 + row] = f2bf(y[e] * tl); }
        } else {
            const float be = sbeta[row];
            *(f32x4*)(VU + row * 128 + seg * 8) = (f32x4){y[0] * be, y[1] * be, y[2] * be, y[3] * be};
            *(f32x4*)(VU + row * 128 + seg * 8 + 4) = (f32x4){y[4] * be, y[5] * be, y[6] * be, y[7] * be};
        }
        __builtin_amdgcn_sched_barrier(0);
    }
    __syncthreads();
    {
        const int ct = w >> 1;
#pragma unroll
        for (int si = 0; si < 2; ++si) {
            const int st = 2 * (w & 1) + si;
            f32x4 akk = (f32x4){0.f, 0.f, 0.f, 0.f}, aqk = (f32x4){0.f, 0.f, 0.f, 0.f};
#pragma unroll
            for (int ks = 0; ks < 4; ++ks) {
                const bf16x8 xk = *(const bf16x8*)(KB + (16 * ct + fr) * 136 + 32 * ks + 8 * fq);
                const bf16x8 xq = *(const bf16x8*)(QB + (16 * ct + fr) * 136 + 32 * ks + 8 * fq);
                const bf16x8 yk = *(const bf16x8*)(KB + (16 * st + fr) * 136 + 32 * ks + 8 * fq);
                akk = MFMA16(xk, yk, akk); aqk = MFMA16(xq, yk, aqk);
            }
            const int s = 16 * st + fr; const float Gs = sG[s];
#pragma unroll
            for (int j = 0; j < 4; ++j) {
                const int c = 16 * ct + 4 * fq + j; const float dec = __expf(fminf(sG[c] - Gs, 0.f));
                LM[c * 64 + s] = (c > s) ? sbeta[c] * dec * akk[j] : 0.f;
                QKD[c * 72 + s] = f2bf((c >= s) ? dec * aqk[j] : 0.f);
            }
        }
    }
    __syncthreads();
    if (tid < 256) {
        float x[64];
        const bool isv = tid < 128; const int d = tid - 128;
        int vzero; asm volatile("v_mov_b32 %0, 0" : "=v"(vzero));
        const float* LMv = LM + vzero;
        if (isv) {
#pragma unroll
            for (int c = 0; c < 64; ++c) x[c] = VU[c * 128 + tid];
        } else {
#pragma unroll
            for (int c = 0; c < 64; ++c) x[c] = bf2f(KB[c * 136 + d]) * sbg[c];
        }
#pragma unroll
        for (int c = 1; c < 64; ++c) {
            float r0 = x[c], r1 = 0.f;
#pragma unroll
            for (int s4 = 0; s4 < (c + 3) / 4; ++s4) {
                const f32x4 lv = *(const f32x4*)(LMv + c * 64 + 4 * s4);
                r0 -= lv[0] * x[4 * s4]; r1 -= lv[1] * x[4 * s4 + 1]; r0 -= lv[2] * x[4 * s4 + 2]; r1 -= lv[3] * x[4 * s4 + 3];
            }
            x[c] = r0 + r1;
            if ((c & 3) == 3) __builtin_amdgcn_sched_barrier(0);
        }
        if (isv) {
#pragma unroll
            for (int c = 0; c < 64; ++c) VU[c * 128 + tid] = x[c];
        } else {
#pragma unroll
            for (int c = 0; c < 64; ++c) KB[c * 136 + d] = f2bf(x[c]);
        }
    }
    __syncthreads();
    {
        bf16_t* recWU = (bf16_t*)(p.ws + WS_H) + (size_t)pi * 16384;
        bf16_t* recQK = (bf16_t*)(p.ws + WS_QK) + (size_t)pi * 16384;
        unsigned char* recD = p.ws + WS_DD + (size_t)pi * 8448;
#pragma unroll
        for (int k = 0; k < 2; ++k) {
            const int idx = tid + 512 * k, row = idx >> 4, sg = idx & 15;
            *(u32x4*)(recWU + row * 128 + sg * 8) = *(const u32x4*)(KB + row * 136 + sg * 8);
            const f32x4 u0 = *(const f32x4*)(VU + row * 128 + sg * 8), u1 = *(const f32x4*)(VU + row * 128 + sg * 8 + 4);
            u32x4 o; o.x = pk2(u0[0], u0[1]); o.y = pk2(u0[2], u0[3]); o.z = pk2(u1[0], u1[1]); o.w = pk2(u1[2], u1[3]);
            *(u32x4*)(recWU + 8192 + row * 128 + sg * 8) = o;
            *(u32x4*)(recQK + row * 128 + sg * 8) = *(const u32x4*)(QB + row * 136 + sg * 8);
            const int r2 = idx >> 3, s8 = idx & 7;
            *(u32x4*)(recQK + 8192 + r2 * 64 + s8 * 8) = *(const u32x4*)(KTT + r2 * 72 + s8 * 8);
        }
        { const int r2 = tid >> 3, s8 = tid & 7; *(u32x4*)((bf16_t*)recD + r2 * 64 + s8 * 8) = *(const u32x4*)(QKD + r2 * 72 + s8 * 8); }
        if (tid < 64) ((float*)(recD + 8192))[tid] = sgam[tid];
        if (n == (prompt ? 31 : 0)) {
            float* co = p.out + (prompt ? O_PQC : O_SQC) + ((size_t)l * 16 + b) * 3 * 1536;
            for (int idx = tid; idx < 1152; idx += 512) { const int r = idx / 384, rem = idx % 384, z = rem >> 7, c = rem & 127;
                co[r * 1536 + z * 512 + hh * 128 + c] = bf2f(proj[(size_t)(rowbase + L - 3 + r) * NPROJ + z * 512 + hh * 128 + c]); }
        }
    }
}

constexpr int D2_QB = 0, D2_KB = 18432, D2_VU = 35840, D2_LM = 53248, D2_SM = 69632, D2_HALF = 70912;
__device__ __forceinline__ void delta_prep2(const Params& p, unsigned char* smem, int l, int piA, int piB) {
    const int tid = opaque_tid(), half = __builtin_amdgcn_readfirstlane(tid >> 8), t = tid & 255, lane = t & 63, wl = t >> 6, fr = lane & 15, fq = lane >> 4;
    const int pi = (half && piB >= 0) ? piB : piA;
    const bool prompt = pi < 2048;
    const int sid = prompt ? (pi >> 5) : (pi - 2048), n = prompt ? (pi & 31) : 0;
    const int b = sid >> 2, hh = sid & 3;
    const int rowbase = prompt ? b * SEQ : TP + b * 64, L = prompt ? SEQ : 64, t0 = n * 64;
    const bf16_t* proj = (const bf16_t*)(p.ws + WS_R2);
    const float* gb = (const float*)(p.ws + WS_GB);
    unsigned char* sb = smem + half * D2_HALF;
    bf16_t* QB = (bf16_t*)(sb + D2_QB); bf16_t* KTT = QB; bf16_t* KB = (bf16_t*)(sb + D2_KB); bf16_t* VUb = (bf16_t*)(sb + D2_VU); float* LM = (float*)(sb + D2_LM);
    float* sG = (float*)(sb + D2_SM); float* sgam = sG + 64; float* sbeta = sG + 128; float* stail = sG + 192; float* sbg = sG + 256;
    const float* convw = p.in[10] + l * 6144; const float* convb = p.in[11] + l * 1536;
    const float* cbuf = p.in[3] + ((size_t)l * 16 + b) * 3 * 1536;
    bf16_t* recWU = (bf16_t*)(p.ws + WS_H) + (size_t)pi * 16384;
    bf16_t* recQK = (bf16_t*)(p.ws + WS_QK) + (size_t)pi * 16384;
    unsigned char* recD = p.ws + WS_DD + (size_t)pi * 8448;
    if (t < 64) {
        const float g = gb[(size_t)(rowbase + t0 + t) * 8 + hh], be = gb[(size_t)(rowbase + t0 + t) * 8 + 4 + hh];
        float G = g;
#pragma unroll
        for (int o = 1; o < 64; o <<= 1) { const float tt = __shfl_up(G, o); if (lane >= o) G += tt; }
        const float Gl = __shfl(G, 63);
        sG[t] = G; sgam[t] = __expf(G); sbeta[t] = be; stail[t] = __expf(Gl - G); sbg[t] = be * __expf(G);
        ((float*)(recD + 8192))[t] = __expf(G);
    }
    __syncthreads();
    auto load_raw = [&](const int z, u32x4 (&raw)[4][4]) {
#pragma unroll
        for (int k = 0; k < 4; ++k) {
            const int item = t + 256 * k, row = item >> 4, seg = item & 15, cq = z * 512 + hh * 128 + seg * 8;
#pragma unroll
            for (int i = 0; i < 4; ++i) {
                const int tt = t0 + row - 3 + i;
                if (tt >= 0) raw[k][i] = *(const u32x4*)(proj + (size_t)(rowbase + tt) * NPROJ + cq);
                else if (!prompt) { const f32x4 c0 = *(const f32x4*)(cbuf + (3 + tt) * 1536 + cq), c1 = *(const f32x4*)(cbuf + (3 + tt) * 1536 + cq + 4);
                    raw[k][i].x = pk2(c0[0], c0[1]); raw[k][i].y = pk2(c0[2], c0[3]); raw[k][i].z = pk2(c1[0], c1[1]); raw[k][i].w = pk2(c1[2], c1[3]); }
                else raw[k][i] = (u32x4){0u, 0u, 0u, 0u};
            }
        }
    };
    auto conv_tensor = [&](const int z, const u32x4 (&raw)[4][4]) {
#pragma unroll
        for (int k = 0; k < 4; ++k) {
            const int item = t + 256 * k, row = item >> 4, seg = item & 15, cq = z * 512 + hh * 128 + seg * 8;
            float y[8];
            { const f32x4 b0 = *(const f32x4*)(convb + cq), b1 = *(const f32x4*)(convb + cq + 4); y[0] = b0[0]; y[1] = b0[1]; y[2] = b0[2]; y[3] = b0[3]; y[4] = b1[0]; y[5] = b1[1]; y[6] = b1[2]; y[7] = b1[3]; }
#pragma unroll
            for (int i = 0; i < 4; ++i) {
                float x[8]; unpack8(raw[k][i], x);
                const f32x4 w0 = *(const f32x4*)(convw + i * 1536 + cq), w1 = *(const f32x4*)(convw + i * 1536 + cq + 4);
                y[0] += w0[0] * x[0]; y[1] += w0[1] * x[1]; y[2] += w0[2] * x[2]; y[3] += w0[3] * x[3]; y[4] += w1[0] * x[4]; y[5] += w1[1] * x[5]; y[6] += w1[2] * x[6]; y[7] += w1[3] * x[7];
            }
            float ss = 0.f;
#pragma unroll
            for (int e = 0; e < 8; ++e) { y[e] = siluf(y[e]); ss += y[e] * y[e]; }
            if (z < 2) {
                ss = row_sum16(ss);
                const float sc = rsqrtf(ss + EPS) * (z == 0 ? 0.08838834764831845f : 1.f);
                u32x4 o; o.x = pk2(y[0] * sc, y[1] * sc); o.y = pk2(y[2] * sc, y[3] * sc); o.z = pk2(y[4] * sc, y[5] * sc); o.w = pk2(y[6] * sc, y[7] * sc);
                *(u32x4*)((z == 0 ? QB : KB) + row * 136 + seg * 8) = o;
            } else {
                const float be = sbeta[row];
                u32x4 o; o.x = pk2(y[0] * be, y[1] * be); o.y = pk2(y[2] * be, y[3] * be); o.z = pk2(y[4] * be, y[5] * be); o.w = pk2(y[6] * be, y[7] * be);
                *(u32x4*)(VUb + row * 136 + seg * 8) = o;
            }
        }
    };
    {
        u32x4 rawA[4][4], rawB[4][4];
        load_raw(0, rawA); load_raw(1, rawB);
        conv_tensor(0, rawA);
        load_raw(2, rawA);
        conv_tensor(1, rawB);
        conv_tensor(2, rawA);
    }
    __syncthreads();
    {
        const int ct = wl; bf16_t* qkd_g = (bf16_t*)recD;
#pragma unroll 1
        for (int st = 0; st < 4; ++st) {
            f32x4 akk = (f32x4){0.f, 0.f, 0.f, 0.f}, aqk = (f32x4){0.f, 0.f, 0.f, 0.f};
#pragma unroll
            for (int ks = 0; ks < 4; ++ks) {
                const bf16x8 xk = *(const bf16x8*)(KB + (16 * ct + fr) * 136 + 32 * ks + 8 * fq);
                const bf16x8 xq = *(const bf16x8*)(QB + (16 * ct + fr) * 136 + 32 * ks + 8 * fq);
                const bf16x8 yk = *(const bf16x8*)(KB + (16 * st + fr) * 136 + 32 * ks + 8 * fq);
                akk = MFMA16(xk, yk, akk); aqk = MFMA16(xq, yk, aqk);
            }
            const int s = 16 * st + fr; const float Gs = sG[s];
#pragma unroll
            for (int j = 0; j < 4; ++j) {
                const int c = 16 * ct + 4 * fq + j; const float dec = __expf(fminf(sG[c] - Gs, 0.f));
                LM[c * 64 + s] = (c > s) ? sbeta[c] * dec * akk[j] : 0.f;
                qkd_g[c * 64 + s] = f2bf((c >= s) ? dec * aqk[j] : 0.f);
            }
        }
    }
    __syncthreads();
#pragma unroll
    for (int k = 0; k < 4; ++k) { const int idx = t + 256 * k, row = idx >> 4, sg = idx & 15; *(u32x4*)(recQK + row * 128 + sg * 8) = *(const u32x4*)(QB + row * 136 + sg * 8); }
    __syncthreads();
#pragma unroll
    for (int k = 0; k < 4; ++k) {
        const int item = t + 256 * k, row = item >> 4, seg = item & 15;
        float x[8]; unpack8(*(const u32x4*)(KB + row * 136 + seg * 8), x);
        const float tl = stail[row];
#pragma unroll
        for (int e = 0; e < 8; ++e) KTT[(seg * 8 + e) * 72 + row] = f2bf(x[e] * tl);
    }
    __syncthreads();
    int vzero; asm volatile("v_mov_b32 %0, 0" : "=v"(vzero));
    if (vzero == 0) {
        float x[64];
        const bool isv = t < 128; const int d = t - 128;
        const float* LMv = LM + vzero;
        bf16_t* col = isv ? (VUb + t) : (KB + d);
#pragma unroll
        for (int c = 0; c < 64; ++c) x[c] = bf2f(col[c * 136]) * (isv ? 1.f : sbg[c]);
#pragma unroll
        for (int c = 1; c < 64; ++c) {
            float r0 = x[c], r1 = 0.f;
#pragma unroll
            for (int s4 = 0; s4 < (c + 3) / 4; ++s4) {
                const f32x4 lv = *(const f32x4*)(LMv + c * 64 + 4 * s4);
                r0 -= lv[0] * x[4 * s4]; r1 -= lv[1] * x[4 * s4 + 1]; r0 -= lv[2] * x[4 * s4 + 2]; r1 -= lv[3] * x[4 * s4 + 3];
            }
            x[c] = r0 + r1;
            if ((c & 3) == 3) __builtin_amdgcn_sched_barrier(0);
        }
#pragma unroll
        for (int c = 0; c < 64; ++c) col[c * 136] = f2bf(x[c]);
    }
    __syncthreads();
#pragma unroll
    for (int k = 0; k < 4; ++k) {
        const int idx = t + 256 * k, row = idx >> 4, sg = idx & 15;
        *(u32x4*)(recWU + row * 128 + sg * 8) = *(const u32x4*)(KB + row * 136 + sg * 8);
        *(u32x4*)(recWU + 8192 + row * 128 + sg * 8) = *(const u32x4*)(VUb + row * 136 + sg * 8);
        const int r2 = idx >> 3, s8 = idx & 7;
        *(u32x4*)(recQK + 8192 + r2 * 64 + s8 * 8) = *(const u32x4*)(KTT + r2 * 72 + s8 * 8);
    }
    if (n == (prompt ? 31 : 0)) {
        float* co = p.out + (prompt ? O_PQC : O_SQC) + ((size_t)l * 16 + b) * 3 * 1536;
        for (int idx = t; idx < 1152; idx += 256) { const int r = idx / 384, rem = idx % 384, z = rem >> 7, c = rem & 127;
            co[r * 1536 + z * 512 + hh * 128 + c] = bf2f(proj[(size_t)(rowbase + L - 3 + r) * NPROJ + z * 512 + hh * 128 + c]); }
    }
}

constexpr int SC_WB = 0, SC_UB = 17408, SC_QB = 34816, SC_KTT = 52224, SC_QKD = 70656, SC_DT = 79872, SC_STB = 98304, SC_SM = 133120;
__device__ __forceinline__ void delta_scan(const Params& p, unsigned char* smem, int l, int sid) {
    const int tid = opaque_tid(), lane = tid & 63, w = tid >> 6, fr = lane & 15, fq = lane >> 4;
    const bool prompt = sid < 64;
    const int s2 = prompt ? sid : sid - 64, b = s2 >> 2, hh = s2 & 3;
    const int rowbase = prompt ? b * SEQ : TP + b * 64, nch = prompt ? 32 : 1, pi0 = prompt ? s2 * 32 : 2048 + s2;
    bf16_t* proj = (bf16_t*)(p.ws + WS_R2);
    bf16_t* WB = (bf16_t*)(smem + SC_WB); bf16_t* UB = (bf16_t*)(smem + SC_UB); bf16_t* QB = (bf16_t*)(smem + SC_QB); bf16_t* KTT = (bf16_t*)(smem + SC_KTT);
    bf16_t* QKD = (bf16_t*)(smem + SC_QKD); bf16_t* DT = (bf16_t*)(smem + SC_DT) + w * 16 * 72; bf16_t* STB = (bf16_t*)(smem + SC_STB);
    float* sgam = (float*)(smem + SC_SM); float* osq = sgam + 64;
    f32x4 accS[8];
    if (prompt) {
#pragma unroll
        for (int dt = 0; dt < 8; ++dt) accS[dt] = (f32x4){0.f, 0.f, 0.f, 0.f};
    } else {
        const float* s0 = p.in[2] + (((size_t)l * 16 + b) * 4 + hh) * 16384;
#pragma unroll
        for (int dt = 0; dt < 8; ++dt)
#pragma unroll
            for (int j = 0; j < 4; ++j) accS[dt][j] = s0[(16 * dt + 4 * fq + j) * 128 + 16 * w + fr];
    }
#pragma unroll
    for (int dt = 0; dt < 8; ++dt) { u32x2 o; o.x = pk2(accS[dt][0], accS[dt][1]); o.y = pk2(accS[dt][2], accS[dt][3]); *(u32x2*)(STB + (16 * w + fr) * 136 + 16 * dt + 4 * fq) = o; }
    u32x4 pre[9]; float pgam = 0.f; u32x2 zr[4];
    auto load_chunk = [&](int n) {
        const size_t pi = (size_t)(pi0 + n);
        const u32x4* wu = (const u32x4*)((const bf16_t*)(p.ws + WS_H) + pi * 16384);
        const u32x4* qk = (const u32x4*)((const bf16_t*)(p.ws + WS_QK) + pi * 16384);
        const unsigned char* dd = p.ws + WS_DD + pi * 8448;
#pragma unroll
        for (int k = 0; k < 4; ++k) pre[k] = wu[tid + 512 * k];
#pragma unroll
        for (int k = 0; k < 4; ++k) pre[4 + k] = qk[tid + 512 * k];
        pre[8] = ((const u32x4*)dd)[tid];
        if (tid < 64) pgam = ((const float*)(dd + 8192))[tid];
#pragma unroll
        for (int ct = 0; ct < 4; ++ct) zr[ct] = *(const u32x2*)(proj + (size_t)(rowbase + n * 64 + 16 * ct + fr) * NPROJ + C_AZ + hh * 128 + 16 * w + 4 * fq);
    };
    load_chunk(0);
    const f32x4 an4 = *(const f32x4*)(p.in[14] + l * 128 + 16 * w + 4 * fq);
    for (int n = 0; n < nch; ++n) {
        const int t0 = n * 64;
#pragma unroll
        for (int k = 0; k < 2; ++k) {
            const int idx = tid + 512 * k, row = idx >> 4, sg = idx & 15;
            *(u32x4*)(WB + row * 136 + sg * 8) = pre[k];
            *(u32x4*)(UB + row * 136 + sg * 8) = pre[2 + k];
            *(u32x4*)(QB + row * 136 + sg * 8) = pre[4 + k];
            const int r2 = idx >> 3, s8 = idx & 7;
            *(u32x4*)(KTT + r2 * 72 + s8 * 8) = pre[6 + k];
        }
        { const int r2 = tid >> 3, s8 = tid & 7; *(u32x4*)(QKD + r2 * 72 + s8 * 8) = pre[8]; }
        if (tid < 64) sgam[tid] = pgam;
        u32x2 zc[4];
#pragma unroll
        for (int i = 0; i < 4; ++i) zc[i] = zr[i];
        __syncthreads();
        if (n + 1 < nch) load_chunk(n + 1);
        f32x4 oacc[4];
        {
            bf16x8 ysb[4];
#pragma unroll
            for (int ks = 0; ks < 4; ++ks) ysb[ks] = *(const bf16x8*)(STB + (16 * w + fr) * 136 + 32 * ks + 8 * fq);
#pragma unroll
            for (int ct = 0; ct < 4; ++ct) {
                f32x4 a = (f32x4){0.f, 0.f, 0.f, 0.f};
#pragma unroll
                for (int ks = 0; ks < 4; ++ks) a = MFMA16(*(const bf16x8*)(WB + (16 * ct + fr) * 136 + 32 * ks + 8 * fq), ysb[ks], a);
                float dl[4];
#pragma unroll
                for (int j = 0; j < 4; ++j) dl[j] = bf2f(UB[(16 * ct + 4 * fq + j) * 136 + 16 * w + fr]) - a[j];
                u32x2 o; o.x = pk2(dl[0], dl[1]); o.y = pk2(dl[2], dl[3]);
                *(u32x2*)(DT + fr * 72 + 16 * ct + 4 * fq) = o;
            }
            asm volatile("s_waitcnt lgkmcnt(0)" ::: "memory");
            bf16x8 ydt[2];
#pragma unroll
            for (int ks = 0; ks < 2; ++ks) ydt[ks] = *(const bf16x8*)(DT + fr * 72 + 32 * ks + 8 * fq);
#pragma unroll
            for (int ct = 0; ct < 4; ++ct) {
                f32x4 a1 = (f32x4){0.f, 0.f, 0.f, 0.f}, a2 = (f32x4){0.f, 0.f, 0.f, 0.f};
#pragma unroll
                for (int ks = 0; ks < 4; ++ks) a1 = MFMA16(ysb[ks], *(const bf16x8*)(QB + (16 * ct + fr) * 136 + 32 * ks + 8 * fq), a1);
#pragma unroll
                for (int ks = 0; ks < 2; ++ks) a2 = MFMA16(ydt[ks], *(const bf16x8*)(QKD + (16 * ct + fr) * 72 + 32 * ks + 8 * fq), a2);
                const float gm = sgam[16 * ct + fr];
                const f32x4 o = a1 * gm + a2;
                oacc[ct] = o;
                float sq = (o[0] * o[0] + o[1] * o[1]) + (o[2] * o[2] + o[3] * o[3]);
                sq += __shfl_xor(sq, 16); sq += __shfl_xor(sq, 32);
                if (fq == 0) osq[w * 64 + 16 * ct + fr] = sq;
            }
            const float gl = sgam[63];
#pragma unroll
            for (int dt = 0; dt < 8; ++dt) {
                f32x4 a = accS[dt] * gl;
#pragma unroll
                for (int ks = 0; ks < 2; ++ks) a = MFMA16(*(const bf16x8*)(KTT + (16 * dt + fr) * 72 + 32 * ks + 8 * fq), ydt[ks], a);
                accS[dt] = a;
                u32x2 o; o.x = pk2(a[0], a[1]); o.y = pk2(a[2], a[3]);
                *(u32x2*)(STB + (16 * w + fr) * 136 + 16 * dt + 4 * fq) = o;
            }
        }
        __syncthreads();
#pragma unroll
        for (int ct = 0; ct < 4; ++ct) {
            const int c = 16 * ct + fr;
            float tot = 0.f;
#pragma unroll
            for (int ww = 0; ww < 8; ++ww) tot += osq[ww * 64 + c];
            const float ri = rsqrtf(tot * (1.f / 128.f) + EPS);
            const float z0 = bflo(zc[ct].x), z1 = bfhi(zc[ct].x), z2 = bflo(zc[ct].y), z3 = bfhi(zc[ct].y);
            u32x2 ov; ov.x = pk2(oacc[ct][0] * ri * an4[0] * siluf(z0), oacc[ct][1] * ri * an4[1] * siluf(z1));
            ov.y = pk2(oacc[ct][2] * ri * an4[2] * siluf(z2), oacc[ct][3] * ri * an4[3] * siluf(z3));
            *(u32x2*)(proj + (size_t)(rowbase + t0 + c) * NPROJ + C_AZ + hh * 128 + 16 * w + 4 * fq) = ov;
        }
    }
    {
        float* so = p.out + (prompt ? O_PSD : O_SSD) + (((size_t)l * 16 + b) * 4 + hh) * 16384;
#pragma unroll
        for (int dt = 0; dt < 8; ++dt)
#pragma unroll
            for (int j = 0; j < 4; ++j) so[(16 * dt + 4 * fq + j) * 128 + 16 * w + fr] = accS[dt][j];
    }
    __syncthreads();
}

constexpr int AT_KS = 0, AT_VT = 34816, AT_OB = 71680;
__device__ __forceinline__ void attn_item(const Params& p, unsigned char* smem, int l, bool prompt, int b, int hh, int qc, float lam, float lam_init) {
    const int tid = opaque_tid(), lane = tid & 63, w = tid >> 6, fr = lane & 15, fq = lane >> 4, map = w >> 2, rb = w & 3;
    const bf16_t* proj = (const bf16_t*)(p.ws + WS_R2);
    bf16_t* mixed = (bf16_t*)(p.ws + WS_R2);
    const int row0 = prompt ? b * SEQ + qc * 64 : TP + b * 64;
    const int nt = prompt ? qc + 1 : 33;
    const float* ck = p.in[4] + ((size_t)l * 16 + b) * 2048 * 512 + hh * 128;
    const float* cv = p.in[5] + ((size_t)l * 16 + b) * 2048 * 512 + hh * 128;
    bf16_t* Ks = (bf16_t*)(smem + AT_KS); bf16_t* Vt = (bf16_t*)(smem + AT_VT); float* ob = (float*)(smem + AT_OB);
    bf16x8 qf[2];
#pragma unroll
    for (int ks = 0; ks < 2; ++ks) qf[ks] = *(const bf16x8*)(proj + (size_t)(row0 + rb * 16 + fr) * NPROJ + C_BQ + hh * 128 + map * 64 + 32 * ks + 8 * fq);
    const int lkey = tid >> 3, lseg = tid & 7;
    const int vkp = tid >> 4, ves = tid & 15;
    u32x4 rk[2], rv[2];
    auto load_tile = [&](int t) {
        if (prompt || t == 32) {
            const size_t rbase = prompt ? (size_t)(b * SEQ + t * 64) : (size_t)(TP + b * 64);
            const bf16_t* src = proj + (rbase + lkey) * NPROJ + hh * 128 + lseg * 16;
            rk[0] = *(const u32x4*)(src + C_BK); rk[1] = *(const u32x4*)(src + C_BK + 8);
            const bf16_t* sv = proj + (rbase + 2 * vkp) * NPROJ + C_BV + hh * 128 + ves * 8;
            rv[0] = *(const u32x4*)sv; rv[1] = *(const u32x4*)(sv + NPROJ);
        } else {
            const size_t o = (size_t)(t * 64 + lkey) * 512 + lseg * 16;
#pragma unroll
            for (int i = 0; i < 2; ++i) {
                const f32x4 a = *(const f32x4*)(ck + o + 8 * i), c = *(const f32x4*)(ck + o + 8 * i + 4);
                rk[i].x = pk2(a[0], a[1]); rk[i].y = pk2(a[2], a[3]); rk[i].z = pk2(c[0], c[1]); rk[i].w = pk2(c[2], c[3]);
                const size_t ov = (size_t)(t * 64 + 2 * vkp + i) * 512 + ves * 8;
                const f32x4 a2 = *(const f32x4*)(cv + ov), c2 = *(const f32x4*)(cv + ov + 4);
                rv[i].x = pk2(a2[0], a2[1]); rv[i].y = pk2(a2[2], a2[3]); rv[i].z = pk2(c2[0], c2[1]); rv[i].w = pk2(c2[2], c2[3]);
            }
        }
    };
    auto store_tile = [&](int buf) {
        bf16_t* kd = Ks + buf * 64 * 136 + lkey * 136 + lseg * 16;
        *(u32x4*)kd = rk[0]; *(u32x4*)(kd + 8) = rk[1];
        unsigned* vd = (unsigned*)(Vt + buf * 128 * 72 + (ves * 8) * 72) + (vkp ^ (2 * ves));
        const unsigned a0 = rv[0].x, a1 = rv[0].y, a2 = rv[0].z, a3 = rv[0].w, b0 = rv[1].x, b1 = rv[1].y, b2 = rv[1].z, b3 = rv[1].w;
        vd[0 * 36] = __builtin_amdgcn_perm(b0, a0, 0x05040100u); vd[1 * 36] = __builtin_amdgcn_perm(b0, a0, 0x07060302u);
        vd[2 * 36] = __builtin_amdgcn_perm(b1, a1, 0x05040100u); vd[3 * 36] = __builtin_amdgcn_perm(b1, a1, 0x07060302u);
        vd[4 * 36] = __builtin_amdgcn_perm(b2, a2, 0x05040100u); vd[5 * 36] = __builtin_amdgcn_perm(b2, a2, 0x07060302u);
        vd[6 * 36] = __builtin_amdgcn_perm(b3, a3, 0x05040100u); vd[7 * 36] = __builtin_amdgcn_perm(b3, a3, 0x07060302u);
    };
    f32x4 oacc[8];
#pragma unroll
    for (int et = 0; et < 8; ++et) oacc[et] = (f32x4){0.f, 0.f, 0.f, 0.f};
    float m_run = -INFINITY, l_run = 0.f;
    const float cs = 0.125f * 1.4426950408889634f;
    load_tile(0); store_tile(0);
    __syncthreads();
    asm volatile("" : "+v"(qf[0]), "+v"(qf[1]));
    for (int t = 0; t < nt; ++t) {
        const int buf = t & 1;
        if (t + 1 < nt) load_tile(t + 1);
        const bf16_t* kb = Ks + buf * 64 * 136; const bf16_t* vb = Vt + buf * 128 * 72;
        f32x4 sacc[4];
#pragma unroll
        for (int kt = 0; kt < 4; ++kt) {
            f32x4 a = (f32x4){0.f, 0.f, 0.f, 0.f};
#pragma unroll
            for (int ks = 0; ks < 2; ++ks) a = MFMA16(*(const bf16x8*)(kb + (16 * kt + fr) * 136 + map * 64 + 32 * ks + 8 * fq), qf[ks], a);
            sacc[kt] = a;
        }
        float mx = sacc[0][0];
#pragma unroll
        for (int kt = 0; kt < 4; ++kt)
#pragma unroll
            for (int j = 0; j < 4; ++j) mx = fmaxf(mx, sacc[kt][j]);
        mx = fmaxf(mx, __shfl_xor(mx, 16)); mx = fmaxf(mx, __shfl_xor(mx, 32));
        const float m_new = fmaxf(m_run, mx);
        const float alpha = __builtin_amdgcn_exp2f((m_run - m_new) * cs);
        m_run = m_new;
        float psum = 0.f;
        bf16x8 pf[2];
#pragma unroll
        for (int ks = 0; ks < 2; ++ks) {
            float pv[8];
#pragma unroll
            for (int i = 0; i < 8; ++i) { pv[i] = __builtin_amdgcn_exp2f((sacc[2 * ks + (i >> 2)][i & 3] - m_new) * cs); psum += pv[i]; }
            u32x4 pk; pk.x = pk2(pv[0], pv[1]); pk.y = pk2(pv[2], pv[3]); pk.z = pk2(pv[4], pv[5]); pk.w = pk2(pv[6], pv[7]);
            pf[ks] = __builtin_bit_cast(bf16x8, pk);
        }
        l_run = l_run * alpha + psum;
#pragma unroll
        for (int et = 0; et < 8; ++et) {
            f32x4 a = oacc[et] * alpha;
#pragma unroll
            for (int ks = 0; ks < 2; ++ks) {
                const int sw = 2 * (2 * et + (fr >> 3));
                const bf16x4 v0 = *(const bf16x4*)(vb + (16 * et + fr) * 72 + 2 * ((16 * ks + 2 * fq) ^ sw));
                const bf16x4 v1 = *(const bf16x4*)(vb + (16 * et + fr) * 72 + 2 * ((16 * ks + 8 + 2 * fq) ^ sw));
                const bf16x8 vx = __builtin_shufflevector(v0, v1, 0, 1, 2, 3, 4, 5, 6, 7);
                a = MFMA16(vx, pf[ks], a);
            }
            oacc[et] = a;
        }
        if (t + 1 < nt) store_tile(buf ^ 1);
        __syncthreads();
    }
    float lt = l_run; lt += __shfl_xor(lt, 16); lt += __shfl_xor(lt, 32);
    const float inv = 1.f / lt;
    const int q = rb * 16 + fr;
    if (map == 1) {
#pragma unroll
        for (int et = 0; et < 8; ++et)
#pragma unroll
            for (int j = 0; j < 4; ++j) ob[q * 129 + 16 * et + 4 * fq + j] = oacc[et][j] * inv * lam;
    }
    __syncthreads();
    if (map == 0) {
        float ss = 0.f;
#pragma unroll
        for (int et = 0; et < 8; ++et)
#pragma unroll
            for (int j = 0; j < 4; ++j) { const float o = oacc[et][j] * inv - ob[q * 129 + 16 * et + 4 * fq + j]; oacc[et][j] = o; ss += o * o; }
        ss += __shfl_xor(ss, 16); ss += __shfl_xor(ss, 32);
        const float sc = rsqrtf(ss * (1.f / 128.f) + EPS) * (1.f - lam_init);
        const float* bn = p.in[16] + l * 128;
#pragma unroll
        for (int et = 0; et < 8; ++et) {
            const int e = 16 * et + 4 * fq; const f32x4 g4 = *(const f32x4*)(bn + e);
            u32x2 o; o.x = pk2(oacc[et][0] * sc * g4[0], oacc[et][1] * sc * g4[1]); o.y = pk2(oacc[et][2] * sc * g4[2], oacc[et][3] * sc * g4[3]);
            *(u32x2*)(mixed + (size_t)(row0 + q) * NPROJ + C_BQ + hh * 128 + e) = o;
        }
    }
}

constexpr int PL_XS = 0, PL_PB = 40448;
__device__ __forceinline__ void pool_item(const Params& p, unsigned char* smem, int l, int pt, int gi) {
    const int tid = opaque_tid(), lane = tid & 63, w = tid >> 6, fr = lane & 15, fq = lane >> 4;
    const bf16_t* proj = (const bf16_t*)(p.ws + WS_R2);
    bf16_t* mixed = (bf16_t*)(p.ws + WS_R2);
    const int r0 = pt * 64; const bool prompt = r0 < TP;
    const int b = prompt ? (r0 >> 11) : ((r0 - TP) >> 6), t0 = prompt ? (r0 & 2047) : 0;
    float* xs = (float*)(smem + PL_XS); bf16_t* pb = (bf16_t*)(smem + PL_PB);
    const float* cpool = p.in[6] + ((size_t)l * 16 + b) * 15 * 512 + gi * 128;
    {
        u32x4 raw[3]; f32x4 ca[3], cc[3];
#pragma unroll
        for (int k = 0; k < 3; ++k) {
            const int idx = tid + 512 * k, rr = idx >> 4, sg = idx & 15, tt = t0 + rr - 15;
            raw[k] = (u32x4){0u, 0u, 0u, 0u}; ca[k] = (f32x4){0.f, 0.f, 0.f, 0.f}; cc[k] = ca[k];
            if (idx < 79 * 16) {
                if (tt >= 0) raw[k] = *(const u32x4*)(proj + (size_t)(r0 + rr - 15) * NPROJ + C_CX + gi * 128 + sg * 8);
                else if (!prompt) { ca[k] = *(const f32x4*)(cpool + (15 + tt) * 512 + sg * 8); cc[k] = *(const f32x4*)(cpool + (15 + tt) * 512 + sg * 8 + 4); }
            }
        }
#pragma unroll
        for (int k = 0; k < 3; ++k) {
            const int idx = tid + 512 * k, rr = idx >> 4, sg = idx & 15, tt = t0 + rr - 15;
            if (idx < 79 * 16) {
                float x[8];
                if (tt >= 0) unpack8(raw[k], x);
                else { x[0] = ca[k][0]; x[1] = ca[k][1]; x[2] = ca[k][2]; x[3] = ca[k][3]; x[4] = cc[k][0]; x[5] = cc[k][1]; x[6] = cc[k][2]; x[7] = cc[k][3]; }
                *(f32x4*)(xs + rr * 128 + sg * 8) = (f32x4){x[0], x[1], x[2], x[3]}; *(f32x4*)(xs + rr * 128 + sg * 8 + 4) = (f32x4){x[4], x[5], x[6], x[7]};
            }
        }
    }
    __syncthreads();
    const int win = 2 << gi;
    {
        const int c = tid & 127, tf = (tid >> 7) * 16;
        float s = 0.f;
        for (int j = 0; j < win; ++j) s += xs[(15 + tf - j) * 128 + c];
#pragma unroll 4
        for (int tt = 0; tt < 16; ++tt) {
            const int t = tf + tt; const float xt = xs[(15 + t) * 128 + c];
            if (tt > 0) s += xt - xs[(15 + t - win) * 128 + c];
            const int cnt = prompt ? min(t0 + t + 1, win) : win;
            pb[t * 136 + c] = f2bf(s / (float)cnt - xt);
        }
    }
    if (!prompt || t0 == SEQ - 64) {
        float* po = p.out + (prompt ? O_PPOOL : O_SPOOL) + ((size_t)l * 16 + b) * 15 * 512 + gi * 128;
        for (int idx = tid; idx < 15 * 128; idx += 512) { const int rr = idx >> 7, c = idx & 127; po[rr * 512 + c] = xs[(15 + 49 + rr) * 128 + c]; }
    }
    __syncthreads();
    const bf16_t* cw = (const bf16_t*)(p.ws + WS_CW) + ((size_t)l * 4 + gi) * 16384;
    bf16x8 yf[4];
#pragma unroll
    for (int ks = 0; ks < 4; ++ks) yf[ks] = *(const bf16x8*)(cw + (16 * w + fr) * 128 + 32 * ks + 8 * fq);
    const f32x4 sc4 = *(const f32x4*)(p.in[18] + l * 512 + gi * 128 + 16 * w + 4 * fq);
#pragma unroll
    for (int tt = 0; tt < 4; ++tt) {
        f32x4 a = (f32x4){0.f, 0.f, 0.f, 0.f};
#pragma unroll
        for (int ks = 0; ks < 4; ++ks) a = MFMA16(yf[ks], *(const bf16x8*)(pb + (16 * tt + fr) * 136 + 32 * ks + 8 * fq), a);
        u32x2 o; o.x = pk2(a[0] * sc4[0], a[1] * sc4[1]); o.y = pk2(a[2] * sc4[2], a[3] * sc4[3]);
        *(u32x2*)(mixed + (size_t)(r0 + 16 * tt + fr) * NPROJ + C_PO + gi * 128 + 16 * w + 4 * fq) = o;
    }
}

constexpr int PL2_HALF = 58368;
__device__ __forceinline__ void pool_item2(const Params& p, unsigned char* smem, int l, int itA) {
    const int tid = opaque_tid(), half = __builtin_amdgcn_readfirstlane(tid >> 8), t = tid & 255, lane = t & 63, wl = t >> 6, fr = lane & 15, fq = lane >> 4;
    const int item = itA + half, pt = item >> 2, gi = item & 3;
    const bf16_t* proj = (const bf16_t*)(p.ws + WS_R2);
    bf16_t* mixed = (bf16_t*)(p.ws + WS_R2);
    const int r0 = pt * 64; const bool prompt = r0 < TP;
    const int b = prompt ? (r0 >> 11) : ((r0 - TP) >> 6), t0 = prompt ? (r0 & 2047) : 0;
    float* xs = (float*)(smem + half * PL2_HALF); bf16_t* pb = (bf16_t*)(smem + half * PL2_HALF + 40448);
    const float* cpool = p.in[6] + ((size_t)l * 16 + b) * 15 * 512 + gi * 128;
    {
        u32x4 raw[5]; f32x4 ca[5], cc[5];
#pragma unroll
        for (int k = 0; k < 5; ++k) {
            const int idx = t + 256 * k, rr = idx >> 4, sg = idx & 15, tt = t0 + rr - 15;
            raw[k] = (u32x4){0u, 0u, 0u, 0u}; ca[k] = (f32x4){0.f, 0.f, 0.f, 0.f}; cc[k] = ca[k];
            if (idx < 79 * 16) {
                if (tt >= 0) raw[k] = *(const u32x4*)(proj + (size_t)(r0 + rr - 15) * NPROJ + C_CX + gi * 128 + sg * 8);
                else if (!prompt) { ca[k] = *(const f32x4*)(cpool + (15 + tt) * 512 + sg * 8); cc[k] = *(const f32x4*)(cpool + (15 + tt) * 512 + sg * 8 + 4); }
            }
        }
#pragma unroll
        for (int k = 0; k < 5; ++k) {
            const int idx = t + 256 * k, rr = idx >> 4, sg = idx & 15, tt = t0 + rr - 15;
            if (idx < 79 * 16) {
                float x[8];
                if (tt >= 0) unpack8(raw[k], x);
                else { x[0] = ca[k][0]; x[1] = ca[k][1]; x[2] = ca[k][2]; x[3] = ca[k][3]; x[4] = cc[k][0]; x[5] = cc[k][1]; x[6] = cc[k][2]; x[7] = cc[k][3]; }
                *(f32x4*)(xs + rr * 128 + sg * 8) = (f32x4){x[0], x[1], x[2], x[3]}; *(f32x4*)(xs + rr * 128 + sg * 8 + 4) = (f32x4){x[4], x[5], x[6], x[7]};
            }
        }
    }
    __syncthreads();
    const int win = 2 << gi;
    {
        const int c = t & 127, tf = (t >> 7) * 32;
        float s = 0.f;
        for (int j = 0; j < win; ++j) s += xs[(15 + tf - j) * 128 + c];
#pragma unroll 4
        for (int tt = 0; tt < 32; ++tt) {
            const int tq = tf + tt; const float xt = xs[(15 + tq) * 128 + c];
            if (tt > 0) s += xt - xs[(15 + tq - win) * 128 + c];
            const int cnt = prompt ? min(t0 + tq + 1, win) : win;
            pb[tq * 136 + c] = f2bf(s / (float)cnt - xt);
        }
    }
    if (!prompt || t0 == SEQ - 64) {
        float* po = p.out + (prompt ? O_PPOOL : O_SPOOL) + ((size_t)l * 16 + b) * 15 * 512 + gi * 128;
        for (int idx = t; idx < 15 * 128; idx += 256) { const int rr = idx >> 7, c = idx & 127; po[rr * 512 + c] = xs[(15 + 49 + rr) * 128 + c]; }
    }
    __syncthreads();
    const bf16_t* cw = (const bf16_t*)(p.ws + WS_CW) + ((size_t)l * 4 + gi) * 16384;
#pragma unroll
    for (int dh = 0; dh < 2; ++dh) {
        const int dt = 2 * wl + dh;
        bf16x8 yf[4];
#pragma unroll
        for (int ks = 0; ks < 4; ++ks) yf[ks] = *(const bf16x8*)(cw + (16 * dt + fr) * 128 + 32 * ks + 8 * fq);
        const f32x4 sc4 = *(const f32x4*)(p.in[18] + l * 512 + gi * 128 + 16 * dt + 4 * fq);
#pragma unroll
        for (int tt = 0; tt < 4; ++tt) {
            f32x4 a = (f32x4){0.f, 0.f, 0.f, 0.f};
#pragma unroll
            for (int ks = 0; ks < 4; ++ks) a = MFMA16(yf[ks], *(const bf16x8*)(pb + (16 * tt + fr) * 136 + 32 * ks + 8 * fq), a);
            u32x2 o; o.x = pk2(a[0] * sc4[0], a[1] * sc4[1]); o.y = pk2(a[2] * sc4[2], a[3] * sc4[3]);
            *(u32x2*)(mixed + (size_t)(r0 + 16 * tt + fr) * NPROJ + C_PO + gi * 128 + 16 * dt + 4 * fq) = o;
        }
    }
}

constexpr int N_PREP = 1056, N_PL = 1056, N_AS = 64, N_AP = 2048, N_AP_A = 0;
__device__ __forceinline__ void phase_mix(const Params& p, unsigned char* smem, int l, const bool second) {
    const int tid = opaque_tid();
    const float lam_init = (l == 0) ? 0.2f : 0.35550906759096924f;
    float lam;
    { const float* bl = p.in[15] + l * 256; float s1 = 0.f, s2 = 0.f;
        for (int i = 0; i < 64; ++i) { s1 += bl[i] * bl[64 + i]; s2 += bl[128 + i] * bl[192 + i]; }
        lam = expf(s1) - expf(s2) + lam_init; }
    if (second) { for (int sid = blockIdx.x; sid < 128; sid += gridDim.x) delta_scan(p, smem, l, sid); }
    unsigned* ctr = (unsigned*)(p.ws + WS_CTL) + l * 2 + (second ? 1 : 0);
    int* s_item = (int*)(smem + LDS_BYTES - 16);
    const int nitems = second ? (N_AP - N_AP_A) : (N_PREP + N_AS + N_AP_A + N_PL);
    for (;;) {
        __syncthreads();
        if (tid == 0) *s_item = (int)atomicAdd(ctr, 1u);
        __syncthreads();
        int item = *s_item;
        if (item >= nitems) break;
        if (second) { item += N_AP_A; const int qc = 31 - (item >> 6), bh = item & 63; attn_item(p, smem, l, true, bh >> 2, bh & 3, qc, lam, lam_init); continue; }
        if (item < N_AS) { attn_item(p, smem, l, false, item >> 2, item & 3, 0, lam, lam_init); continue; }
        item -= N_AS;
        if (item < N_PREP) { const int i0 = 2 * item, i1 = 2 * item + 1, c0 = i0 >> 6, q0 = i0 & 63, c1 = i1 >> 6, q1 = i1 & 63;
            delta_prep2(p, smem, l, c0 < 32 ? q0 * 32 + c0 : 2048 + q0, c1 < 32 ? q1 * 32 + c1 : 2048 + q1); continue; }
        item -= N_PREP;
        if (item < N_AP_A) { const int qc = 31 - (item >> 6), bh = item & 63; attn_item(p, smem, l, true, bh >> 2, bh & 3, qc, lam, lam_init); continue; }
        item -= N_AP_A;
        pool_item2(p, smem, l, 2 * item);
    }
}

__device__ __forceinline__ void phase_ffnconv(const Params& p, int l) {
    bf16_t* u = (bf16_t*)(p.ws + WS_R2); const bf16_t* side = (const bf16_t*)(p.ws + WS_SIDE);
    const float* cw = p.in[22] + l * 3 * NFF2; const float* cb = p.in[23] + l * NFF2;
    const int nitems = 1056 * 352;
    const int tid0 = opaque_tid();
    for (int item = blockIdx.x * NTHREADS + tid0; item < nitems; item += gridDim.x * NTHREADS) {
        const int seg = item / 352, j = (item % 352) * 8;
        float wg[3][8], wv[3][8], bg[8], bv[8];
#pragma unroll
        for (int i = 0; i < 3; ++i) {
            const f32x4 a0 = *(const f32x4*)(cw + i * NFF2 + j), a1 = *(const f32x4*)(cw + i * NFF2 + j + 4), c0 = *(const f32x4*)(cw + i * NFF2 + NFF + j), c1 = *(const f32x4*)(cw + i * NFF2 + NFF + j + 4);
#pragma unroll
            for (int e = 0; e < 4; ++e) { wg[i][e] = a0[e]; wg[i][4 + e] = a1[e]; wv[i][e] = c0[e]; wv[i][4 + e] = c1[e]; }
        }
        { const f32x4 a0 = *(const f32x4*)(cb + j), a1 = *(const f32x4*)(cb + j + 4), c0 = *(const f32x4*)(cb + NFF + j), c1 = *(const f32x4*)(cb + NFF + j + 4);
#pragma unroll
            for (int e = 0; e < 4; ++e) { bg[e] = a0[e]; bg[4 + e] = a1[e]; bv[e] = c0[e]; bv[4 + e] = c1[e]; } }
        float g1[8], g2[8], v1[8], v2[8];
        const int r0 = seg * 32;
        if (r0 >= TP && ((r0 - TP) & 63) == 0) {
            const float* c = p.in[7] + ((size_t)l * 16 + ((r0 - TP) >> 6)) * 2 * NFF2;
#pragma unroll
            for (int e = 0; e < 8; ++e) { g1[e] = c[j + e]; v1[e] = c[NFF + j + e]; g2[e] = c[NFF2 + j + e]; v2[e] = c[NFF2 + NFF + j + e]; }
        } else if (r0 < TP && (r0 & 2047) == 0) {
#pragma unroll
            for (int e = 0; e < 8; ++e) { g1[e] = 0.f; g2[e] = 0.f; v1[e] = 0.f; v2[e] = 0.f; }
        } else {
            const bf16_t* sd = side + (size_t)(seg - 1) * 2 * NFF2;
            unpack8(*(const u32x4*)(sd + j), g1); unpack8(*(const u32x4*)(sd + NFF + j), v1); unpack8(*(const u32x4*)(sd + NFF2 + j), g2); unpack8(*(const u32x4*)(sd + NFF2 + NFF + j), v2);
        }
        bf16_t* ur = u + (size_t)r0 * NFF2 + j;
#pragma unroll 4
        for (int r = 0; r < 32; ++r) {
            float g3[8], v3[8];
            unpack8(*(const u32x4*)(ur + (size_t)r * NFF2), g3); unpack8(*(const u32x4*)(ur + (size_t)r * NFF2 + NFF), v3);
            float hh[8];
#pragma unroll
            for (int e = 0; e < 8; ++e) {
                const float cg = bg[e] + wg[0][e] * g1[e] + wg[1][e] * g2[e] + wg[2][e] * g3[e], cv = bv[e] + wv[0][e] * v1[e] + wv[1][e] * v2[e] + wv[2][e] * v3[e];
                hh[e] = siluf(cg) * cv; g1[e] = g2[e]; g2[e] = g3[e]; v1[e] = v2[e]; v2[e] = v3[e];
            }
            u32x4 o; o.x = pk2(hh[0], hh[1]); o.y = pk2(hh[2], hh[3]); o.z = pk2(hh[4], hh[5]); o.w = pk2(hh[6], hh[7]);
            *(u32x4*)(ur + (size_t)r * NFF2) = o;
        }
    }
}

template <int s> __device__ __forceinline__ void run_step(const Params& p, unsigned char* smem) {
    constexpr int l = s / 9, ph = s % 9;
    if constexpr (s == 18) { phase_norm(p, smem, 0, 2, 11, p.ws + WS_R2 + 5632, 11264); }
    else if constexpr (ph == 1 || ph == 4 || ph == 6 || ph == 8) {
        pg8::Gemm g; pg8::EpiAny E; bool perm = true;
        if constexpr (ph == 1) {
            g = pg8::Gemm{(const bf16_t*)(p.ws + WS_H), (const bf16_t*)(p.ws + WS_WIN) + (size_t)l * 4096 * 1024, T, NPN, 1024, 1024};
            E = pg8::EpiAny{0, l, p.ws + WS_R2, nullptr, p.out, 0};
        } else if constexpr (ph == 4) {
            g = pg8::Gemm{(const bf16_t*)(p.ws + WS_R2) + C_AZ, (const bf16_t*)(p.ws + WS_WOUT) + (size_t)l * 1024 * 1536, T, D, NMIX, NPROJ};
            E = pg8::EpiAny{1, l, (void*)(l == 0 ? p.in[0] : p.out), p.ws + WS_QK, p.out, 4096}; perm = false;
        } else if constexpr (ph == 6) {
            g = pg8::Gemm{(const bf16_t*)(p.ws + WS_H), (const bf16_t*)(p.ws + WS_WUP) + (size_t)l * NFF2 * 1024, T, NFF2, 1024, 1024};
            E = pg8::EpiAny{2, l, p.ws + WS_R2, p.ws + WS_SIDE, p.out, 0};
        } else {
            g = pg8::Gemm{(const bf16_t*)(p.ws + WS_R2), (const bf16_t*)(p.ws + WS_WDN) + (size_t)l * 1024 * NFF, T, D, NFF, NFF2};
            E = pg8::EpiAny{1, l, p.out, p.ws + WS_R2 + 5632, p.out, 11264}; perm = false;
        }
        pg8::StaticOrder S; S.init(g.M, g.N, g.K, gridDim.x, blockIdx.x, (ph == 4 || ph == 8) ? TSM : 0);
        pg8::gemm_phase((LAS unsigned char*)smem, g, S, E, perm);
    } else if constexpr (ph == 0) {
        if constexpr (l == 0) phase_weights(p, smem);
        if constexpr (l == 0) phase_norm(p, smem, l, 0); else phase_norm(p, smem, l, 0, 11, p.ws + WS_R2 + 5632, 11264);
    } else if constexpr (ph == 2) phase_mix(p, smem, l, false);
    else if constexpr (ph == 3) phase_mix(p, smem, l, true);
    else if constexpr (ph == 5) phase_norm(p, smem, l, 1, 6, p.ws + WS_QK, 4096);
    else phase_ffnconv(p, l);
}

#define XB_TMO      128
#define XB_XCNT(j)  (256  + 64 * (j))
#define XB_XSUB(j)  (1280 + 64 * (j))
#define XB_XGEN(j)  (2304 + 64 * (j))
#define XB_TOP      3328
#define XB_TOPGEN   3392
#define XCD_BAR_WORDS 3456
#define XB_SPIN_CAP (1u << 18)

__device__ __forceinline__ unsigned xb_ld(unsigned* p)              { return __hip_atomic_load(p, __ATOMIC_RELAXED, __HIP_MEMORY_SCOPE_AGENT); }
__device__ __forceinline__ unsigned xb_add(unsigned* p, unsigned v) { return __hip_atomic_fetch_add(p, v, __ATOMIC_RELAXED, __HIP_MEMORY_SCOPE_AGENT); }
__device__ __forceinline__ unsigned xb_xcc_id() { return (unsigned)__builtin_amdgcn_s_getreg((3 << 11) | 20) & 0xFu; }
#define XB_SPIN(cond, bar) do { unsigned _sp = 0; while (cond) { __builtin_amdgcn_s_sleep(1); \
    if ((++_sp & 255u) == 0u) { if (xb_ld(&(bar)[XB_TMO])) break; if (_sp > XB_SPIN_CAP) { atomicAdd(&(bar)[XB_TMO], 1u); break; } } } } while (0)

struct XcdBarrier {
    unsigned* bar; unsigned x;
    volatile LAS unsigned* st;
};

__device__ __forceinline__ XcdBarrier xcd_barrier_post(unsigned* bar, volatile LAS unsigned* st) {
    XcdBarrier b; b.bar = bar; b.x = xb_xcc_id(); b.st = st;
    if (threadIdx.x == 0) (void)xb_add(&bar[XB_XCNT(b.x)], 1u);
    return b;
}
__device__ __forceinline__ void xcd_barrier_complete(unsigned* bar, unsigned x, unsigned& nloc, unsigned& nx) {
    const unsigned G = gridDim.x * gridDim.y * gridDim.z;
    unsigned sum, cnt, mine, sp = 0u;
    for (;;) {
        sum = 0u; cnt = 0u; mine = 0u;
#pragma unroll
        for (unsigned j = 0; j < 16; ++j) { const unsigned c = xb_ld(&bar[XB_XCNT(j)]); sum += c; cnt += (c > 0u) ? 1u : 0u; mine = (j == x) ? c : mine; }
        if (sum == G) break;
        __builtin_amdgcn_s_sleep(1);
        if ((++sp & 255u) == 0u) { if (xb_ld(&bar[XB_TMO])) break; if (sp > XB_SPIN_CAP) { atomicAdd(&bar[XB_TMO], 1u); break; } }
    }
    nloc = mine > 0u ? mine : 1u; nx = cnt > 0u ? cnt : 1u;
}

__device__ __forceinline__ void xcd_barrier(const XcdBarrier& b) {
    asm volatile("s_waitcnt vmcnt(0)" ::: "memory");
    __syncthreads();
    if (threadIdx.x == 0) {
        unsigned* bar = b.bar;
        __builtin_amdgcn_s_waitcnt(0);
        unsigned nloc = b.st[0], nx = b.st[1];
        if (nloc == 0u) { xcd_barrier_complete(bar, b.x, nloc, nx); b.st[0] = nloc; b.st[1] = nx; }
        const unsigned old = xb_add(&bar[XB_XSUB(b.x)], 1u);
        const unsigned gen = old / nloc;
        if (old + 1u == (gen + 1u) * nloc) {
            __builtin_amdgcn_fence(__ATOMIC_RELEASE, "agent");
            asm volatile("s_waitcnt vmcnt(0)" ::: "memory");
            const unsigned og = xb_add(&bar[XB_TOP], 1u);
            const unsigned tg = og / nx;
            if (og + 1u == (tg + 1u) * nx) xb_add(&bar[XB_TOPGEN], 1u);
            else XB_SPIN(xb_ld(&bar[XB_TOPGEN]) == tg, bar);
            __builtin_amdgcn_fence(__ATOMIC_ACQUIRE, "agent");
            xb_add(&bar[XB_XGEN(b.x)], 1u);
            asm volatile("s_waitcnt vmcnt(0)" ::: "memory");
        } else {
            XB_SPIN(xb_ld(&bar[XB_XGEN(b.x)]) == gen, bar);
            __builtin_amdgcn_fence(__ATOMIC_ACQUIRE, "agent");
            asm volatile("s_waitcnt vmcnt(0)" ::: "memory");
        }
    }
    __syncthreads();
}


__global__ void __launch_bounds__(NTHREADS, 2) fwd_megakernel(Params p) {
    extern __shared__ __attribute__((aligned(16))) unsigned char smem[];
    cg::grid_group grid = cg::this_grid();
    volatile LAS unsigned* xst = (volatile LAS unsigned*)(LAS unsigned char*)(smem + LDS_BYTES - 8);
    if (p.ws == nullptr) grid.sync();
    if (threadIdx.x == 0) { xst[0] = 0u; xst[1] = 0u; }
    __syncthreads();
    const XcdBarrier xb = xcd_barrier_post((unsigned*)(p.ws + WS_BAR), xst);
    run_step<0>(p, smem); xcd_barrier(xb);
    run_step<1>(p, smem); xcd_barrier(xb);  run_step<2>(p, smem); xcd_barrier(xb);  run_step<3>(p, smem); xcd_barrier(xb);
    run_step<4>(p, smem); xcd_barrier(xb);  run_step<5>(p, smem); xcd_barrier(xb);  run_step<6>(p, smem); xcd_barrier(xb);  run_step<7>(p, smem); xcd_barrier(xb);
    run_step<8>(p, smem); xcd_barrier(xb);  run_step<9>(p, smem); xcd_barrier(xb);  run_step<10>(p, smem); xcd_barrier(xb); run_step<11>(p, smem); xcd_barrier(xb);
    run_step<12>(p, smem); xcd_barrier(xb); run_step<13>(p, smem); xcd_barrier(xb); run_step<14>(p, smem); xcd_barrier(xb); run_step<15>(p, smem); xcd_barrier(xb);
    run_step<16>(p, smem); xcd_barrier(xb); run_step<17>(p, smem); xcd_barrier(xb); run_step<18>(p, smem);
}

extern "C" void kernel_launch(void* const* d_in, const int* in_sizes, int n_in, void* d_out, int out_size, void* d_ws, size_t ws_size, hipStream_t stream) {
    static int grid_blocks = 0;
    if (grid_blocks == 0) {
        if (n_in != 26 || ws_size < WS_END) { fprintf(stderr, "kernel_launch: unexpected problem (n_in %d, ws %zu < %zu)\n", n_in, ws_size, (size_t)WS_END); grid_blocks = -1; return; }
        int dev = 0, cus = 0, per_cu = 0;
        (void)hipGetDevice(&dev);
        (void)hipDeviceGetAttribute(&cus, hipDeviceAttributeMultiprocessorCount, dev);
        if (hipFuncSetAttribute((const void*)fwd_megakernel, hipFuncAttributeMaxDynamicSharedMemorySize, LDS_BYTES) != hipSuccess) { fprintf(stderr, "hipFuncSetAttribute failed\n"); grid_blocks = -1; return; }
        if (hipOccupancyMaxActiveBlocksPerMultiprocessor(&per_cu, (const void*)fwd_megakernel, NTHREADS, LDS_BYTES) != hipSuccess || per_cu < 1) { fprintf(stderr, "occupancy query failed (%d)\n", per_cu); (void)hipGetLastError(); per_cu = 1; }
        if (per_cu > 1) per_cu = 1;
        grid_blocks = cus * per_cu;
    }
    if (grid_blocks < 0) return;
    Params p{};
    for (int i = 0; i < 26; ++i) p.in[i] = (const float*)d_in[i];
    p.out = (float*)d_out; p.ws = (unsigned char*)d_ws;
    void* args[] = {&p};
    if (hipMemsetAsync((char*)d_ws + WS_CTL, 0, 16384, stream) != hipSuccess) { fprintf(stderr, "kernel_launch: hipMemsetAsync of the control words failed\n"); return; }
    hipError_t e = hipLaunchCooperativeKernel((const void*)fwd_megakernel, dim3(grid_blocks), dim3(NTHREADS), args, LDS_BYTES, stream);
    if (e != hipSuccess) fprintf(stderr, "cooperative launch failed: %s (grid %d)\n", hipGetErrorString(e), grid_blocks);
}
```
